# Optimizing an MI355X kernel written in HIP

```python
import jax, jax.numpy as jnp
from jax import lax
import numpy as np

D_MODEL = 1024
BATCH = 8
SEQ = 8192
DEPTH = 4
DEC_BATCH = 16
DEC_SEQ = 64
PAST_LEN = 1024

CHUNK = 64
N_EVEN = (DEPTH + 1) // 2
N_ODD = DEPTH // 2
A_WIDTH = D_MODEL // 2
A_HEAD_DIM = 64
A_HEADS = A_WIDTH // A_HEAD_DIM
A_DECAY_LORA = 64
A_ICL_LORA = 64
A_GATE_LORA = 128
A_PROJ = 3 * A_WIDTH + A_DECAY_LORA + A_ICL_LORA + A_GATE_LORA
A_NORM_EPS = 64e-5
B_VWIDTH = D_MODEL // 2
B_KWIDTH = B_VWIDTH // 2
B_HEADS = 4
B_KEY_DIM = B_KWIDTH // B_HEADS
B_VAL_DIM = B_VWIDTH // B_HEADS
B_GATE_LORA = 16
B_GATE_NORM = 16.0
B_PROJ = 2 * B_KWIDTH + 2 * B_VWIDTH + B_GATE_LORA
MIX_PROJ = A_PROJ + B_PROJ
C_HEAD_DIM = 64
C_HEADS = D_MODEL // C_HEAD_DIM
C_PAST_CHUNKS = 8
C_PAST_ROWS = C_PAST_CHUNKS * CHUNK
C_BAND = C_PAST_ROWS + CHUNK
C_REL_CLIP = 128
FFN_HIDDEN = ((8 * D_MODEL + 3 * 256 - 1) // (3 * 256)) * 256
LN_EPS = 1e-5
DEEPNORM_ALPHA = (2.0 * DEPTH) ** 0.25
DEEPNORM_BETA = (8.0 * DEPTH) ** -0.25
NEG_INF = -1e30

kernel_name = "hybrid_rwkv7_gla_chunkband_streaming_step"

F32 = jnp.float32


def layer_norm(x, w, b):
    xf = x.astype(F32)
    mu = jnp.mean(xf, -1, keepdims=True)
    var = jnp.mean(jnp.square(xf - mu), -1, keepdims=True)
    return ((xf - mu) * lax.rsqrt(var + LN_EPS) * w.astype(F32) + b.astype(F32)).astype(x.dtype)


def swiglu(x, w_in, w_out):
    gate, up = jnp.split(x @ w_in, 2, axis=-1)
    return (jax.nn.silu(gate) * up) @ w_out


def wkv7_scan(r, decay, k, v, kk, a, S0):
    def step(S, inp):
        r_t, w_t, k_t, v_t, kk_t, a_t = inp
        sa = jnp.einsum('bhvk,bhk->bhv', S, kk_t)
        S = (S * w_t[:, :, None, :] - sa[..., None] * (kk_t * a_t)[:, :, None, :]
             + v_t[..., None] * k_t[:, :, None, :])
        return S, jnp.einsum('bhvk,bhk->bhv', S, r_t)
    xs = tuple(jnp.swapaxes(t, 0, 1) for t in (r, decay, k, v, kk, a))
    S, o = lax.scan(step, S0.astype(F32), xs)
    return S, jnp.swapaxes(o, 0, 1)


def rwkv7_time_mix(pa, shift0, wkv0, mu, w0, w2, a0, a2, g2, k_k, k_a, r_k, ln_w, ln_b):
    Bsz, T, _ = pa.shape
    prev = jnp.concatenate([shift0[:, None, :].astype(pa.dtype), pa[:, :-1]], axis=1)
    xs = pa + (prev - pa) * mu
    i3 = 3 * A_WIDTH
    r, k, v, xw, xa, xg = jnp.split(
        xs, [A_WIDTH, 2 * A_WIDTH, i3, i3 + A_DECAY_LORA, i3 + A_DECAY_LORA + A_ICL_LORA], axis=-1)
    w = -jax.nn.softplus(-(w0 + jnp.tanh(xw) @ w2).astype(F32)) - 0.5
    decay = jnp.exp(-jnp.exp(w))
    a = jax.nn.sigmoid((a0 + xa @ a2).astype(F32))
    g = jax.nn.sigmoid(xg) @ g2
    hs = (Bsz, T, A_HEADS, A_HEAD_DIM)
    hd = (A_HEADS, A_HEAD_DIM)
    r, k, v, decay, a = (t.astype(F32).reshape(hs) for t in (r, k, v, decay, a))
    kk = k * k_k.astype(F32).reshape(hd)
    kk = kk * lax.rsqrt(jnp.sum(kk * kk, -1, keepdims=True) + 1e-12)
    k = k * (1.0 + (a - 1.0) * k_a.astype(F32).reshape(hd))
    wkv, o = wkv7_scan(r, decay, k, v, kk, a, wkv0)
    mean = jnp.mean(o, -1, keepdims=True)
    var = jnp.mean(jnp.square(o - mean), -1, keepdims=True)
    o = (o - mean) * lax.rsqrt(var + A_NORM_EPS) * ln_w.astype(F32).reshape(hd) + ln_b.astype(F32).reshape(hd)
    o = o + jnp.sum(r * k * r_k.astype(F32), -1, keepdims=True) * v
    y = o.reshape(Bsz, T, A_WIDTH).astype(pa.dtype) * g
    return y, wkv.astype(wkv0.dtype), pa[:, -1]


def _to_chunks(t, L):
    Bsz, T, H, d = t.shape
    return t.reshape(Bsz, T // L, L, H, d).transpose(1, 0, 3, 2, 4)


def gla_chunked(q, k, v, log_a, S0):
    Bsz, T, H, _ = q.shape
    L = min(CHUNK, T)
    qc, kc, vc, lc = (_to_chunks(t, L) for t in (q, k, v, log_a))
    bc = jnp.cumsum(lc, axis=3)
    mask = jnp.tril(jnp.ones((L, L), bool))

    def step(S, inp):
        q_i, k_i, v_i, b_i = inp
        b_last = b_i[:, :, -1, :]
        q_dec = q_i * jnp.exp(b_i)
        scores = jnp.einsum('bhtd,bhsd->bhts', q_dec, k_i * jnp.exp(-b_i))
        scores = jnp.where(mask, scores, 0.0)
        o = jnp.einsum('bhtd,bhdv->bhtv', q_dec, S) + jnp.einsum('bhts,bhsv->bhtv', scores, v_i)
        k_state = k_i * jnp.exp(b_last[:, :, None, :] - b_i)
        S = S * jnp.exp(b_last)[..., None] + jnp.einsum('bhsd,bhsv->bhdv', k_state, v_i)
        return S, o

    S, o = lax.scan(step, S0.astype(F32), (qc, kc, vc, bc))
    o = o.transpose(1, 0, 3, 2, 4).reshape(Bsz, T, H, v.shape[-1])
    return o, S


def gla_mix(pb, S0, alpha_up, alpha_bias, norm_w):
    Bsz, T, _ = pb.shape
    kw, vw = B_KWIDTH, B_VWIDTH
    q, k, v, xa, rg = jnp.split(pb, [kw, 2 * kw, 2 * kw + vw, 2 * kw + vw + B_GATE_LORA], axis=-1)
    log_a = jax.nn.log_sigmoid((xa @ alpha_up + alpha_bias).astype(F32)) / B_GATE_NORM
    ks = (Bsz, T, B_HEADS, B_KEY_DIM)
    q = q.astype(F32).reshape(ks) * (B_KEY_DIM ** -0.5)
    k = k.astype(F32).reshape(ks)
    log_a = log_a.reshape(ks)
    v = v.astype(F32).reshape(Bsz, T, B_HEADS, B_VAL_DIM)
    o, S = gla_chunked(q, k, v, log_a, S0)
    o = o * lax.rsqrt(jnp.mean(o * o, -1, keepdims=True) + LN_EPS) * norm_w.astype(F32)
    y = o.reshape(Bsz, T, B_VWIDTH).astype(pb.dtype) * jax.nn.silu(rg)
    return y, S.astype(S0.dtype)


def rel_bias_lookup(table, rel):
    idx = jnp.clip(rel, -C_REL_CLIP, C_REL_CLIP) + C_REL_CLIP
    return table.astype(F32)[:, idx]


def band_attention_prompt(q, k, v, rel_table):
    Bsz, H, S, hd = q.shape
    kp = jnp.pad(k, ((0, 0), (0, 0), (C_PAST_ROWS, 0), (0, 0)))
    vp = jnp.pad(v, ((0, 0), (0, 0), (C_PAST_ROWS, 0), (0, 0)))
    i = jnp.arange(CHUNK)
    j = jnp.arange(C_BAND)
    bias = rel_bias_lookup(rel_table, C_PAST_ROWS + i[:, None] - j[None, :])
    scale = hd ** -0.5

    def one_chunk(c):
        qc = lax.dynamic_slice_in_dim(q, c * CHUNK, CHUNK, axis=2)
        kc = lax.dynamic_slice_in_dim(kp, c * CHUNK, C_BAND, axis=2)
        vc = lax.dynamic_slice_in_dim(vp, c * CHUNK, C_BAND, axis=2)
        valid = j >= C_PAST_ROWS - c * CHUNK
        s = jnp.einsum('bhqd,bhkd->bhqk', qc, kc).astype(F32) * scale + bias
        s = jnp.where(valid[None, None, None, :], s, NEG_INF)
        p = jax.nn.softmax(s, axis=-1)
        return jnp.einsum('bhqk,bhkd->bhqd', p.astype(vc.dtype), vc)

    out = lax.map(one_chunk, jnp.arange(S // CHUNK))
    return out.transpose(1, 2, 0, 3, 4).reshape(Bsz, H, S, hd)


def band_attention_sample(q, k_new, v_new, k_cache, v_cache, rel_table):
    R = k_cache.shape[2]
    T = q.shape[2]
    k = jnp.concatenate([k_cache.astype(k_new.dtype), k_new], axis=2)
    v = jnp.concatenate([v_cache.astype(v_new.dtype), v_new], axis=2)
    rel = R + jnp.arange(T)[:, None] - jnp.arange(R + T)[None, :]
    s = jnp.einsum('bhqd,bhkd->bhqk', q, k).astype(F32) * (q.shape[-1] ** -0.5) + rel_bias_lookup(rel_table, rel)
    p = jax.nn.softmax(s, axis=-1)
    return jnp.einsum('bhqk,bhkd->bhqd', p.astype(v.dtype), v)


def chunk_band_attention(x, w_qkv, rel_table, w_o, cache_k, cache_v):
    Bsz, T, _ = x.shape
    qkv = (x @ w_qkv).reshape(Bsz, T, 3, C_HEADS, C_HEAD_DIM)
    q, k, v = (jnp.swapaxes(qkv[:, :, i], 1, 2) for i in range(3))
    if cache_k is None:
        o = band_attention_prompt(q, k, v, rel_table)
        keep = min(C_PAST_ROWS, T)
        k_rows, v_rows = k[:, :, T - keep:], v[:, :, T - keep:]
    else:
        o = band_attention_sample(q, k, v, cache_k, cache_v, rel_table)
        k_rows, v_rows = k, v
    y = jnp.swapaxes(o, 1, 2).reshape(Bsz, T, D_MODEL) @ w_o
    return y, k_rows, v_rows


def run_trunk(x, wkv0, shift0, gla0, cache_k, cache_v, P):
    wkv_o, shift_o, gla_o, k_o, v_o = [], [], [], [], []
    for layer in range(DEPTH):
        if layer % 2 == 0:
            e = layer // 2
            p = x @ P['w_in_mix'][e]
            ya, wkv, sh = rwkv7_time_mix(
                p[..., :A_PROJ], shift0[e], wkv0[e], P['a_mu'][e], P['a_w0'][e], P['a_w2'][e],
                P['a_a0'][e], P['a_a2'][e], P['a_g2'][e], P['a_k_k'][e], P['a_k_a'][e],
                P['a_r_k'][e], P['a_ln_w'][e], P['a_ln_b'][e])
            yb, gs = gla_mix(p[..., A_PROJ:], gla0[e], P['b_alpha_up'][e], P['b_alpha_bias'][e], P['b_norm_w'][e])
            mix = jnp.concatenate([ya, yb], axis=-1) @ P['w_out_mix'][e]
            wkv_o.append(wkv)
            shift_o.append(sh)
            gla_o.append(gs)
        else:
            o = layer // 2
            ck = None if cache_k is None else cache_k[o]
            cv = None if cache_v is None else cache_v[o]
            mix, kr, vr = chunk_band_attention(x, P['c_w_qkv'][o], P['c_rel_bias'][o], P['c_w_o'][o], ck, cv)
            k_o.append(kr)
            v_o.append(vr)
        x = layer_norm(DEEPNORM_ALPHA * x + mix, P['ln1_w'][layer], P['ln1_b'][layer])
        x = layer_norm(DEEPNORM_ALPHA * x + swiglu(x, P['ffn_w_in'][layer], P['ffn_w_out'][layer]),
                       P['ln2_w'][layer], P['ln2_b'][layer])
    return x, jnp.stack(wkv_o), jnp.stack(shift_o), jnp.stack(gla_o), jnp.stack(k_o), jnp.stack(v_o)


def setup_inputs(seed: int = 0) -> dict:
    key = jax.random.key(seed)
    keys = iter(jax.random.split(key, 40))

    def nrm(shape, scale):
        return jax.random.normal(next(keys), shape, F32) * scale

    def uni(shape, lo, hi):
        return jax.random.uniform(next(keys), shape, F32, minval=lo, maxval=hi)

    kv_rows = min(C_PAST_ROWS, PAST_LEN)
    return {
        'x_prompt': nrm((BATCH, SEQ, D_MODEL), 1.0),
        'x_sample': nrm((DEC_BATCH, DEC_SEQ, D_MODEL), 1.0),
        'state_a_wkv': nrm((N_EVEN, DEC_BATCH, A_HEADS, A_HEAD_DIM, A_HEAD_DIM), 0.3),
        'state_a_shift': nrm((N_EVEN, DEC_BATCH, A_PROJ), 1.0),
        'state_b_gla': nrm((N_EVEN, DEC_BATCH, B_HEADS, B_KEY_DIM, B_VAL_DIM), 0.3),
        'cache_c_k': nrm((N_ODD, DEC_BATCH, C_HEADS, kv_rows, C_HEAD_DIM), 1.0),
        'cache_c_v': nrm((N_ODD, DEC_BATCH, C_HEADS, kv_rows, C_HEAD_DIM), 1.0),
        'w_in_mix': nrm((N_EVEN, D_MODEL, MIX_PROJ), D_MODEL ** -0.5),
        'a_mu': uni((N_EVEN, A_PROJ), 0.0, 1.0),
        'a_w0': uni((N_EVEN, A_WIDTH), -6.0, 1.0),
        'a_w2': nrm((N_EVEN, A_DECAY_LORA, A_WIDTH), 0.1 * A_DECAY_LORA ** -0.5),
        'a_a0': nrm((N_EVEN, A_WIDTH), 0.1),
        'a_a2': nrm((N_EVEN, A_ICL_LORA, A_WIDTH), A_ICL_LORA ** -0.5),
        'a_g2': nrm((N_EVEN, A_GATE_LORA, A_WIDTH), A_GATE_LORA ** -0.5),
        'a_k_k': 0.85 + nrm((N_EVEN, A_WIDTH), 0.05),
        'a_k_a': 1.0 + nrm((N_EVEN, A_WIDTH), 0.05),
        'a_r_k': nrm((N_EVEN, A_HEADS, A_HEAD_DIM), 0.1),
        'a_ln_w': 1.0 + nrm((N_EVEN, A_WIDTH), 0.05),
        'a_ln_b': nrm((N_EVEN, A_WIDTH), 0.02),
        'b_alpha_up': nrm((N_EVEN, B_GATE_LORA, B_KWIDTH), B_GATE_LORA ** -0.5),
        'b_alpha_bias': nrm((N_EVEN, B_KWIDTH), 0.1) + 1.0,
        'b_norm_w': 1.0 + nrm((N_EVEN, B_VAL_DIM), 0.05),
        'w_out_mix': nrm((N_EVEN, A_WIDTH + B_VWIDTH, D_MODEL), DEEPNORM_BETA * (A_WIDTH + B_VWIDTH) ** -0.5),
        'c_w_qkv': nrm((N_ODD, D_MODEL, 3 * D_MODEL), D_MODEL ** -0.5),
        'c_rel_bias': nrm((N_ODD, C_HEADS, 2 * C_REL_CLIP + 1), 0.2),
        'c_w_o': nrm((N_ODD, D_MODEL, D_MODEL), DEEPNORM_BETA * D_MODEL ** -0.5),
        'ln1_w': 1.0 + nrm((DEPTH, D_MODEL), 0.05),
        'ln1_b': nrm((DEPTH, D_MODEL), 0.02),
        'ln2_w': 1.0 + nrm((DEPTH, D_MODEL), 0.05),
        'ln2_b': nrm((DEPTH, D_MODEL), 0.02),
        'ffn_w_in': nrm((DEPTH, D_MODEL, 2 * FFN_HIDDEN), D_MODEL ** -0.5),
        'ffn_w_out': nrm((DEPTH, FFN_HIDDEN, D_MODEL), DEEPNORM_BETA * FFN_HIDDEN ** -0.5),
    }


def reference(x_prompt, x_sample, state_a_wkv, state_a_shift, state_b_gla, cache_c_k, cache_c_v,
              w_in_mix, a_mu, a_w0, a_w2, a_a0, a_a2, a_g2, a_k_k, a_k_a, a_r_k, a_ln_w, a_ln_b,
              b_alpha_up, b_alpha_bias, b_norm_w, w_out_mix, c_w_qkv, c_rel_bias, c_w_o,
              ln1_w, ln1_b, ln2_w, ln2_b, ffn_w_in, ffn_w_out):
    P = dict(w_in_mix=w_in_mix, a_mu=a_mu, a_w0=a_w0, a_w2=a_w2, a_a0=a_a0, a_a2=a_a2, a_g2=a_g2,
             a_k_k=a_k_k, a_k_a=a_k_a, a_r_k=a_r_k, a_ln_w=a_ln_w, a_ln_b=a_ln_b,
             b_alpha_up=b_alpha_up, b_alpha_bias=b_alpha_bias, b_norm_w=b_norm_w, w_out_mix=w_out_mix,
             c_w_qkv=c_w_qkv, c_rel_bias=c_rel_bias, c_w_o=c_w_o,
             ln1_w=ln1_w, ln1_b=ln1_b, ln2_w=ln2_w, ln2_b=ln2_b, ffn_w_in=ffn_w_in, ffn_w_out=ffn_w_out)
    bp = x_prompt.shape[0]
    dt = x_prompt.dtype
    wkv_zero = jnp.zeros((N_EVEN, bp, A_HEADS, A_HEAD_DIM, A_HEAD_DIM), dt)
    shift_zero = jnp.zeros((N_EVEN, bp, A_PROJ), dt)
    gla_zero = jnp.zeros((N_EVEN, bp, B_HEADS, B_KEY_DIM, B_VAL_DIM), dt)
    y_prompt, p_wkv, p_shift, p_gla, p_k, p_v = run_trunk(
        x_prompt, wkv_zero, shift_zero, gla_zero, None, None, P)
    y_sample, s_wkv, s_shift, s_gla, s_k, s_v = run_trunk(
        x_sample, state_a_wkv, state_a_shift, state_b_gla, cache_c_k, cache_c_v, P)
    return (y_prompt, y_sample, p_wkv, p_shift, p_gla, p_k, p_v, s_wkv, s_shift, s_gla, s_k, s_v)
```

```cpp
#include <hip/hip_runtime.h>
#include <hip/hip_cooperative_groups.h>
#include <cstdio>
#include <cstdint>
namespace cg = cooperative_groups;
namespace pg8 {
#define PG8_LAS __attribute__((address_space(3)))
typedef unsigned short bf16_t;
typedef short bf16x8 __attribute__((ext_vector_type(8)));
typedef float f32x4 __attribute__((ext_vector_type(4)));
typedef unsigned u32x4 __attribute__((ext_vector_type(4)));
constexpr int BM = 256, BK = 64, HALF = 128, HTB = HALF * BK * 2  , STAGE_BYTES = 8 * HTB, NXCD = 8, WGM = 8;

__host__ __device__ __forceinline__ int lds_byte(int r, int c) { const int st = (r >> 4) * 2 + (c >> 5), rr = r & 15, cc = c & 31, ob = rr * 64 + cc * 2; return st * 1024 + (ob ^ (((ob >> 9) & 1) << 5)); }
__host__ __device__ __forceinline__ void stage_rc(int b, int& R, int& C) { const int st = b / 1024, sb = b % 1024, swz = sb ^ (((sb >> 9) & 1) << 5); R = (st >> 1) * 16 + swz / 64; C = (st & 1) * 32 + (swz % 64) / 2; }
__host__ __device__ __forceinline__ int perm32(int rho) { const int n = rho >> 4, i = rho & 15; return 8 * (i >> 2) + 4 * n + (i & 3); }

struct Unit { int pm, pn, k0, nt, sl, z; };
struct Gemm { const bf16_t* A; const bf16_t* Bt; int M, N, K; const bf16_t* A2; const bf16_t* Bt2; };

struct StaticOrder {
    int nM, nN, nwg, G, c, ntk, lora, nM2, nN2, nwg2;
    __host__ __device__ void init(int M, int N, int G_, int c_, int K_, int lora_ = 0) { nM = M / BM; nN = N / BM; nwg = nM * nN; G = G_; c = c_; ntk = K_ / BK; lora = lora_; nM2 = 0; nN2 = 0; nwg2 = 0; }
    __host__ __device__ void second(int M2, int N2) { nM2 = M2 / BM; nN2 = N2 / BM; nwg2 = nM2 * nN2; }
    __host__ __device__ bool next(int i, Unit& u) const {
        long L = (long)i * G + c; int nM_ = nM, nN_ = nN, nwg_ = nwg, z_ = 0;
        if (L >= nwg) { L -= nwg; if (L >= nwg2) return false; nM_ = nM2; nN_ = nN2; nwg_ = nwg2; z_ = 1; }
        int wgid = (int)L; { const int q = nwg_ / NXCD, r = nwg_ % NXCD, xcd = wgid % NXCD, off = wgid / NXCD; wgid = (xcd < r ? xcd * (q + 1) : r * (q + 1) + (xcd - r) * q) + off; }
        const int nig = WGM * nN_, gid = wgid / nig, fm = gid * WGM, gsz = (nM_ - fm) < WGM ? (nM_ - fm) : WGM;
        u.pm = fm + ((wgid % nig) % gsz); u.pn = (wgid % nig) / gsz; u.k0 = 0; u.nt = ntk; u.sl = -1; u.z = z_; if (lora) { u.k0 = u.pn < 4 ? 0 : 2; u.nt = 2; } return true;
    }
    __device__ __forceinline__ void a_ready(const Unit&) const {}
    __device__ __forceinline__ void done(const Unit&) const {}
};

struct SplitOrder {
    StaticOrder so; int NS, nts, G, c;
    __host__ __device__ void init(int G_, int c_, int K_, int NS_) { so.init(65536, 1024, G_, c_, K_); NS = NS_; nts = (K_ / BK) / NS_; G = G_; c = c_; }
    __host__ __device__ bool next(int i, Unit& u) const {
        if (so.next(i, u)) return true;
        const long L = (long)i * G + c - 1024; if (L < 0 || L >= 16 * NS) return false;
        const int tile = (int)L / NS, sl = (int)L - tile * NS;
        u.pm = 256 + (tile >> 2); u.pn = tile & 3; u.k0 = sl * nts; u.nt = nts; u.sl = sl; u.z = 0; return true;
    }
    __device__ __forceinline__ void a_ready(const Unit&) const {}
    __device__ __forceinline__ void done(const Unit&) const {}
};

__device__ __forceinline__ unsigned cvt_pk_bf16(float lo, float hi) { unsigned r; asm volatile("v_cvt_pk_bf16_f32 %0, %1, %2" : "=v"(r) : "v"(lo), "v"(hi)); return r; }
__device__ __forceinline__ float bf_lo(unsigned w) { return __uint_as_float(w << 16); }
__device__ __forceinline__ float bf_hi(unsigned w) { return __uint_as_float(w & 0xffff0000u); }
struct EpiBf16 {
    static constexpr bool PERM = true, AFTER_DRAIN = false;
    bf16_t* O; int ldc; int split_cols; size_t split_stride; float scale0; bf16_t* O2; int ldc2;
    __device__ __forceinline__ void operator()(const f32x4 (&acc)[2][2][4][2], const Unit& u, int wr, int wc, int fr, int fq) const {
        const int row0 = u.pm * BM + wr * 64 + fr; int colt = u.pn * BM; bf16_t* base = u.z ? O2 : O; const int ldc = u.z ? ldc2 : this->ldc;
        float sc = 1.f; if (split_cols && !u.z) { const int t = colt / split_cols; base += (size_t)t * split_stride; colt -= t * split_cols; if (t == 0) sc = scale0; }
        const int col0 = colt + wc * 32 + 8 * fq;
#pragma unroll
        for (int ai = 0; ai < 2; ++ai)
#pragma unroll
            for (int m = 0; m < 4; ++m) { bf16_t* rowp = base + (size_t)(row0 + ai * HALF + m * 16) * ldc + col0;
#pragma unroll
                for (int bj = 0; bj < 2; ++bj) { const f32x4 v0 = acc[ai][bj][m][0] * sc, v1 = acc[ai][bj][m][1] * sc;
                    u32x4 w; w.x = cvt_pk_bf16(v0[0], v0[1]); w.y = cvt_pk_bf16(v0[2], v0[3]); w.z = cvt_pk_bf16(v1[0], v1[1]); w.w = cvt_pk_bf16(v1[2], v1[3]);
                    *(u32x4*)(rowp + bj * HALF) = w; } }
    }
};
__device__ __forceinline__ float silu_f(float x) { return x * __builtin_amdgcn_rcpf(1.0f + __expf(-x)); }
struct EpiSwiglu {
    static constexpr bool PERM = true, AFTER_DRAIN = false;
    bf16_t* O; int ldc;
    __device__ __forceinline__ void operator()(const f32x4 (&acc)[2][2][4][2], const Unit& u, int wr, int wc, int fr, int fq) const {
        const int row0 = u.pm * BM + wr * 64 + fr; const int col0 = u.pn * HALF + wc * 32 + 8 * fq;
#pragma unroll
        for (int ai = 0; ai < 2; ++ai)
#pragma unroll
            for (int m = 0; m < 4; ++m) { bf16_t* rowp = O + (size_t)(row0 + ai * HALF + m * 16) * ldc + col0;
                const f32x4 g0 = acc[ai][0][m][0], g1 = acc[ai][0][m][1], u0 = acc[ai][1][m][0], u1 = acc[ai][1][m][1];
                u32x4 w;
                w.x = cvt_pk_bf16(silu_f(g0[0]) * u0[0], silu_f(g0[1]) * u0[1]); w.y = cvt_pk_bf16(silu_f(g0[2]) * u0[2], silu_f(g0[3]) * u0[3]);
                w.z = cvt_pk_bf16(silu_f(g1[0]) * u1[0], silu_f(g1[1]) * u1[1]); w.w = cvt_pk_bf16(silu_f(g1[2]) * u1[2], silu_f(g1[3]) * u1[3]);
                *(u32x4*)rowp = w; }
    }
};
struct EpiResid {
    static constexpr bool PERM = true, AFTER_DRAIN = false;
    const bf16_t* X; bf16_t* Z; int ldc; float alpha; float* ZS;
    __device__ __forceinline__ void operator()(const f32x4 (&acc)[2][2][4][2], const Unit& u, int wr, int wc, int fr, int fq) const {
        const int row0 = u.pm * BM + wr * 64 + fr; const int col0 = u.pn * BM + wc * 32 + 8 * fq;
        if (u.sl >= 0) {
            float* zs = ZS + ((size_t)u.sl * 1024 + (row0 - 65536)) * 1024 + col0;
#pragma unroll
            for (int ai = 0; ai < 2; ++ai)
#pragma unroll
                for (int m = 0; m < 4; ++m)
#pragma unroll
                    for (int bj = 0; bj < 2; ++bj) { float* q = zs + (size_t)(ai * HALF + m * 16) * 1024 + bj * HALF; *(f32x4*)q = acc[ai][bj][m][0]; *(f32x4*)(q + 4) = acc[ai][bj][m][1]; }
            return;
        }
#pragma unroll
        for (int ai = 0; ai < 2; ++ai)
#pragma unroll
            for (int m = 0; m < 4; ++m) { const size_t off = (size_t)(row0 + ai * HALF + m * 16) * ldc + col0;
#pragma unroll
                for (int bj = 0; bj < 2; ++bj) { const u32x4 x = *(const u32x4*)(X + off + bj * HALF);
                    const f32x4 v0 = acc[ai][bj][m][0], v1 = acc[ai][bj][m][1];
                    u32x4 w;
                    w.x = cvt_pk_bf16(alpha * bf_lo(x.x) + v0[0], alpha * bf_hi(x.x) + v0[1]); w.y = cvt_pk_bf16(alpha * bf_lo(x.y) + v0[2], alpha * bf_hi(x.y) + v0[3]);
                    w.z = cvt_pk_bf16(alpha * bf_lo(x.z) + v1[0], alpha * bf_hi(x.z) + v1[1]); w.w = cvt_pk_bf16(alpha * bf_lo(x.w) + v1[2], alpha * bf_hi(x.w) + v1[3]);
                    *(u32x4*)(Z + off + bj * HALF) = w; } }
    }
};
template <class Epi, class Sched, bool ALIGN_EPI = false, bool SP2 = false>
__device__ __forceinline__ void gemm_phase(PG8_LAS unsigned char* lds, const Gemm g, const Sched& S, const Epi& E) {
    int tid = threadIdx.x; asm volatile("" : "+v"(tid)); const int wid = __builtin_amdgcn_readfirstlane(tid >> 6), lane = tid & 63, wr = wid >> 2, wc = wid & 3, fr = lane & 15, fq = lane >> 4;
    const int K = g.K;
    unsigned voffA[2], voffB[2];
#pragma unroll
    for (int i = 0; i < 2; ++i) { int R, C; stage_rc(tid * 16 + i * 8192, R, C); const int Rb = Epi::PERM ? ((R & ~31) + perm32(R & 31)) : R;
        voffA[i] = (unsigned)(R * K + C) * 2u; voffB[i] = (unsigned)(Rb * K + C) * 2u; }
    const size_t kstep = (size_t)(BK * 2);
    const size_t hstep = (size_t)HALF * K * 2;
    const size_t tstep = 2 * hstep;
    const unsigned ldsw = (unsigned)wid * 1024u;
    const int aoff = lds_byte(wr * 64 + fr, fq * 8), boff = lds_byte(wc * 32 + fr, fq * 8);
#define PG8_SA(b, h) (((b) * 2 + (h)) * HTB)
#define PG8_SB(b, h) ((4 + (b) * 2 + (h)) * HTB)
#define PG8_STAGE(bufoff, gbase, voff) do { _Pragma("unroll") for (int _i = 0; _i < 2; ++_i) \
        __builtin_amdgcn_global_load_lds((const unsigned*)((const char*)(gbase) + (voff)[_i]), (PG8_LAS unsigned*)(lds + (bufoff) + ldsw + _i * 8192), 16, 0, 0); } while (0)
#define PG8_LDA(dst, b, h) do { _Pragma("unroll") for (int m = 0; m < 4; ++m) _Pragma("unroll") for (int k = 0; k < 2; ++k) dst[m][k] = *(const PG8_LAS bf16x8*)(lds + PG8_SA(b, h) + aoff + m * 2048 + k * 1024); } while (0)
#define PG8_LDB(dst, b, h) do { _Pragma("unroll") for (int n = 0; n < 2; ++n) _Pragma("unroll") for (int k = 0; k < 2; ++k) dst[n][k] = *(const PG8_LAS bf16x8*)(lds + PG8_SB(b, h) + boff + n * 2048 + k * 1024); } while (0)
#define PG8_MMA(ai, bj, At, Bt) do { __builtin_amdgcn_s_setprio(1); _Pragma("unroll") for (int m = 0; m < 4; ++m) _Pragma("unroll") for (int n = 0; n < 2; ++n) _Pragma("unroll") for (int k = 0; k < 2; ++k) \
        acc[ai][bj][m][n] = __builtin_amdgcn_mfma_f32_16x16x32_bf16(Bt[n][k], At[m][k], acc[ai][bj][m][n], 0, 0, 0); __builtin_amdgcn_s_setprio(0); } while (0)
#define PG8_WAIT_V(n) asm volatile("s_waitcnt vmcnt(" #n ")" ::: "memory")
#define PG8_WAIT_L(n) asm volatile("s_waitcnt lgkmcnt(" #n ")" ::: "memory")
#define PG8_BAR __builtin_amdgcn_s_barrier()
#define PG8_SCHED __builtin_amdgcn_sched_barrier(0)
    Unit cur, nxt; int ui = 0;
    if (!S.next(0, cur)) return;
    f32x4 acc[2][2][4][2];
#pragma unroll
    for (int a = 0; a < 2; ++a)
#pragma unroll
        for (int b = 0; b < 2; ++b)
#pragma unroll
            for (int m = 0; m < 4; ++m)
#pragma unroll
                for (int n = 0; n < 2; ++n) acc[a][b][m][n] = (f32x4){0.f, 0.f, 0.f, 0.f};
    bf16x8 At[4][2], B0[2][2], B1[2][2];
    const char* cA = (const char*)(cur.z ? g.A2 : g.A) + (size_t)cur.pm * tstep + (size_t)cur.k0 * kstep; const char* cB = (const char*)(cur.z ? g.Bt2 : g.Bt) + (size_t)cur.pn * tstep + (size_t)cur.k0 * kstep;
    S.a_ready(cur);
    if constexpr (SP2) {
        PG8_STAGE(PG8_SB(0, 0), cB, voffB); PG8_STAGE(PG8_SB(0, 1), cB + hstep, voffB); PG8_STAGE(PG8_SA(0, 0), cA, voffA); PG8_STAGE(PG8_SA(0, 1), cA + hstep, voffA);
        if (wr == 1) PG8_BAR;
        PG8_WAIT_V(2); PG8_BAR;
        PG8_STAGE(PG8_SB(1, 0), cB + kstep, voffB); PG8_STAGE(PG8_SA(1, 0), cA + kstep, voffA); PG8_STAGE(PG8_SB(1, 1), cB + hstep + kstep, voffB);
        PG8_WAIT_V(6); PG8_BAR;
    } else {
        PG8_STAGE(PG8_SB(0, 0), cB, voffB); PG8_STAGE(PG8_SA(0, 0), cA, voffA); PG8_STAGE(PG8_SB(0, 1), cB + hstep, voffB); PG8_STAGE(PG8_SA(0, 1), cA + hstep, voffA);
        if (wr == 1) PG8_BAR;
        PG8_WAIT_V(4); PG8_BAR;
        PG8_STAGE(PG8_SB(1, 0), cB + kstep, voffB); PG8_STAGE(PG8_SA(1, 0), cA + kstep, voffA); PG8_STAGE(PG8_SB(1, 1), cB + hstep + kstep, voffB);
        PG8_WAIT_V(6); PG8_BAR;
    }
    for (;;) {
        const bool has_next = S.next(ui + 1, nxt);
        const char* nA = has_next ? (const char*)(nxt.z ? g.A2 : g.A) + (size_t)nxt.pm * tstep + (size_t)nxt.k0 * kstep : cA; const char* nB = has_next ? (const char*)(nxt.z ? g.Bt2 : g.Bt) + (size_t)nxt.pn * tstep + (size_t)nxt.k0 * kstep : cB;
        const int nt = cur.nt;
        for (int t = 0; t < nt; t += 2) {
            const bool last = (t == nt - 2);
            const char* a1 = cA + (size_t)(t + 1) * kstep;
            const char* a2 = last ? nA : cA + (size_t)(t + 2) * kstep; const char* b2 = last ? nB : cB + (size_t)(t + 2) * kstep;
            const char* a3 = a2 + kstep; const char* b3 = b2 + kstep;
            if (last && has_next) S.a_ready(nxt);
            if constexpr (SP2) {
            PG8_LDB(B0, 0, 0); PG8_LDB(B1, 0, 1); PG8_SCHED; PG8_LDA(At, 0, 0); PG8_STAGE(PG8_SA(1, 1), a1 + hstep, voffA);
            PG8_WAIT_V(8); PG8_WAIT_L(0); PG8_BAR; PG8_MMA(0, 0, At, B0); PG8_MMA(0, 1, At, B1); PG8_BAR; PG8_SCHED;
            PG8_LDA(At, 0, 1); PG8_STAGE(PG8_SB(0, 0), b2, voffB); PG8_STAGE(PG8_SB(0, 1), b2 + hstep, voffB); PG8_STAGE(PG8_SA(0, 0), a2, voffA);
            PG8_WAIT_V(8); PG8_WAIT_L(0); PG8_BAR; PG8_MMA(1, 0, At, B0); PG8_MMA(1, 1, At, B1); PG8_BAR; PG8_SCHED;
            PG8_LDB(B0, 1, 0); PG8_LDB(B1, 1, 1); PG8_SCHED; PG8_LDA(At, 1, 0); PG8_STAGE(PG8_SA(0, 1), a2 + hstep, voffA);
            PG8_WAIT_V(8); PG8_WAIT_L(0); PG8_BAR; PG8_MMA(0, 0, At, B0); PG8_MMA(0, 1, At, B1); PG8_BAR; PG8_SCHED;
            PG8_LDA(At, 1, 1); PG8_STAGE(PG8_SB(1, 0), b3, voffB); PG8_STAGE(PG8_SB(1, 1), b3 + hstep, voffB); PG8_STAGE(PG8_SA(1, 0), a3, voffA);
            PG8_WAIT_V(8); PG8_WAIT_L(0); PG8_BAR; PG8_MMA(1, 0, At, B0); PG8_MMA(1, 1, At, B1); PG8_BAR; PG8_SCHED;
            } else {
            PG8_LDB(B0, 0, 0); PG8_SCHED; PG8_LDA(At, 0, 0); PG8_STAGE(PG8_SA(1, 1), a1 + hstep, voffA);
            PG8_WAIT_L(8); PG8_BAR; PG8_WAIT_L(0); PG8_MMA(0, 0, At, B0); PG8_BAR; PG8_SCHED;
            PG8_LDB(B1, 0, 1); PG8_STAGE(PG8_SB(0, 0), b2, voffB);
            PG8_BAR; PG8_WAIT_L(0); PG8_MMA(0, 1, At, B1); PG8_BAR;
            PG8_LDA(At, 0, 1); PG8_STAGE(PG8_SA(0, 0), a2, voffA);
            PG8_BAR; PG8_WAIT_L(0); PG8_MMA(1, 0, At, B0); PG8_BAR; PG8_SCHED;
            PG8_STAGE(PG8_SB(0, 1), b2 + hstep, voffB);
            PG8_WAIT_V(6); PG8_BAR; PG8_MMA(1, 1, At, B1); PG8_BAR;
            PG8_LDB(B0, 1, 0); PG8_SCHED; PG8_LDA(At, 1, 0); PG8_STAGE(PG8_SA(0, 1), a2 + hstep, voffA);
            PG8_WAIT_L(8); PG8_BAR; PG8_WAIT_L(0); PG8_MMA(0, 0, At, B0); PG8_BAR; PG8_SCHED;
            PG8_LDB(B1, 1, 1); PG8_STAGE(PG8_SB(1, 0), b3, voffB);
            PG8_BAR; PG8_WAIT_L(0); PG8_MMA(0, 1, At, B1); PG8_BAR;
            PG8_LDA(At, 1, 1); PG8_STAGE(PG8_SA(1, 0), a3, voffA);
            PG8_BAR; PG8_WAIT_L(0); PG8_MMA(1, 0, At, B0); PG8_BAR; PG8_SCHED;
            PG8_STAGE(PG8_SB(1, 1), b3 + hstep, voffB);
            PG8_WAIT_V(6); PG8_BAR; PG8_MMA(1, 1, At, B1); PG8_BAR;
            }
        }
        if constexpr (ALIGN_EPI) { if (wr == 0) PG8_BAR; }
        if constexpr (!Epi::AFTER_DRAIN) { E(acc, cur, wr, wc, fr, fq); S.done(cur); }
        if (!has_next) break;
#pragma unroll
        for (int a = 0; a < 2; ++a)
#pragma unroll
            for (int b = 0; b < 2; ++b)
#pragma unroll
                for (int m = 0; m < 4; ++m)
#pragma unroll
                    for (int n = 0; n < 2; ++n) acc[a][b][m][n] = (f32x4){0.f, 0.f, 0.f, 0.f};
        cur = nxt; cA = nA; cB = nB; ++ui;
        if constexpr (ALIGN_EPI) { if (wr == 1) PG8_BAR; }
    }
    PG8_WAIT_V(0);
    if constexpr (!ALIGN_EPI) { if (wr == 0) PG8_BAR; }
    PG8_BAR;
    if constexpr (Epi::AFTER_DRAIN) { E.fused(acc, cur, wr, wc, fr, fq, lds, wid, lane); S.done(cur); }
#undef PG8_SA
#undef PG8_SB
#undef PG8_STAGE
#undef PG8_LDA
#undef PG8_LDB
#undef PG8_MMA
#undef PG8_WAIT_V
#undef PG8_WAIT_L
#undef PG8_BAR
#undef PG8_SCHED
}
}
#define TR_LO 0
#define TR_HI 16


#define LAS __attribute__((address_space(3)))
typedef unsigned short bf16;
typedef unsigned v4u __attribute__((ext_vector_type(4)));
typedef unsigned v2u __attribute__((ext_vector_type(2)));
typedef float f32x4 __attribute__((ext_vector_type(4)));
typedef short bf16x8 __attribute__((ext_vector_type(8)));
using pg8::cvt_pk_bf16; using pg8::bf_lo; using pg8::bf_hi;

constexpr int DM = 1024, MP = 65536, MS = 1024, MT = MP + MS;
constexpr int TPR = 8192, TSM = 64;
constexpr int APROJ = 1792, NMIX = 3584, FH = 2816, NLORA = 1536, KLORA = 256;
constexpr float LN_EPS = 1e-5f, A_NORM_EPS = 64e-5f;
constexpr float DN_ALPHA = 1.681792830507429f;
constexpr int NWAVES = 8, NTHREADS = 512;
constexpr int LDS_BYTES = 132096;

constexpr size_t SZ_X = (size_t)MT * 1024 * 2;
constexpr size_t W_IN = 0, W_IN_SZ = (size_t)NMIX * 1024 * 2;
constexpr size_t W_LO = W_IN + 2 * W_IN_SZ, W_LO_SZ = (size_t)NLORA * KLORA * 2;
constexpr size_t W_OM = W_LO + 2 * W_LO_SZ, W_SQ_SZ = (size_t)1024 * 1024 * 2;
constexpr size_t W_QKV = W_OM + 2 * W_SQ_SZ, W_QKV_SZ = (size_t)3072 * 1024 * 2;
constexpr size_t W_O = W_QKV + 2 * W_QKV_SZ;
constexpr size_t W_FI = W_O + 2 * W_SQ_SZ, W_FI_SZ = (size_t)2 * FH * 1024 * 2;
constexpr size_t W_FO = W_FI + 4 * W_FI_SZ, W_FO_SZ = (size_t)1024 * FH * 2;
constexpr size_t OFF_XB = W_FO + 4 * W_FO_SZ;
constexpr size_t OFF_R1 = OFF_XB + SZ_X;
constexpr size_t OFF_G = OFF_R1 + SZ_X;
constexpr size_t OFF_Z = OFF_G + SZ_X / 2;
constexpr size_t OFF_BIG = OFF_Z + SZ_X;
constexpr size_t WS_END = OFF_BIG + (size_t)MT * NMIX * 2;
constexpr size_t WS_BAR = WS_END, WS_BAR_BYTES = 16384;
static_assert(OFF_XB % 256 == 0 && WS_BAR % 256 == 0 && WS_BAR + WS_BAR_BYTES <= (size_t)1073741824, "ws map");

constexpr size_t O_YP = 0, O_YS = 67108864, O_PWKV = 68157440, O_PSHIFT = 68681728, O_PGLA = 68710400, O_PK = 69234688, O_PV = 77623296,
                 O_SWKV = 86011904, O_SSHIFT = 87060480, O_SGLA = 87117824, O_SK = 88166400, O_SV = 90263552;

__device__ __forceinline__ int tid_opaque() { int t = threadIdx.x; asm volatile("" : "+v"(t)); return t; }
struct Args { const float* in[32]; float* out; unsigned char* ws; int ph_lo, ph_hi; };

__device__ __forceinline__ float wave_sum(float v) {
#pragma unroll
    for (int o = 1; o < 64; o <<= 1) v += __shfl_xor(v, o);
    return v;
}
__device__ __forceinline__ void unpack8(const v4u w, float* f) {
    f[0] = bf_lo(w.x); f[1] = bf_hi(w.x); f[2] = bf_lo(w.y); f[3] = bf_hi(w.y); f[4] = bf_lo(w.z); f[5] = bf_hi(w.z); f[6] = bf_lo(w.w); f[7] = bf_hi(w.w);
}
__device__ __forceinline__ v4u pack8(const float* f) {
    v4u w; w.x = cvt_pk_bf16(f[0], f[1]); w.y = cvt_pk_bf16(f[2], f[3]); w.z = cvt_pk_bf16(f[4], f[5]); w.w = cvt_pk_bf16(f[6], f[7]); return w;
}
__device__ __forceinline__ void load8f(const float* p, float* f) {
    const f32x4 a = *(const f32x4*)p, b = *(const f32x4*)(p + 4);
    f[0] = a.x; f[1] = a.y; f[2] = a.z; f[3] = a.w; f[4] = b.x; f[5] = b.y; f[6] = b.z; f[7] = b.w;
}
__device__ __forceinline__ float softplus_f(float x) { return fmaxf(x, 0.f) + __logf(1.0f + __expf(-fabsf(x))); }
__device__ __forceinline__ float sigmoid_f(float x) { return __builtin_amdgcn_rcpf(1.0f + __expf(-x)); }
#define LDS_WAIT() asm volatile("s_waitcnt lgkmcnt(0)" ::: "memory")

__device__ __forceinline__ int src_col(int mode, int n) {
    if (mode == 0) return n;
    if (mode == 1) {
        if (n < 1792) return n;
        if (n < 2816) { const int h = (n - 1792) >> 8, r = (n - 1792) & 255;
            if (r < 64) return 1792 + h * 64 + r; if (r < 128) return 1792 + 256 + h * 64 + (r - 64); return 1792 + 512 + h * 128 + (r - 128); }
        if (n < 3328) return 1792 + 1040 + (n - 2816);
        if (n < 3344) return 1792 + 1024 + (n - 3328);
        return -1;
    }
    const int pn = n >> 8, jj = n & 255;
    return jj < 128 ? pn * 128 + jj : FH + pn * 128 + (jj - 128);
}
__device__ __forceinline__ void transpose_item(const float* W, int ldw, int mode, bf16* WT, int K, int N, int it, int lane) {
    const int nblk = N / 64;
    const int kb = it / nblk, nb = it - kb * nblk, k0 = 64 * kb, n = 64 * nb + lane;
    const int sc = src_col(mode, n); const float msk = sc >= 0 ? 1.f : 0.f; const int scc = sc >= 0 ? sc : 0;
    const float* wp = W + (size_t)k0 * ldw + scc; bf16* op = WT + (size_t)n * K + k0;
#pragma unroll 4
    for (int k8 = 0; k8 < 8; ++k8) {
        float f[8];
#pragma unroll
        for (int i = 0; i < 8; ++i) f[i] = wp[(size_t)(8 * k8 + i) * ldw] * msk;
        *(v4u*)(op + 8 * k8) = pack8(f);
    }
}
__device__ __forceinline__ void prologue_phase(const Args& a, LAS unsigned char* lds) {
    const int tid = tid_opaque(), lane = tid & 63, wave = tid >> 6;
    const int gw = blockIdx.x * NWAVES + wave, ngw = gridDim.x * NWAVES;
    LAS float* scr = (LAS float*)(lds + wave * 8704);
    unsigned char* ws = a.ws;
    for (int itg = gw; itg < 12800; itg += ngw) {
        int j, base;
        if (itg < 1792) { j = itg / 896; base = j * 896; }
        else if (itg < 2304) { j = 2 + (itg - 1792) / 256; base = 1792 + (j - 2) * 256; }
        else if (itg < 3840) { j = 4 + (itg - 2304) / 768; base = 2304 + (j - 4) * 768; }
        else if (itg < 4352) { j = 6 + (itg - 3840) / 256; base = 3840 + (j - 6) * 256; }
        else if (itg < 9984) { j = 8 + (itg - 4352) / 1408; base = 4352 + (j - 8) * 1408; }
        else { j = 12 + (itg - 9984) / 704; base = 9984 + (j - 12) * 704; }
        const float* W; int ldw, mode, K, N; bf16* WT;
        if (j < 2)       { W = a.in[7] + (size_t)j * 1024 * 3344; ldw = 3344; mode = 1; K = 1024; N = NMIX; WT = (bf16*)(ws + W_IN + j * W_IN_SZ); }
        else if (j < 4)  { const int e = j - 2;  W = a.in[22] + (size_t)e * 1024 * 1024; ldw = 1024; mode = 0; K = 1024; N = 1024; WT = (bf16*)(ws + W_OM + e * W_SQ_SZ); }
        else if (j < 6)  { const int e = j - 4;  W = a.in[23] + (size_t)e * 1024 * 3072; ldw = 3072; mode = 0; K = 1024; N = 3072; WT = (bf16*)(ws + W_QKV + e * W_QKV_SZ); }
        else if (j < 8)  { const int e = j - 6;  W = a.in[25] + (size_t)e * 1024 * 1024; ldw = 1024; mode = 0; K = 1024; N = 1024; WT = (bf16*)(ws + W_O + e * W_SQ_SZ); }
        else if (j < 12) { const int l = j - 8;  W = a.in[30] + (size_t)l * 1024 * 2 * FH; ldw = 2 * FH; mode = 2; K = 1024; N = 2 * FH; WT = (bf16*)(ws + W_FI + l * W_FI_SZ); }
        else             { const int l = j - 12; W = a.in[31] + (size_t)l * FH * 1024; ldw = 1024; mode = 0; K = FH; N = 1024; WT = (bf16*)(ws + W_FO + l * W_FO_SZ); }
        transpose_item(W, ldw, mode, WT, K, N, itg - base, lane);
    }
    const int gt = blockIdx.x * NTHREADS + tid, ngt = gridDim.x * NTHREADS;
#ifndef SKIP_LORA
    for (int idx = gt; idx < 2 * NLORA * 32; idx += ngt) {
        const int e = idx / (NLORA * 32), r = idx - e * (NLORA * 32), n = r >> 5, k0 = (r & 31) * 8;
        float f[8];
#pragma unroll
        for (int i = 0; i < 8; ++i) { const int k = k0 + i; float v = 0.f;
            if (n < 512) { if (k < 64) v = a.in[10][((size_t)e * 64 + k) * 512 + n]; }
            else if (n < 1024) { if (k >= 64 && k < 128) v = a.in[12][((size_t)e * 64 + (k - 64)) * 512 + (n - 512)]; }
            else { if (k >= 128) v = a.in[13][((size_t)e * 128 + (k - 128)) * 512 + (n - 1024)]; }
            f[i] = v; }
        *(v4u*)((bf16*)(ws + W_LO + e * W_LO_SZ) + (size_t)n * KLORA + k0) = pack8(f);
    }
#endif
    bf16* XB = (bf16*)(ws + OFF_XB);
    for (size_t idx = gt; idx < (size_t)MT * 128; idx += ngt) {
        const size_t e0 = idx * 8; const float* src = e0 < (size_t)MP * 1024 ? a.in[0] + e0 : a.in[1] + (e0 - (size_t)MP * 1024);
        float f[8]; load8f(src, f); *(v4u*)(XB + e0) = pack8(f);
    }
}

__device__ __forceinline__ void prep1_phase(const Args& a, int e) {
    const int tid = tid_opaque(), lane = tid & 63, wave = tid >> 6;
    const int gw = blockIdx.x * NWAVES + wave, ngw = gridDim.x * NWAVES;
    const bf16* PA = (const bf16*)(a.ws + OFF_BIG); bf16* L = (bf16*)(a.ws + OFF_Z);
    const float* mu = a.in[8] + (size_t)e * APROJ; const float* shift0 = a.in[3] + (size_t)e * 16 * APROJ;
    const int c = 1536 + 4 * lane;
    const f32x4 mu4 = *(const f32x4*)(mu + c);
    for (int m = gw; m < MT; m += ngw) {
        const v2u pw = *(const v2u*)(PA + (size_t)m * APROJ + c);
        float p[4] = {bf_lo(pw.x), bf_hi(pw.x), bf_lo(pw.y), bf_hi(pw.y)}, q[4];
        const int t = m < MP ? (m & (TPR - 1)) : ((m - MP) & (TSM - 1));
        if (t > 0) { const v2u qw = *(const v2u*)(PA + (size_t)(m - 1) * APROJ + c); q[0] = bf_lo(qw.x); q[1] = bf_hi(qw.x); q[2] = bf_lo(qw.y); q[3] = bf_hi(qw.y); }
        else if (m < MP) { q[0] = q[1] = q[2] = q[3] = 0.f; }
        else { const f32x4 s = *(const f32x4*)(shift0 + (size_t)((m - MP) >> 6) * APROJ + c); q[0] = s.x; q[1] = s.y; q[2] = s.z; q[3] = s.w; }
        float r[4];
#pragma unroll
        for (int i = 0; i < 4; ++i) { const float xs = p[i] + (q[i] - p[i]) * mu4[i]; r[i] = lane < 16 ? tanhf(xs) : (lane < 32 ? xs : sigmoid_f(xs)); }
        v2u o; o.x = cvt_pk_bf16(r[0], r[1]); o.y = cvt_pk_bf16(r[2], r[3]);
        *(v2u*)(L + (size_t)m * KLORA + 4 * lane) = o;
    }
}
__device__ __forceinline__ void prep2_phase(const Args& a, int e) {
    const int tid = tid_opaque(), lane = tid & 63, wave = tid >> 6;
    const int gw = blockIdx.x * NWAVES + wave, ngw = gridDim.x * NWAVES;
    const bf16* PA = (const bf16*)(a.ws + OFF_BIG); bf16* PB = (bf16*)(a.ws + OFF_BIG) + (size_t)MT * APROJ;
    const bf16* Lw = (const bf16*)(a.ws + OFF_R1); const bf16* La = Lw + (size_t)MT * 512;
    bf16* SA = (bf16*)a.out; bf16* SB = (bf16*)(a.ws + OFF_Z);
    const float* mu = a.in[8] + (size_t)e * APROJ; const float* shift0 = a.in[3] + (size_t)e * 16 * APROJ;
    const int c8 = 8 * lane, h = lane >> 3;
    float mur[8], muk[8], muv[8], w0[8], a0[8], kkw[8], kaw[8];
    load8f(mu + c8, mur); load8f(mu + 512 + c8, muk); load8f(mu + 1024 + c8, muv);
    load8f(a.in[9] + (size_t)e * 512 + c8, w0); load8f(a.in[11] + (size_t)e * 512 + c8, a0);
    load8f(a.in[14] + (size_t)e * 512 + c8, kkw); load8f(a.in[15] + (size_t)e * 512 + c8, kaw);
    const float* aup = a.in[19] + (size_t)e * 16 * 256; const f32x4 ab = *(const f32x4*)(a.in[20] + (size_t)e * 256 + 4 * lane);
    for (int m = gw; m < MT; m += ngw) {
        const bf16* pr = PA + (size_t)m * APROJ;
        float r[8], k[8], v[8], pq[8];
        unpack8(*(const v4u*)(pr + c8), r); unpack8(*(const v4u*)(pr + 512 + c8), k); unpack8(*(const v4u*)(pr + 1024 + c8), v);
        const int t = m < MP ? (m & (TPR - 1)) : ((m - MP) & (TSM - 1));
        if (t > 0) {
            unpack8(*(const v4u*)(pr - APROJ + c8), pq);
#pragma unroll
            for (int i = 0; i < 8; ++i) r[i] += (pq[i] - r[i]) * mur[i];
            unpack8(*(const v4u*)(pr - APROJ + 512 + c8), pq);
#pragma unroll
            for (int i = 0; i < 8; ++i) k[i] += (pq[i] - k[i]) * muk[i];
            unpack8(*(const v4u*)(pr - APROJ + 1024 + c8), pq);
#pragma unroll
            for (int i = 0; i < 8; ++i) v[i] += (pq[i] - v[i]) * muv[i];
        } else if (m < MP) {
#pragma unroll
            for (int i = 0; i < 8; ++i) { r[i] -= r[i] * mur[i]; k[i] -= k[i] * muk[i]; v[i] -= v[i] * muv[i]; }
        } else {
            const float* s0 = shift0 + (size_t)((m - MP) >> 6) * APROJ;
            load8f(s0 + c8, pq);
#pragma unroll
            for (int i = 0; i < 8; ++i) r[i] += (pq[i] - r[i]) * mur[i];
            load8f(s0 + 512 + c8, pq);
#pragma unroll
            for (int i = 0; i < 8; ++i) k[i] += (pq[i] - k[i]) * muk[i];
            load8f(s0 + 1024 + c8, pq);
#pragma unroll
            for (int i = 0; i < 8; ++i) v[i] += (pq[i] - v[i]) * muv[i];
        }
        float lw[8], la[8], u[8], av[8], kk[8], km[8], ka[8];
        unpack8(*(const v4u*)(Lw + (size_t)m * 512 + c8), lw); unpack8(*(const v4u*)(La + (size_t)m * 512 + c8), la);
        float ss = 0.f;
#pragma unroll
        for (int i = 0; i < 8; ++i) {
            const float w = -softplus_f(-(w0[i] + lw[i])) - 0.5f;
            u[i] = 1.0f - __expf(-__expf(w));
            av[i] = sigmoid_f(a0[i] + la[i]);
            kk[i] = k[i] * kkw[i]; ss += kk[i] * kk[i];
            km[i] = k[i] * (1.0f + (av[i] - 1.0f) * kaw[i]);
        }
        ss += __shfl_xor(ss, 1); ss += __shfl_xor(ss, 2); ss += __shfl_xor(ss, 4);
        const float rn = rsqrtf(ss + 1e-12f);
#pragma unroll
        for (int i = 0; i < 8; ++i) { kk[i] *= rn; ka[i] = kk[i] * av[i]; }
        bf16* sa = SA + ((size_t)m * 8 + h) * 256 + (lane & 7) * 8; bf16* sb = SB + ((size_t)m * 8 + h) * 128 + (lane & 7) * 8;
        *(v4u*)(sa) = pack8(r); *(v4u*)(sa + 64) = pack8(u); *(v4u*)(sa + 128) = pack8(km); *(v4u*)(sa + 192) = pack8(v);
        *(v4u*)(sb) = pack8(kk); *(v4u*)(sb + 64) = pack8(ka);
        bf16* pb = PB + (size_t)m * APROJ + 1536;
        float xa[16]; unpack8(*(const v4u*)(pb), xa); unpack8(*(const v4u*)(pb + 8), xa + 8);
        f32x4 acc = ab;
#pragma unroll
        for (int i = 0; i < 16; ++i) { const f32x4 wv = *(const f32x4*)(aup + i * 256 + 4 * lane); acc += xa[i] * wv; }
        float ug[4];
#pragma unroll
        for (int i = 0; i < 4; ++i) ug[i] = 1.0f - __expf(-softplus_f(-acc[i]) * (1.0f / 16.0f));
        v2u o; o.x = cvt_pk_bf16(ug[0], ug[1]); o.y = cvt_pk_bf16(ug[2], ug[3]);
        *(v2u*)(pb + 4 * lane) = o;
    }
}
struct PostRaw { v4u o, r, km, v, g, og, rg; };
__device__ __forceinline__ void post_phase(const Args& a, int e) {
    const int tid = tid_opaque(), lane = tid & 63, wave = tid >> 6;
    const int gw = blockIdx.x * NWAVES + wave, ngw = gridDim.x * NWAVES;
    bf16* Y = (bf16*)(a.ws + OFF_R1); const bf16* G = (const bf16*)(a.ws + OFF_G);
    const bf16* PB = (const bf16*)(a.ws + OFF_BIG) + (size_t)MT * APROJ; const bf16* SA = (const bf16*)a.out;
    const int c8 = 8 * lane, h = lane >> 3;
    float lnw[8], lnb[8], rk[8], nw[8];
    load8f(a.in[17] + (size_t)e * 512 + c8, lnw); load8f(a.in[18] + (size_t)e * 512 + c8, lnb); load8f(a.in[16] + (size_t)e * 512 + c8, rk);
    load8f(a.in[21] + (size_t)e * 128 + (lane & 15) * 8, nw);
    for (int mb = gw; mb < MT; mb += 2 * ngw) {
        PostRaw raw[2];
#pragma unroll
        for (int j = 0; j < 2; ++j) { const int m_ = mb + j * ngw; const size_t m = m_ < MT ? m_ : mb;
            const bf16* sa = SA + (m * 8 + h) * 256 + (lane & 7) * 8;
            raw[j].o = *(const v4u*)(Y + m * 1024 + c8); raw[j].r = *(const v4u*)(sa); raw[j].km = *(const v4u*)(sa + 128); raw[j].v = *(const v4u*)(sa + 192);
            raw[j].g = *(const v4u*)(G + m * 512 + c8); raw[j].og = *(const v4u*)(Y + m * 1024 + 512 + c8); raw[j].rg = *(const v4u*)(PB + m * APROJ + 1024 + c8); }
#pragma unroll
        for (int j = 0; j < 2; ++j) {
            const int m = mb + j * ngw;
            float o[8], r[8], km[8], v[8], g[8];
            unpack8(raw[j].o, o); unpack8(raw[j].r, r); unpack8(raw[j].km, km); unpack8(raw[j].v, v); unpack8(raw[j].g, g);
            float s = 0.f, bn = 0.f;
#pragma unroll
            for (int i = 0; i < 8; ++i) { s += o[i]; bn += r[i] * km[i] * rk[i]; }
            s += __shfl_xor(s, 1); s += __shfl_xor(s, 2); s += __shfl_xor(s, 4);
            bn += __shfl_xor(bn, 1); bn += __shfl_xor(bn, 2); bn += __shfl_xor(bn, 4);
            const float mean = s * (1.0f / 64.0f); float q = 0.f;
#pragma unroll
            for (int i = 0; i < 8; ++i) { o[i] -= mean; q += o[i] * o[i]; }
            q += __shfl_xor(q, 1); q += __shfl_xor(q, 2); q += __shfl_xor(q, 4);
            const float rstd = rsqrtf(q * (1.0f / 64.0f) + A_NORM_EPS);
#pragma unroll
            for (int i = 0; i < 8; ++i) o[i] = (o[i] * rstd * lnw[i] + lnb[i] + bn * v[i]) * g[i];
            float og[8], rg[8];
            unpack8(raw[j].og, og); unpack8(raw[j].rg, rg);
            float ms = 0.f;
#pragma unroll
            for (int i = 0; i < 8; ++i) ms += og[i] * og[i];
            ms += __shfl_xor(ms, 1); ms += __shfl_xor(ms, 2); ms += __shfl_xor(ms, 4); ms += __shfl_xor(ms, 8);
            const float rr = rsqrtf(ms * (1.0f / 128.0f) + LN_EPS);
#pragma unroll
            for (int i = 0; i < 8; ++i) og[i] = og[i] * rr * nw[i] * (rg[i] * sigmoid_f(rg[i]));
            if (m < MT) { *(v4u*)(Y + (size_t)m * 1024 + c8) = pack8(o); *(v4u*)(Y + (size_t)m * 1024 + 512 + c8) = pack8(og); }
        }
    }
}
__device__ __forceinline__ void ln_row_out(float* x0, float* x1, const float* w0, const float* w1, const float* b0, const float* b1, bf16* XB, float* fout, int m, int lane) {
    float s = 0.f;
#pragma unroll
    for (int i = 0; i < 8; ++i) s += x0[i] + x1[i];
    const float mean = wave_sum(s) * (1.0f / 1024.0f); float q = 0.f;
#pragma unroll
    for (int i = 0; i < 8; ++i) { x0[i] -= mean; x1[i] -= mean; q += x0[i] * x0[i] + x1[i] * x1[i]; }
    const float rstd = rsqrtf(wave_sum(q) * (1.0f / 1024.0f) + LN_EPS);
#pragma unroll
    for (int i = 0; i < 8; ++i) { x0[i] = x0[i] * rstd * w0[i] + b0[i]; x1[i] = x1[i] * rstd * w1[i] + b1[i]; }
    if (fout) {
        float* fo = fout + (size_t)m * 1024 + 8 * lane;
        *(f32x4*)(fo) = (f32x4){x0[0], x0[1], x0[2], x0[3]}; *(f32x4*)(fo + 4) = (f32x4){x0[4], x0[5], x0[6], x0[7]};
        *(f32x4*)(fo + 512) = (f32x4){x1[0], x1[1], x1[2], x1[3]}; *(f32x4*)(fo + 516) = (f32x4){x1[4], x1[5], x1[6], x1[7]};
    } else {
        *(v4u*)(XB + (size_t)m * 1024 + 8 * lane) = pack8(x0); *(v4u*)(XB + (size_t)m * 1024 + 512 + 8 * lane) = pack8(x1);
    }
}
__device__ __forceinline__ void ln_phase(const Args& a, const float* w, const float* b, float* fout, int ns) {
    const int tid = tid_opaque(), lane = tid & 63, wave = tid >> 6;
    const int gw = blockIdx.x * NWAVES + wave, ngw = gridDim.x * NWAVES;
    const bf16* Z = (const bf16*)(a.ws + OFF_Z); bf16* XB = (bf16*)(a.ws + OFF_XB);
    float w0[8], w1[8], b0[8], b1[8];
    load8f(w + 8 * lane, w0); load8f(w + 512 + 8 * lane, w1); load8f(b + 8 * lane, b0); load8f(b + 512 + 8 * lane, b1);
    for (int mb = gw; mb < MP; mb += 4 * ngw) {
        v4u r0[4], r1[4];
#pragma unroll
        for (int j = 0; j < 4; ++j) { const int m = mb + j * ngw; const int mc = m < MP ? m : mb;
            r0[j] = *(const v4u*)(Z + (size_t)mc * 1024 + 8 * lane); r1[j] = *(const v4u*)(Z + (size_t)mc * 1024 + 512 + 8 * lane); }
#pragma unroll
        for (int j = 0; j < 4; ++j) {
            const int m = mb + j * ngw;
            float x0[8], x1[8];
            unpack8(r0[j], x0); unpack8(r1[j], x1);
            if (m < MP) ln_row_out(x0, x1, w0, w1, b0, b1, XB, fout, m, lane);
        }
    }
#pragma unroll 1
    for (int m = MP + gw; m < MT; m += ngw) {
        float x0[8], x1[8];
        unpack8(*(const v4u*)(XB + (size_t)m * 1024 + 8 * lane), x0); unpack8(*(const v4u*)(XB + (size_t)m * 1024 + 512 + 8 * lane), x1);
#pragma unroll
        for (int i = 0; i < 8; ++i) { x0[i] *= DN_ALPHA; x1[i] *= DN_ALPHA; }
        const float* zs = (const float*)(a.ws + OFF_G) + (size_t)(m - MP) * 1024 + 8 * lane;
#pragma unroll 1
        for (int sl = 0; sl < ns; ++sl) { float t0[8], t1[8]; load8f(zs + (size_t)sl * 1024 * 1024, t0); load8f(zs + (size_t)sl * 1024 * 1024 + 512, t1);
#pragma unroll
            for (int i = 0; i < 8; ++i) { x0[i] += t0[i]; x1[i] += t1[i]; } }
        ln_row_out(x0, x1, w0, w1, b0, b1, XB, fout, m, lane);
    }
}

constexpr int TC = 16;
constexpr int SCW = 384, SCG = 320;
__device__ __forceinline__ void st8(LAS float* d, const v4u w, float sc) {
    *(LAS f32x4*)(d) = (f32x4){bf_lo(w.x) * sc, bf_hi(w.x) * sc, bf_lo(w.y) * sc, bf_hi(w.y) * sc};
    *(LAS f32x4*)(d + 4) = (f32x4){bf_lo(w.z) * sc, bf_hi(w.z) * sc, bf_lo(w.w) * sc, bf_hi(w.w) * sc};
}
typedef float f32x2 __attribute__((ext_vector_type(2)));
#define LO2(v4) (__builtin_shufflevector(v4, v4, 0, 1))
#define HI2(v4) (__builtin_shufflevector(v4, v4, 2, 3))
__device__ __forceinline__ f32x2 fma2(f32x2 a, f32x2 b, f32x2 c) { return __builtin_elementwise_fma(a, b, c); }
__device__ __forceinline__ float rowsum16(float x) {
    x += __builtin_bit_cast(float, __builtin_amdgcn_update_dpp(0, __builtin_bit_cast(int, x), 0x128, 0xf, 0xf, false));
    x += __builtin_bit_cast(float, __builtin_amdgcn_update_dpp(0, __builtin_bit_cast(int, x), 0x124, 0xf, 0xf, false));
    x += __builtin_bit_cast(float, __builtin_amdgcn_update_dpp(0, __builtin_bit_cast(int, x), 0x122, 0xf, 0xf, false));
    x += __builtin_bit_cast(float, __builtin_amdgcn_update_dpp(0, __builtin_bit_cast(int, x), 0x121, 0xf, 0xf, false));
    return x;
}
struct WkvIn { f32x4 r, u, km, kk, ka; float v; };
struct GlaIn { f32x4 q, k, u; float v; };
__device__ __forceinline__ void scan_phase(const Args& a, int e, LAS unsigned char* lds) {
    const int tid = tid_opaque(), lane = tid & 63, wave = tid >> 6;
    const bool isW = wave < 4; const int ltid = tid & 255, lw = wave & 3;
    const int g = lane & 15, rl = lw * 4 + (lane >> 4);
    const bf16* SA = (const bf16*)a.out; const bf16* SB = (const bf16*)(a.ws + OFF_Z);
    const bf16* PB = (const bf16*)(a.ws + OFF_BIG) + (size_t)MT * APROJ;
    bf16* O1 = (bf16*)(a.ws + OFF_R1);
    LAS float* bufW = (LAS float*)lds;
    LAS float* bufG = (LAS float*)(lds + 2 * TC * SCW * 4);
    int ps[3], pp[3];
#pragma unroll
    for (int j = 0; j < 3; ++j) { const int p = ltid + 256 * j; if (isW) { ps[j] = p / 48; pp[j] = p - ps[j] * 48; } else { ps[j] = p / 40; pp[j] = p - ps[j] * 40; } }
    const bool v2ok = isW || (ltid + 512 < 640);
#pragma unroll 1
    for (int it = blockIdx.x; it < 768; it += gridDim.x) {
        const bool samp = it >= 256; const int wi = samp ? it - 256 : it;
        const int b = wi >> 5; const int T = samp ? TSM : TPR; const size_t row0 = samp ? (size_t)MP + b * TSM : (size_t)b * TPR;
        const int nb = samp ? 16 : 8;
        int h, sub;
        if (isW) { h = (wi >> 2) & 7; sub = wi & 3; } else { h = (wi >> 3) & 3; sub = wi & 7; }
        const int vrow = sub * 16 + rl;
        f32x2 P0 = {0.f, 0.f}, P1 = {0.f, 0.f};
        if (samp) {
            if (isW) { const f32x4 S = *(const f32x4*)(a.in[2] + ((((size_t)e * 16 + b) * 8 + h) * 64 + vrow) * 64 + 4 * g); P0 = LO2(S); P1 = HI2(S); }
            else { const float* s0 = a.in[4] + (((size_t)e * 16 + b) * 4 + h) * 8192 + vrow;
                P0 = (f32x2){s0[(4 * g + 0) * 128], s0[(4 * g + 1) * 128]}; P1 = (f32x2){s0[(4 * g + 2) * 128], s0[(4 * g + 3) * 128]}; }
        }
        const int nc = T / TC;
        bf16* obase = isW ? O1 + (row0 + g) * 1024 + h * 64 + vrow : O1 + (row0 + g) * 1024 + 512 + h * 128 + vrow;
        v4u pre[3];
#define SCAN_ISSUE(t0) do { _Pragma("unroll") for (int j = 0; j < 3; ++j) { const size_t row = row0 + (t0) + ps[j]; const bf16* src; \
            if (isW) src = pp[j] < 32 ? SA + (row * 8 + h) * 256 + pp[j] * 8 : SB + (row * 8 + h) * 128 + (pp[j] - 32) * 8; \
            else src = pp[j] < 32 ? PB + row * APROJ + h * 256 + pp[j] * 8 : PB + row * APROJ + 1536 + h * 64 + (pp[j] - 32) * 8; \
            if (j < 2 || v2ok) pre[j] = *(const v4u*)src; } } while (0)
#define SCAN_COMMIT(bi) do { _Pragma("unroll") for (int j = 0; j < 3; ++j) { if (j < 2 || v2ok) { \
            if (isW) st8(bufW + ((bi) * TC + ps[j]) * SCW + pp[j] * 8, pre[j], 1.0f); \
            else st8(bufG + ((bi) * TC + ps[j]) * SCG + pp[j] * 8, pre[j], pp[j] < 8 ? 0.125f : 1.0f); } } } while (0)
        __syncthreads();
        SCAN_ISSUE(0); SCAN_COMMIT(0);
        __syncthreads();
#pragma unroll 1
        for (int c = 0; c < nc; ++c) {
            const int bi = c & 1;
            if (c + 1 < nc) SCAN_ISSUE((c + 1) * TC);
            float oacc = 0.f;
            if (isW) {
                const LAS float* bw = bufW + bi * TC * SCW + 4 * g; const LAS float* bv = bufW + bi * TC * SCW + 192 + vrow;
#define WKV_LOAD(d, s) do { const LAS float* p_ = bw + (s) * SCW; d.r = *(const LAS f32x4*)(p_); d.u = *(const LAS f32x4*)(p_ + 64); d.km = *(const LAS f32x4*)(p_ + 128); \
                    d.kk = *(const LAS f32x4*)(p_ + 256); d.ka = *(const LAS f32x4*)(p_ + 320); d.v = bv[(s) * SCW]; } while (0)
                WkvIn in[3];
                WKV_LOAD(in[0], 0); WKV_LOAD(in[1], 1);
#pragma unroll
                for (int s = 0; s < TC; ++s) {
                    if (s + 2 < TC) WKV_LOAD(in[(s + 2) % 3], s + 2);
                    __builtin_amdgcn_sched_barrier(0);
                    const WkvIn& x = in[s % 3];
                    const f32x2 vv = {x.v, x.v};
                    const f32x2 s2 = fma2(P1, HI2(x.kk), P0 * LO2(x.kk));
                    const f32x2 T0 = fma2(vv, LO2(x.km), fma2(-LO2(x.u), P0, P0)), T1 = fma2(vv, HI2(x.km), fma2(-HI2(x.u), P1, P1));
                    const float sa = rowsum16(s2.x + s2.y);
                    const f32x2 ns = {-sa, -sa};
                    P0 = fma2(ns, LO2(x.ka), T0); P1 = fma2(ns, HI2(x.ka), T1);
                    const f32x2 o2 = fma2(P1, HI2(x.r), P0 * LO2(x.r));
                    const float o = rowsum16(o2.x + o2.y);
                    oacc = (g == s) ? o : oacc;
                }
#undef WKV_LOAD
            } else {
                const LAS float* bg = bufG + bi * TC * SCG + 4 * g; const LAS float* bv = bufG + bi * TC * SCG + 128 + vrow;
#define GLA_LOAD(d, s) do { const LAS float* p_ = bg + (s) * SCG; d.q = *(const LAS f32x4*)(p_); d.k = *(const LAS f32x4*)(p_ + 64); d.u = *(const LAS f32x4*)(p_ + 256); d.v = bv[(s) * SCG]; } while (0)
                GlaIn in[3];
                GLA_LOAD(in[0], 0); GLA_LOAD(in[1], 1);
#pragma unroll
                for (int s = 0; s < TC; ++s) {
                    if (s + 2 < TC) GLA_LOAD(in[(s + 2) % 3], s + 2);
                    __builtin_amdgcn_sched_barrier(0);
                    const GlaIn& x = in[s % 3];
                    const f32x2 vv = {x.v, x.v};
                    P0 = fma2(vv, LO2(x.k), fma2(-LO2(x.u), P0, P0)); P1 = fma2(vv, HI2(x.k), fma2(-HI2(x.u), P1, P1));
                    const f32x2 o2 = fma2(P1, HI2(x.q), P0 * LO2(x.q));
                    const float o = rowsum16(o2.x + o2.y);
                    oacc = (g == s) ? o : oacc;
                }
#undef GLA_LOAD
            }
            obase[(size_t)c * TC * 1024] = (bf16)(cvt_pk_bf16(oacc, 0.f) & 0xffffu);
            if (c + 1 < nc) SCAN_COMMIT(bi ^ 1);
            __syncthreads();
        }
#undef SCAN_ISSUE
#undef SCAN_COMMIT
        if (isW) { float* so = a.out + (samp ? O_SWKV : O_PWKV) + ((((size_t)e * nb + b) * 8 + h) * 64 + vrow) * 64 + 4 * g; *(f32x4*)so = (f32x4){P0.x, P0.y, P1.x, P1.y}; }
        else { float* so = a.out + (samp ? O_SGLA : O_PGLA) + (((size_t)e * nb + b) * 4 + h) * 8192 + vrow;
            so[(4 * g + 0) * 128] = P0.x; so[(4 * g + 1) * 128] = P0.y; so[(4 * g + 2) * 128] = P1.x; so[(4 * g + 3) * 128] = P1.y; }
    }
    const bf16* PA = (const bf16*)(a.ws + OFF_BIG);
    for (int idx = blockIdx.x * NTHREADS + tid; idx < 24 * APROJ; idx += gridDim.x * NTHREADS) {
        const int bb = idx / APROJ, c = idx - bb * APROJ;
        if (bb < 8) a.out[O_PSHIFT + ((size_t)e * 8 + bb) * APROJ + c] = bf_lo((unsigned)PA[((size_t)bb * TPR + TPR - 1) * APROJ + c]);
        else a.out[O_SSHIFT + ((size_t)e * 16 + (bb - 8)) * APROJ + c] = bf_lo((unsigned)PA[((size_t)MP + (bb - 8) * TSM + TSM - 1) * APROJ + c]);
    }
}

constexpr int KEXT = 8192, LDV = MT + KEXT;
constexpr size_t BIG_K = (size_t)MT * 1024, BIG_VT = (size_t)(2 * MT + KEXT) * 1024;
__device__ __forceinline__ bf16x8 ld_frag(const bf16* p) { return __builtin_bit_cast(bf16x8, *(const v4u*)p); }
__device__ __forceinline__ void cache_convert(const Args& a, int o) {
    const int tid = tid_opaque();
    const int gt = blockIdx.x * NTHREADS + tid, ngt = gridDim.x * NTHREADS;
    bf16* Kb = (bf16*)(a.ws + OFF_BIG) + BIG_K; bf16* Vt = (bf16*)(a.ws + OFF_BIG) + BIG_VT;
    const float* ck = a.in[5] + (size_t)o * 16 * 16 * 512 * 64; const float* cv = a.in[6] + (size_t)o * 16 * 16 * 512 * 64;
    for (int idx = gt; idx < 16 * 16 * 512 * 8; idx += ngt) {
        const int d8 = idx & 7, key = (idx >> 3) & 511, h = (idx >> 12) & 15, b = idx >> 16;
        float f[8]; load8f(ck + (size_t)idx * 8, f);
        *(v4u*)(Kb + ((size_t)MT + b * 512 + key) * 1024 + h * 64 + d8 * 8) = pack8(f);
    }
    for (int idx = gt; idx < 16 * 16 * 64 * 64; idx += ngt) {
        const int d = idx & 63, k8 = (idx >> 6) & 63, h = (idx >> 12) & 15, b = idx >> 16;
        const float* src = cv + (((size_t)b * 16 + h) * 512 + k8 * 8) * 64 + d; float f[8];
#pragma unroll
        for (int j = 0; j < 8; ++j) f[j] = src[j * 64];
        *(v4u*)(Vt + (size_t)(h * 64 + d) * LDV + MT + b * 512 + k8 * 8) = pack8(f);
    }
}
__device__ __forceinline__ void attn_phase(const Args& a, int o, LAS unsigned char* lds) {
    const int tid = tid_opaque(), lane = tid & 63, wave = tid >> 6;
    const int gw = blockIdx.x * NWAVES + wave, ngw = gridDim.x * NWAVES;
    const bf16* Q = (const bf16*)(a.ws + OFF_BIG); const bf16* Kb = Q + BIG_K; const bf16* Vt = Q + BIG_VT;
    bf16* O = (bf16*)(a.ws + OFF_R1);
    LAS float* bias = (LAS float*)lds;
    constexpr int KVP = 72;
    LAS bf16* KT = (LAS bf16*)(lds + 16512);
    LAS bf16* VT = KT + 2 * 64 * KVP;
    for (int i = tid; i < 16 * 257; i += NTHREADS) bias[i] = a.in[24][(size_t)o * 16 * 257 + i] * 1.4426950408889634f;
    __syncthreads();
    const int i16 = lane & 15, g = lane >> 4;
    const int keyoff = 8 * (i16 >> 2) + (i16 & 3);
    {
        const int wu = __builtin_amdgcn_readfirstlane(wave);
        const int srow = tid >> 3, sseg = (tid & 7) * 8;
#pragma unroll 1
        for (int unit = blockIdx.x; unit < 4096; unit += gridDim.x) {
            const int b = unit >> 9, h = (unit >> 5) & 15, c0 = (unit & 31) * 4;
            const int c = c0 + (wu >> 1), half = wu & 1;
            const size_t qrow0 = (size_t)b * TPR + c * 64 + half * 32;
            const int qpos0 = c * 64 + half * 32;
            const int kc_lo = c0 >= 8 ? c0 - 8 : 0, kc_hi = c0 + 3, my_lo = c >= 8 ? c - 8 : 0;
            const LAS float* bh = bias + h * 257 + 128;
            const float bfar = bh[128];
            bf16x8 qf[2][2];
#pragma unroll
            for (int qt = 0; qt < 2; ++qt)
#pragma unroll
                for (int kk = 0; kk < 2; ++kk) qf[qt][kk] = ld_frag(Q + (qrow0 + 16 * qt + i16) * 1024 + h * 64 + 32 * kk + 8 * g);
            f32x4 ot[4][2];
#pragma unroll
            for (int dt = 0; dt < 4; ++dt) { ot[dt][0] = (f32x4){0.f, 0.f, 0.f, 0.f}; ot[dt][1] = (f32x4){0.f, 0.f, 0.f, 0.f}; }
            float mrun[2] = {-1e30f, -1e30f}, lrun[2] = {0.f, 0.f};
            const bf16* kg_ = Kb + ((size_t)b * TPR + srow) * 1024 + h * 64 + sseg;
            const bf16* vg_ = Vt + (size_t)(h * 64 + srow) * LDV + (size_t)b * TPR + sseg;
            v4u kreg = *(const v4u*)(kg_ + (size_t)(64 * kc_lo) * 1024), vreg = *(const v4u*)(vg_ + 64 * kc_lo);
            *(LAS v4u*)(KT + srow * KVP + sseg) = kreg; *(LAS v4u*)(VT + srow * KVP + sseg) = vreg;
            __syncthreads();
#pragma unroll 1
            for (int kc = kc_lo; kc <= kc_hi; ++kc) {
                const int buf = (kc - kc_lo) & 1;
                if (kc < kc_hi) { kreg = *(const v4u*)(kg_ + (size_t)(64 * (kc + 1)) * 1024); vreg = *(const v4u*)(vg_ + 64 * (kc + 1)); }
                if (kc >= my_lo && kc <= c) {
                    const int kpos0 = 64 * kc;
                    const LAS bf16* kt = KT + buf * 64 * KVP + keyoff * KVP + 8 * g; const LAS bf16* vt = VT + buf * 64 * KVP + i16 * KVP + 8 * g;
                    f32x4 st[4][2];
#pragma unroll
                    for (int t4 = 0; t4 < 4; ++t4) {
                        const LAS bf16* p = kt + (32 * (t4 >> 1) + 4 * (t4 & 1)) * KVP;
                        const bf16x8 k0 = *(const LAS bf16x8*)p, k1 = *(const LAS bf16x8*)(p + 32);
#pragma unroll
                        for (int qt = 0; qt < 2; ++qt) {
                            f32x4 acc = {0.f, 0.f, 0.f, 0.f};
                            acc = __builtin_amdgcn_mfma_f32_16x16x32_bf16(k0, qf[qt][0], acc, 0, 0, 0);
                            acc = __builtin_amdgcn_mfma_f32_16x16x32_bf16(k1, qf[qt][1], acc, 0, 0, 0);
                            st[t4][qt] = acc;
                        }
                    }
                    const bool far = qpos0 - (kpos0 + 63) >= 128;
                    bf16x8 pf[2][2];
#pragma unroll
                    for (int qt = 0; qt < 2; ++qt) {
                        const int qpos = qpos0 + 16 * qt + i16;
                        float mx = -1e30f;
                        float boff = 0.f;
                        if (far) {
#pragma unroll
                            for (int t4 = 0; t4 < 4; ++t4)
#pragma unroll
                                for (int j = 0; j < 4; ++j) mx = fmaxf(mx, st[t4][qt][j]);
                            mx += bfar; boff = bfar;
                        } else {
#pragma unroll
                            for (int t4 = 0; t4 < 4; ++t4)
#pragma unroll
                                for (int j = 0; j < 4; ++j) {
                                    int rel = qpos - (kpos0 + 32 * (t4 >> 1) + 8 * g + 4 * (t4 & 1) + j); rel = rel > 128 ? 128 : (rel < -128 ? -128 : rel);
                                    const float sv = st[t4][qt][j] + bh[rel]; st[t4][qt][j] = sv; mx = fmaxf(mx, sv);
                                }
                        }
                        mx = fmaxf(mx, __shfl_xor(mx, 16)); mx = fmaxf(mx, __shfl_xor(mx, 32));
                        const float mnew = fmaxf(mrun[qt], mx), corr = __builtin_amdgcn_exp2f(mrun[qt] - mnew), msub = mnew - boff; mrun[qt] = mnew;
                        float psum = 0.f;
#pragma unroll
                        for (int sb = 0; sb < 2; ++sb) {
                            float p[8];
#pragma unroll
                            for (int T = 0; T < 2; ++T)
#pragma unroll
                                for (int j = 0; j < 4; ++j) { p[4 * T + j] = __builtin_amdgcn_exp2f(st[2 * sb + T][qt][j] - msub); psum += p[4 * T + j]; }
                            pf[sb][qt] = __builtin_bit_cast(bf16x8, pack8(p));
                        }
                        lrun[qt] = lrun[qt] * corr + psum;
#pragma unroll
                        for (int dt = 0; dt < 4; ++dt) ot[dt][qt] *= corr;
                    }
#pragma unroll
                    for (int sb = 0; sb < 2; ++sb)
#pragma unroll
                        for (int dt = 0; dt < 4; ++dt) {
                            const bf16x8 vf = *(const LAS bf16x8*)(vt + 16 * dt * KVP + 32 * sb);
#pragma unroll
                            for (int qt = 0; qt < 2; ++qt) ot[dt][qt] = __builtin_amdgcn_mfma_f32_16x16x32_bf16(vf, pf[sb][qt], ot[dt][qt], 0, 0, 0);
                        }
                }
                if (kc < kc_hi) { *(LAS v4u*)(KT + (buf ^ 1) * 64 * KVP + srow * KVP + sseg) = kreg; *(LAS v4u*)(VT + (buf ^ 1) * 64 * KVP + srow * KVP + sseg) = vreg; }
                __syncthreads();
            }
#pragma unroll
            for (int qt = 0; qt < 2; ++qt) {
                float l = lrun[qt]; l += __shfl_xor(l, 16); l += __shfl_xor(l, 32);
                const float inv = 1.0f / l;
                bf16* op = O + (qrow0 + 16 * qt + i16) * 1024 + h * 64 + 4 * g;
#pragma unroll
                for (int dt = 0; dt < 4; ++dt) { const f32x4 v = ot[dt][qt] * inv; v2u w; w.x = cvt_pk_bf16(v[0], v[1]); w.y = cvt_pk_bf16(v[2], v[3]); *(v2u*)(op + 16 * dt) = w; }
            }
        }
    }
#pragma unroll 1
    for (int it = 32768 + gw; it < 32768 + 512; it += ngw) {
        const bool samp = it >= 32768;
        int b, c, h, half;
        if (!samp) { b = it >> 12; c = (it >> 5) & 127; h = (it >> 1) & 15; half = it & 1; }
        else { const int r = it - 32768; b = r >> 5; c = 8; h = (r >> 1) & 15; half = r & 1; }
        const size_t qrow0 = samp ? (size_t)MP + b * 64 + half * 32 : (size_t)b * TPR + c * 64 + half * 32;
        const int qpos0 = c * 64 + half * 32;
        const int kstart = c >= 8 ? c * 64 - 512 : 0, nkb = (c * 64 + 64 - kstart) >> 6;
        const size_t kbase = samp ? (size_t)MT + b * 512 : (size_t)b * TPR + kstart;
        const size_t knew = (size_t)MP + b * 64;
        const LAS float* bh = bias + h * 257 + 128;
        const float bfar = bh[128];
        bf16x8 qf[2][2];
#pragma unroll
        for (int qt = 0; qt < 2; ++qt)
#pragma unroll
            for (int kk = 0; kk < 2; ++kk) qf[qt][kk] = ld_frag(Q + (qrow0 + 16 * qt + i16) * 1024 + h * 64 + 32 * kk + 8 * g);
        f32x4 ot[4][2];
#pragma unroll
        for (int dt = 0; dt < 4; ++dt) { ot[dt][0] = (f32x4){0.f, 0.f, 0.f, 0.f}; ot[dt][1] = (f32x4){0.f, 0.f, 0.f, 0.f}; }
        float mrun[2] = {-1e30f, -1e30f}, lrun[2] = {0.f, 0.f};
        bf16x8 kc[4][2], kn[4][2];
        {   const bf16* kp = Kb + (kbase + keyoff) * 1024 + h * 64 + 8 * g;
#pragma unroll
            for (int t4 = 0; t4 < 4; ++t4) { const bf16* p = kp + (size_t)(32 * (t4 >> 1) + 4 * (t4 & 1)) * 1024; kc[t4][0] = ld_frag(p); kc[t4][1] = ld_frag(p + 32); } }
#pragma unroll 1
        for (int kb = 0; kb < nkb; ++kb) {
            const int kpos0 = kstart + 64 * kb;
            const size_t krow0 = (samp && kb == 8) ? knew : kbase + 64 * kb;
            bf16x8 vf[2][4];
            {   const bf16* vp = Vt + (size_t)(h * 64 + i16) * LDV + krow0 + 8 * g;
#pragma unroll
                for (int sb = 0; sb < 2; ++sb)
#pragma unroll
                    for (int dt = 0; dt < 4; ++dt) vf[sb][dt] = ld_frag(vp + (size_t)(16 * dt) * LDV + 32 * sb); }
            if (kb + 1 < nkb) {
                const size_t krow1 = (samp && kb + 1 == 8) ? knew : kbase + 64 * (kb + 1);
                const bf16* kp = Kb + (krow1 + keyoff) * 1024 + h * 64 + 8 * g;
#pragma unroll
                for (int t4 = 0; t4 < 4; ++t4) { const bf16* p = kp + (size_t)(32 * (t4 >> 1) + 4 * (t4 & 1)) * 1024; kn[t4][0] = ld_frag(p); kn[t4][1] = ld_frag(p + 32); }
            }
            f32x4 st[4][2];
#pragma unroll
            for (int t4 = 0; t4 < 4; ++t4)
#pragma unroll
                for (int qt = 0; qt < 2; ++qt) {
                    f32x4 acc = {0.f, 0.f, 0.f, 0.f};
                    acc = __builtin_amdgcn_mfma_f32_16x16x32_bf16(kc[t4][0], qf[qt][0], acc, 0, 0, 0);
                    acc = __builtin_amdgcn_mfma_f32_16x16x32_bf16(kc[t4][1], qf[qt][1], acc, 0, 0, 0);
                    st[t4][qt] = acc;
                }
            const bool far = qpos0 - (kpos0 + 63) >= 128;
            bf16x8 pf[2][2];
#pragma unroll
            for (int qt = 0; qt < 2; ++qt) {
                const int qpos = qpos0 + 16 * qt + i16;
                float mx = -1e30f;
                float boff = 0.f;
                if (far) {
#pragma unroll
                    for (int t4 = 0; t4 < 4; ++t4)
#pragma unroll
                        for (int j = 0; j < 4; ++j) mx = fmaxf(mx, st[t4][qt][j]);
                    mx += bfar; boff = bfar;
                } else {
#pragma unroll
                    for (int t4 = 0; t4 < 4; ++t4)
#pragma unroll
                        for (int j = 0; j < 4; ++j) {
                            int rel = qpos - (kpos0 + 32 * (t4 >> 1) + 8 * g + 4 * (t4 & 1) + j); rel = rel > 128 ? 128 : (rel < -128 ? -128 : rel);
                            const float s = st[t4][qt][j] + bh[rel]; st[t4][qt][j] = s; mx = fmaxf(mx, s);
                        }
                }
                mx = fmaxf(mx, __shfl_xor(mx, 16)); mx = fmaxf(mx, __shfl_xor(mx, 32));
                const float mnew = fmaxf(mrun[qt], mx), corr = __builtin_amdgcn_exp2f(mrun[qt] - mnew), msub = mnew - boff; mrun[qt] = mnew;
                float psum = 0.f;
#pragma unroll
                for (int sb = 0; sb < 2; ++sb) {
                    float p[8];
#pragma unroll
                    for (int T = 0; T < 2; ++T)
#pragma unroll
                        for (int j = 0; j < 4; ++j) { p[4 * T + j] = __builtin_amdgcn_exp2f(st[2 * sb + T][qt][j] - msub); psum += p[4 * T + j]; }
                    pf[sb][qt] = __builtin_bit_cast(bf16x8, pack8(p));
                }
                lrun[qt] = lrun[qt] * corr + psum;
#pragma unroll
                for (int dt = 0; dt < 4; ++dt) ot[dt][qt] *= corr;
            }
#pragma unroll
            for (int sb = 0; sb < 2; ++sb)
#pragma unroll
                for (int dt = 0; dt < 4; ++dt)
#pragma unroll
                    for (int qt = 0; qt < 2; ++qt) ot[dt][qt] = __builtin_amdgcn_mfma_f32_16x16x32_bf16(vf[sb][dt], pf[sb][qt], ot[dt][qt], 0, 0, 0);
#pragma unroll
            for (int t4 = 0; t4 < 4; ++t4) { kc[t4][0] = kn[t4][0]; kc[t4][1] = kn[t4][1]; }
        }
#pragma unroll
        for (int qt = 0; qt < 2; ++qt) {
            float l = lrun[qt]; l += __shfl_xor(l, 16); l += __shfl_xor(l, 32);
            const float inv = 1.0f / l;
            bf16* op = O + (qrow0 + 16 * qt + i16) * 1024 + h * 64 + 4 * g;
#pragma unroll
            for (int dt = 0; dt < 4; ++dt) { const f32x4 v = ot[dt][qt] * inv; v2u w; w.x = cvt_pk_bf16(v[0], v[1]); w.y = cvt_pk_bf16(v[2], v[3]); *(v2u*)(op + 16 * dt) = w; }
        }
    }
    const int gt = blockIdx.x * NTHREADS + tid, ngt = gridDim.x * NTHREADS;
    for (int idx = gt; idx < 8 * 16 * 512 * 8; idx += ngt) {
        const int d8 = idx & 7, r = (idx >> 3) & 511, h = (idx >> 12) & 15, b = idx >> 16;
        float f[8]; unpack8(*(const v4u*)(Kb + ((size_t)b * TPR + 7680 + r) * 1024 + h * 64 + d8 * 8), f);
        float* dst = a.out + O_PK + ((((size_t)o * 8 + b) * 16 + h) * 512 + r) * 64 + d8 * 8;
        *(f32x4*)dst = (f32x4){f[0], f[1], f[2], f[3]}; *(f32x4*)(dst + 4) = (f32x4){f[4], f[5], f[6], f[7]};
    }
    for (int idx = gt; idx < 8 * 16 * 64 * 64; idx += ngt) {
        const int r8 = idx & 63, d = (idx >> 6) & 63, h = (idx >> 12) & 15, b = idx >> 16;
        float f[8]; unpack8(*(const v4u*)(Vt + (size_t)(h * 64 + d) * LDV + (size_t)b * TPR + 7680 + r8 * 8), f);
        float* dst = a.out + O_PV + ((((size_t)o * 8 + b) * 16 + h) * 512 + r8 * 8) * 64 + d;
#pragma unroll
        for (int j = 0; j < 8; ++j) dst[j * 64] = f[j];
    }
    for (int idx = gt; idx < 16 * 16 * 64 * 8; idx += ngt) {
        const int d8 = idx & 7, t = (idx >> 3) & 63, h = (idx >> 9) & 15, b = idx >> 13;
        float f[8]; unpack8(*(const v4u*)(Kb + ((size_t)MP + b * 64 + t) * 1024 + h * 64 + d8 * 8), f);
        float* dst = a.out + O_SK + ((((size_t)o * 16 + b) * 16 + h) * 64 + t) * 64 + d8 * 8;
        *(f32x4*)dst = (f32x4){f[0], f[1], f[2], f[3]}; *(f32x4*)(dst + 4) = (f32x4){f[4], f[5], f[6], f[7]};
    }
    for (int idx = gt; idx < 16 * 16 * 64 * 8; idx += ngt) {
        const int t8 = idx & 7, d = (idx >> 3) & 63, h = (idx >> 9) & 15, b = idx >> 13;
        float f[8]; unpack8(*(const v4u*)(Vt + (size_t)(h * 64 + d) * LDV + (size_t)MP + b * 64 + t8 * 8), f);
        float* dst = a.out + O_SV + ((((size_t)o * 16 + b) * 16 + h) * 64 + t8 * 8) * 64 + d;
#pragma unroll
        for (int j = 0; j < 8; ++j) dst[j * 64] = f[j];
    }
}

#define XB_TMO      128
#define XB_XCNT(j)  (256  + 64 * (j))
#define XB_XSUB(j)  (1280 + 64 * (j))
#define XB_XGEN(j)  (2304 + 64 * (j))
#define XB_TOP      3328
#define XB_TOPGEN   3392
#define XCD_BAR_WORDS 3456
#define XB_SPIN_CAP (1u << 18)

__device__ __forceinline__ unsigned xb_ld(unsigned* p)              { return __hip_atomic_load(p, __ATOMIC_RELAXED, __HIP_MEMORY_SCOPE_AGENT); }
__device__ __forceinline__ unsigned xb_add(unsigned* p, unsigned v) { return __hip_atomic_fetch_add(p, v, __ATOMIC_RELAXED, __HIP_MEMORY_SCOPE_AGENT); }
__device__ __forceinline__ unsigned xb_xcc_id() { return (unsigned)__builtin_amdgcn_s_getreg((3 << 11) | 20) & 0xFu; }
#define XB_SPIN(cond, bar) do { unsigned _sp = 0; while (cond) { __builtin_amdgcn_s_sleep(1); \
    if ((++_sp & 255u) == 0u) { if (xb_ld(&(bar)[XB_TMO])) break; if (_sp > XB_SPIN_CAP) { atomicAdd(&(bar)[XB_TMO], 1u); break; } } } } while (0)

struct XcdBarrier {
    unsigned* bar; unsigned x;
    volatile LAS unsigned* st;
};

__device__ __forceinline__ XcdBarrier xcd_barrier_post(unsigned* bar, volatile LAS unsigned* st) {
    XcdBarrier b; b.bar = bar; b.x = xb_xcc_id(); b.st = st;
    if (threadIdx.x == 0) (void)xb_add(&bar[XB_XCNT(b.x)], 1u);
    return b;
}
__device__ __forceinline__ void xcd_barrier_complete(unsigned* bar, unsigned x, unsigned& nloc, unsigned& nx) {
    const unsigned G = gridDim.x * gridDim.y * gridDim.z;
    unsigned sum, cnt, mine, sp = 0u;
    for (;;) {
        sum = 0u; cnt = 0u; mine = 0u;
#pragma unroll
        for (unsigned j = 0; j < 16; ++j) { const unsigned c = xb_ld(&bar[XB_XCNT(j)]); sum += c; cnt += (c > 0u) ? 1u : 0u; mine = (j == x) ? c : mine; }
        if (sum == G) break;
        __builtin_amdgcn_s_sleep(1);
        if ((++sp & 255u) == 0u) { if (xb_ld(&bar[XB_TMO])) break; if (sp > XB_SPIN_CAP) { atomicAdd(&bar[XB_TMO], 1u); break; } }
    }
    nloc = mine > 0u ? mine : 1u; nx = cnt > 0u ? cnt : 1u;
}

__device__ __forceinline__ void xcd_barrier(const XcdBarrier& b) {
    asm volatile("s_waitcnt vmcnt(0)" ::: "memory");
    __syncthreads();
    if (threadIdx.x == 0) {
        unsigned* bar = b.bar;
        __builtin_amdgcn_s_waitcnt(0);
        unsigned nloc = b.st[0], nx = b.st[1];
        if (nloc == 0u) { xcd_barrier_complete(bar, b.x, nloc, nx); b.st[0] = nloc; b.st[1] = nx; }
        const unsigned old = xb_add(&bar[XB_XSUB(b.x)], 1u);
        const unsigned gen = old / nloc;
        if (old + 1u == (gen + 1u) * nloc) {
            __builtin_amdgcn_fence(__ATOMIC_RELEASE, "agent");
            asm volatile("s_waitcnt vmcnt(0)" ::: "memory");
            const unsigned og = xb_add(&bar[XB_TOP], 1u);
            const unsigned tg = og / nx;
            if (og + 1u == (tg + 1u) * nx) xb_add(&bar[XB_TOPGEN], 1u);
            else XB_SPIN(xb_ld(&bar[XB_TOPGEN]) == tg, bar);
            __builtin_amdgcn_fence(__ATOMIC_ACQUIRE, "agent");
            xb_add(&bar[XB_XGEN(b.x)], 1u);
            asm volatile("s_waitcnt vmcnt(0)" ::: "memory");
        } else {
            XB_SPIN(xb_ld(&bar[XB_XGEN(b.x)]) == gen, bar);
            __builtin_amdgcn_fence(__ATOMIC_ACQUIRE, "agent");
            asm volatile("s_waitcnt vmcnt(0)" ::: "memory");
        }
    }
    __syncthreads();
}

#ifndef REP_GEMM
#define REP_GEMM 1
#endif
#ifndef REP_SCAN
#define REP_SCAN 1
#endif
#ifndef REP_ATTN
#define REP_ATTN 1
#endif
#ifndef REP_LN
#define REP_LN 1
#endif
#ifndef EXTRA_SYNC
#define EXTRA_SYNC 2
#endif
#ifndef PH_STOP
#define PH_STOP N_PHASES
#endif
#ifndef PHMASK
#define PHMASK 0xffff
#endif
#define PHM(i) (((PHMASK) >> (i)) & 1)
constexpr int NS_K1 = 4, NS_K2 = 11;
constexpr int PH_PER_PAIR = 19, N_PHASES = 1 + 2 * PH_PER_PAIR;
__global__ void __launch_bounds__(NTHREADS, 2) trunk_fwd(Args a) {
    __shared__ __attribute__((aligned(16))) unsigned char lds_raw[LDS_BYTES];
    LAS unsigned char* lds = (LAS unsigned char*)lds_raw;
    cg::grid_group grid = cg::this_grid();
    volatile LAS unsigned* bar_st = (volatile LAS unsigned*)(lds + 131072);
    if (threadIdx.x < 2) bar_st[threadIdx.x] = 0u;
    __syncthreads();
    XcdBarrier xbar = xcd_barrier_post((unsigned*)(a.ws + WS_BAR), bar_st);
    unsigned char* ws = a.ws;
    bf16* XB = (bf16*)(ws + OFF_XB); bf16* R1 = (bf16*)(ws + OFF_R1); bf16* Z = (bf16*)(ws + OFF_Z); bf16* BIG = (bf16*)(ws + OFF_BIG);
    const int G = gridDim.x, cb = blockIdx.x;
#pragma unroll 1
    for (int ph = a.ph_lo; ph < a.ph_hi; ++ph) {
        bool nosync = false;
        if (ph == 0) { if (PHM(0)) prologue_phase(a, lds); }
        else {
            const int e = (ph - 1) / PH_PER_PAIR, q = (ph - 1) - e * PH_PER_PAIR;
            const int layer = 2 * e + (q >= 11 ? 1 : 0);
            int kind = -1; pg8::Gemm g{nullptr, nullptr, MT, 0, 0, nullptr, nullptr};
            pg8::EpiBf16 eb{nullptr, 0, 0, 0, 1.f, nullptr, 0}; int m2 = 0, n2 = 0;
            switch (q) {
            case 0:  kind = 0; g = pg8::Gemm{XB, (const bf16*)(ws + W_IN + e * W_IN_SZ), MT, NMIX, 1024, nullptr, nullptr}; eb = pg8::EpiBf16{BIG, APROJ, APROJ, (size_t)MT * APROJ, 1.f, nullptr, 0}; break;
            case 2:  kind = 0; g = pg8::Gemm{Z, (const bf16*)(ws + W_LO + e * W_LO_SZ), MT, NLORA, KLORA, nullptr, nullptr}; eb = pg8::EpiBf16{R1, 512, 512, (size_t)MT * 512, 1.f, nullptr, 0}; break;
            case 11: kind = 0; g = pg8::Gemm{XB, (const bf16*)(ws + W_QKV + e * W_QKV_SZ), MT, 2048, 1024, (const bf16*)(ws + W_QKV + e * W_QKV_SZ) + (size_t)2048 * 1024, XB};
                     eb = pg8::EpiBf16{BIG, 1024, 1024, (size_t)MT * 1024, 0.125f * 1.4426950408889634f, BIG + BIG_VT, LDV}; m2 = 1024; n2 = MT; break;
            case 12: nosync = true; break;
            case 8: case 16: kind = 1; g = pg8::Gemm{XB, (const bf16*)(ws + W_FI + layer * W_FI_SZ), MT, 2 * FH, 1024, nullptr, nullptr}; break;
            case 6:  kind = 2; g = pg8::Gemm{R1, (const bf16*)(ws + W_OM + e * W_SQ_SZ), MT, 1024, 1024, nullptr, nullptr}; break;
            case 14: kind = 2; g = pg8::Gemm{R1, (const bf16*)(ws + W_O + e * W_SQ_SZ), MT, 1024, 1024, nullptr, nullptr}; break;
            case 9: case 17: kind = 2; g = pg8::Gemm{BIG, (const bf16*)(ws + W_FO + layer * W_FO_SZ), MT, 1024, FH, nullptr, nullptr}; break;
            default: break;
            }
            const int nrep = kind >= 0 ? REP_GEMM : (q == 4 ? REP_SCAN : (q == 13 ? REP_ATTN : ((q == 7 || q == 15 || q == 10 || q == 18) ? REP_LN : 1)));
            if (q == 11) cache_convert(a, e);
#pragma unroll 1
            for (int rep = 0; rep < nrep; ++rep) {
            if (kind == 0 && PHM(1)) { pg8::StaticOrder S; S.init(g.M, g.N, G, cb, g.K, q == 2 ? 1 : 0); if (m2) S.second(m2, n2); pg8::gemm_phase<pg8::EpiBf16, pg8::StaticOrder, true, true>(lds, g, S, eb); }
            else if (kind == 1 && PHM(2)) { pg8::StaticOrder S; S.init(g.M, g.N, G, cb, g.K); pg8::EpiSwiglu es{BIG, FH}; pg8::gemm_phase<pg8::EpiSwiglu, pg8::StaticOrder, true, true>(lds, g, S, es); }
            else if (kind == 2 && PHM(3)) { pg8::SplitOrder S; S.init(G, cb, g.K, g.K == 1024 ? NS_K1 : NS_K2); pg8::EpiResid er{XB, Z, 1024, DN_ALPHA, (float*)(ws + OFF_G)}; pg8::gemm_phase<pg8::EpiResid, pg8::SplitOrder, true, true>(lds, g, S, er); }
            else if (q == 1 && PHM(4)) prep1_phase(a, e);
            else if (q == 3 && PHM(5)) prep2_phase(a, e);
            else if (q == 4 && PHM(6)) scan_phase(a, e, lds);
            else if (q == 5 && PHM(7)) post_phase(a, e);
            else if (q == 13 && PHM(8)) attn_phase(a, e, lds);
            else if ((q == 7 || q == 15) && PHM(9)) ln_phase(a, a.in[26] + (size_t)layer * 1024, a.in[27] + (size_t)layer * 1024, nullptr, NS_K1);
            else if ((q == 10 || q == 18) && PHM(9)) ln_phase(a, a.in[28] + (size_t)layer * 1024, a.in[29] + (size_t)layer * 1024, (layer == 3) ? a.out : nullptr, NS_K2);
        }
        }
        if (ph + 1 < a.ph_hi && !nosync) { if (ph == 0) grid.sync(); else xcd_barrier(xbar); }
        else __syncthreads();
    }
}

extern "C" void kernel_launch(void* const* d_in, const int* in_sizes, int n_in, void* d_out, int out_size, void* d_ws, size_t ws_size, hipStream_t stream) {
    static int grid = 0; static int badsz = 0;
    if (grid == 0) {
        if (n_in != 32 || ws_size < WS_BAR + WS_BAR_BYTES || out_size != 92360704) { fprintf(stderr, "kernel_launch: unexpected shapes (n_in %d, ws %zu, out %d)\n", n_in, ws_size, out_size); grid = -1; return; }
        static const long long exp_sz[32] = {67108864LL, 1048576, 1048576, 57344, 1048576, 16777216, 16777216, 6848512, 3584, 1024, 65536, 1024, 65536, 131072, 1024, 1024, 1024, 1024, 1024, 8192, 512, 256, 2097152, 6291456, 8224, 2097152, 4096, 4096, 4096, 4096, 23068672, 11534336};
        for (int i = 0; i < 32; ++i) if ((long long)in_sizes[i] != exp_sz[i]) { fprintf(stderr, "kernel_launch: input %d has %d elements, expected %lld\n", i, in_sizes[i], exp_sz[i]); badsz = 1; }
        int dev = 0, cus = 0, per_cu = 0;
        hipGetDevice(&dev); hipDeviceGetAttribute(&cus, hipDeviceAttributeMultiprocessorCount, dev);
        if (hipOccupancyMaxActiveBlocksPerMultiprocessor(&per_cu, (const void*)trunk_fwd, NTHREADS, 0) != hipSuccess || per_cu < 1) { fprintf(stderr, "kernel_launch: occupancy query says %d\n", per_cu); per_cu = 1; }
        (void)hipGetLastError();
        grid = cus * per_cu;
    }
    if (grid < 0) return;
    Args a{};
    for (int i = 0; i < 32; ++i) a.in[i] = (const float*)d_in[i];
    a.out = (float*)d_out; a.ws = (unsigned char*)d_ws;
#if defined(MK_PER_PHASE)
    for (int p = 0; p < N_PHASES; ++p) { a.ph_lo = p; a.ph_hi = p + 1; hipLaunchKernelGGL(trunk_fwd, dim3(grid), dim3(NTHREADS), 0, stream, a); }
#else
    a.ph_lo = 0; a.ph_hi = badsz ? 0 : PH_STOP;
    if (hipMemsetAsync((char*)d_ws + WS_BAR, 0, WS_BAR_BYTES, stream) != hipSuccess) { fprintf(stderr, "kernel_launch: memset of the barrier words failed\n"); return; }
    void* args[] = {&a};
    hipError_t err = hipLaunchCooperativeKernel((const void*)trunk_fwd, dim3(grid), dim3(NTHREADS), args, 0, stream);
    if (err != hipSuccess) fprintf(stderr, "kernel_launch: cooperative launch failed: %s (grid %d)\n", hipGetErrorString(err), grid);
#endif
}
```

```cpp
#include <hip/hip_runtime.h>
#include <hip/hip_cooperative_groups.h>
#include <cstdio>
#include <cstdint>
namespace cg = cooperative_groups;
namespace pg8 {
#define PG8_LAS __attribute__((address_space(3)))
typedef unsigned short bf16_t;
typedef short bf16x8 __attribute__((ext_vector_type(8)));
typedef float f32x4 __attribute__((ext_vector_type(4)));
typedef unsigned u32x4 __attribute__((ext_vector_type(4)));
constexpr int BM = 256, BK = 64, HALF = 128, HTB = HALF * BK * 2  , STAGE_BYTES = 8 * HTB, NXCD = 8, WGM = 8;

__host__ __device__ __forceinline__ int lds_byte(int r, int c) { const int st = (r >> 4) * 2 + (c >> 5), rr = r & 15, cc = c & 31, ob = rr * 64 + cc * 2; return st * 1024 + (ob ^ (((ob >> 9) & 1) << 5)); }
__host__ __device__ __forceinline__ void stage_rc(int b, int& R, int& C) { const int st = b / 1024, sb = b % 1024, swz = sb ^ (((sb >> 9) & 1) << 5); R = (st >> 1) * 16 + swz / 64; C = (st & 1) * 32 + (swz % 64) / 2; }
__host__ __device__ __forceinline__ int perm32(int rho) { const int n = rho >> 4, i = rho & 15; return 8 * (i >> 2) + 4 * n + (i & 3); }

struct Unit { int pm, pn, k0, nt, sl, z; };
struct Gemm { const bf16_t* A; const bf16_t* Bt; int M, N, K; const bf16_t* A2; const bf16_t* Bt2; };

struct StaticOrder {
    int nM, nN, nwg, G, c, ntk, lora, nM2, nN2, nwg2;
    __host__ __device__ void init(int M, int N, int G_, int c_, int K_, int lora_ = 0) { nM = M / BM; nN = N / BM; nwg = nM * nN; G = G_; c = c_; ntk = K_ / BK; lora = lora_; nM2 = 0; nN2 = 0; nwg2 = 0; }
    __host__ __device__ void second(int M2, int N2) { nM2 = M2 / BM; nN2 = N2 / BM; nwg2 = nM2 * nN2; }
    __host__ __device__ bool next(int i, Unit& u) const {
        long L = (long)i * G + c; int nM_ = nM, nN_ = nN, nwg_ = nwg, z_ = 0;
        if (L >= nwg) { L -= nwg; if (L >= nwg2) return false; nM_ = nM2; nN_ = nN2; nwg_ = nwg2; z_ = 1; }
        int wgid = (int)L; { const int q = nwg_ / NXCD, r = nwg_ % NXCD, xcd = wgid % NXCD, off = wgid / NXCD; wgid = (xcd < r ? xcd * (q + 1) : r * (q + 1) + (xcd - r) * q) + off; }
        const int nig = WGM * nN_, gid = wgid / nig, fm = gid * WGM, gsz = (nM_ - fm) < WGM ? (nM_ - fm) : WGM;
        u.pm = fm + ((wgid % nig) % gsz); u.pn = (wgid % nig) / gsz; u.k0 = 0; u.nt = ntk; u.sl = -1; u.z = z_; if (lora) { u.k0 = u.pn < 4 ? 0 : 2; u.nt = 2; } return true;
    }
    __device__ __forceinline__ void a_ready(const Unit&) const {}
    __device__ __forceinline__ void done(const Unit&) const {}
};

struct SplitOrder {
    StaticOrder so; int NS, nts, G, c;
    __host__ __device__ void init(int G_, int c_, int K_, int NS_) { so.init(65536, 1024, G_, c_, K_); NS = NS_; nts = (K_ / BK) / NS_; G = G_; c = c_; }
    __host__ __device__ bool next(int i, Unit& u) const {
        if (so.next(i, u)) return true;
        const long L = (long)i * G + c - 1024; if (L < 0 || L >= 16 * NS) return false;
        const int tile = (int)L / NS, sl = (int)L - tile * NS;
        u.pm = 256 + (tile >> 2); u.pn = tile & 3; u.k0 = sl * nts; u.nt = nts; u.sl = sl; u.z = 0; return true;
    }
    __device__ __forceinline__ void a_ready(const Unit&) const {}
    __device__ __forceinline__ void done(const Unit&) const {}
};

__device__ __forceinline__ unsigned cvt_pk_bf16(float lo, float hi) { unsigned r; asm volatile("v_cvt_pk_bf16_f32 %0, %1, %2" : "=v"(r) : "v"(lo), "v"(hi)); return r; }
__device__ __forceinline__ float bf_lo(unsigned w) { return __uint_as_float(w << 16); }
__device__ __forceinline__ float bf_hi(unsigned w) { return __uint_as_float(w & 0xffff0000u); }
struct EpiBf16 {
    static constexpr bool PERM = true, AFTER_DRAIN = false;
    bf16_t* O; int ldc; int split_cols; size_t split_stride; float scale0; bf16_t* O2; int ldc2;
    __device__ __forceinline__ void operator()(const f32x4 (&acc)[2][2][4][2], const Unit& u, int wr, int wc, int fr, int fq) const {
        const int row0 = u.pm * BM + wr * 64 + fr; int colt = u.pn * BM; bf16_t* base = u.z ? O2 : O; const int ldc = u.z ? ldc2 : this->ldc;
        float sc = 1.f; if (split_cols && !u.z) { const int t = colt / split_cols; base += (size_t)t * split_stride; colt -= t * split_cols; if (t == 0) sc = scale0; }
        const int col0 = colt + wc * 32 + 8 * fq;
#pragma unroll
        for (int ai = 0; ai < 2; ++ai)
#pragma unroll
            for (int m = 0; m < 4; ++m) { bf16_t* rowp = base + (size_t)(row0 + ai * HALF + m * 16) * ldc + col0;
#pragma unroll
                for (int bj = 0; bj < 2; ++bj) { const f32x4 v0 = acc[ai][bj][m][0] * sc, v1 = acc[ai][bj][m][1] * sc;
                    u32x4 w; w.x = cvt_pk_bf16(v0[0], v0[1]); w.y = cvt_pk_bf16(v0[2], v0[3]); w.z = cvt_pk_bf16(v1[0], v1[1]); w.w = cvt_pk_bf16(v1[2], v1[3]);
                    *(u32x4*)(rowp + bj * HALF) = w; } }
    }
};
__device__ __forceinline__ float silu_f(float x) { return x * __builtin_amdgcn_rcpf(1.0f + __expf(-x)); }
struct EpiSwiglu {
    static constexpr bool PERM = true, AFTER_DRAIN = false;
    bf16_t* O; int ldc;
    __device__ __forceinline__ void operator()(const f32x4 (&acc)[2][2][4][2], const Unit& u, int wr, int wc, int fr, int fq) const {
        const int row0 = u.pm * BM + wr * 64 + fr; const int col0 = u.pn * HALF + wc * 32 + 8 * fq;
#pragma unroll
        for (int ai = 0; ai < 2; ++ai)
#pragma unroll
            for (int m = 0; m < 4; ++m) { bf16_t* rowp = O + (size_t)(row0 + ai * HALF + m * 16) * ldc + col0;
                const f32x4 g0 = acc[ai][0][m][0], g1 = acc[ai][0][m][1], u0 = acc[ai][1][m][0], u1 = acc[ai][1][m][1];
                u32x4 w;
                w.x = cvt_pk_bf16(silu_f(g0[0]) * u0[0], silu_f(g0[1]) * u0[1]); w.y = cvt_pk_bf16(silu_f(g0[2]) * u0[2], silu_f(g0[3]) * u0[3]);
                w.z = cvt_pk_bf16(silu_f(g1[0]) * u1[0], silu_f(g1[1]) * u1[1]); w.w = cvt_pk_bf16(silu_f(g1[2]) * u1[2], silu_f(g1[3]) * u1[3]);
                *(u32x4*)rowp = w; }
    }
};
struct EpiResid {
    static constexpr bool PERM = true, AFTER_DRAIN = false;
    const bf16_t* X; bf16_t* Z; int ldc; float alpha; float* ZS;
    __device__ __forceinline__ void operator()(const f32x4 (&acc)[2][2][4][2], const Unit& u, int wr, int wc, int fr, int fq) const {
        const int row0 = u.pm * BM + wr * 64 + fr; const int col0 = u.pn * BM + wc * 32 + 8 * fq;
        if (u.sl >= 0) {
            float* zs = ZS + ((size_t)u.sl * 1024 + (row0 - 65536)) * 1024 + col0;
#pragma unroll
            for (int ai = 0; ai < 2; ++ai)
#pragma unroll
                for (int m = 0; m < 4; ++m)
#pragma unroll
                    for (int bj = 0; bj < 2; ++bj) { float* q = zs + (size_t)(ai * HALF + m * 16) * 1024 + bj * HALF; *(f32x4*)q = acc[ai][bj][m][0]; *(f32x4*)(q + 4) = acc[ai][bj][m][1]; }
            return;
        }
#pragma unroll
        for (int ai = 0; ai < 2; ++ai)
#pragma unroll
            for (int m = 0; m < 4; ++m) { const size_t off = (size_t)(row0 + ai * HALF + m * 16) * ldc + col0;
#pragma unroll
                for (int bj = 0; bj < 2; ++bj) { const u32x4 x = *(const u32x4*)(X + off + bj * HALF);
                    const f32x4 v0 = acc[ai][bj][m][0], v1 = acc[ai][bj][m][1];
                    u32x4 w;
                    w.x = cvt_pk_bf16(alpha * bf_lo(x.x) + v0[0], alpha * bf_hi(x.x) + v0[1]); w.y = cvt_pk_bf16(alpha * bf_lo(x.y) + v0[2], alpha * bf_hi(x.y) + v0[3]);
                    w.z = cvt_pk_bf16(alpha * bf_lo(x.z) + v1[0], alpha * bf_hi(x.z) + v1[1]); w.w = cvt_pk_bf16(alpha * bf_lo(x.w) + v1[2], alpha * bf_hi(x.w) + v1[3]);
                    *(u32x4*)(Z + off + bj * HALF) = w; } }
    }
};
template <class Epi, class Sched, bool ALIGN_EPI = false, bool SP2 = false>
__device__ __forceinline__ void gemm_phase(PG8_LAS unsigned char* lds, const Gemm g, const Sched& S, const Epi& E) {
    int tid = threadIdx.x; asm volatile("" : "+v"(tid)); const int wid = __builtin_amdgcn_readfirstlane(tid >> 6), lane = tid & 63, wr = wid >> 2, wc = wid & 3, fr = lane & 15, fq = lane >> 4;
    const int K = g.K;
    unsigned voffA[2], voffB[2];
#pragma unroll
    for (int i = 0; i < 2; ++i) { int R, C; stage_rc(tid * 16 + i * 8192, R, C); const int Rb = Epi::PERM ? ((R & ~31) + perm32(R & 31)) : R;
        voffA[i] = (unsigned)(R * K + C) * 2u; voffB[i] = (unsigned)(Rb * K + C) * 2u; }
    const size_t kstep = (size_t)(BK * 2);
    const size_t hstep = (size_t)HALF * K * 2;
    const size_t tstep = 2 * hstep;
    const unsigned ldsw = (unsigned)wid * 1024u;
    const int aoff = lds_byte(wr * 64 + fr, fq * 8), boff = lds_byte(wc * 32 + fr, fq * 8);
#define PG8_SA(b, h) (((b) * 2 + (h)) * HTB)
#define PG8_SB(b, h) ((4 + (b) * 2 + (h)) * HTB)
#define PG8_STAGE(bufoff, gbase, voff) do { _Pragma("unroll") for (int _i = 0; _i < 2; ++_i) \
        __builtin_amdgcn_global_load_lds((const unsigned*)((const char*)(gbase) + (voff)[_i]), (PG8_LAS unsigned*)(lds + (bufoff) + ldsw + _i * 8192), 16, 0, 0); } while (0)
#define PG8_LDA(dst, b, h) do { _Pragma("unroll") for (int m = 0; m < 4; ++m) _Pragma("unroll") for (int k = 0; k < 2; ++k) dst[m][k] = *(const PG8_LAS bf16x8*)(lds + PG8_SA(b, h) + aoff + m * 2048 + k * 1024); } while (0)
#define PG8_LDB(dst, b, h) do { _Pragma("unroll") for (int n = 0; n < 2; ++n) _Pragma("unroll") for (int k = 0; k < 2; ++k) dst[n][k] = *(const PG8_LAS bf16x8*)(lds + PG8_SB(b, h) + boff + n * 2048 + k * 1024); } while (0)
#define PG8_MMA(ai, bj, At, Bt) do { __builtin_amdgcn_s_setprio(1); _Pragma("unroll") for (int m = 0; m < 4; ++m) _Pragma("unroll") for (int n = 0; n < 2; ++n) _Pragma("unroll") for (int k = 0; k < 2; ++k) \
        acc[ai][bj][m][n] = __builtin_amdgcn_mfma_f32_16x16x32_bf16(Bt[n][k], At[m][k], acc[ai][bj][m][n], 0, 0, 0); __builtin_amdgcn_s_setprio(0); } while (0)
#define PG8_WAIT_V(n) asm volatile("s_waitcnt vmcnt(" #n ")" ::: "memory")
#define PG8_WAIT_L(n) asm volatile("s_waitcnt lgkmcnt(" #n ")" ::: "memory")
#define PG8_BAR __builtin_amdgcn_s_barrier()
#define PG8_SCHED __builtin_amdgcn_sched_barrier(0)
    Unit cur, nxt; int ui = 0;
    if (!S.next(0, cur)) return;
    f32x4 acc[2][2][4][2];
#pragma unroll
    for (int a = 0; a < 2; ++a)
#pragma unroll
        for (int b = 0; b < 2; ++b)
#pragma unroll
            for (int m = 0; m < 4; ++m)
#pragma unroll
                for (int n = 0; n < 2; ++n) acc[a][b][m][n] = (f32x4){0.f, 0.f, 0.f, 0.f};
    bf16x8 At[4][2], B0[2][2], B1[2][2];
    const char* cA = (const char*)(cur.z ? g.A2 : g.A) + (size_t)cur.pm * tstep + (size_t)cur.k0 * kstep; const char* cB = (const char*)(cur.z ? g.Bt2 : g.Bt) + (size_t)cur.pn * tstep + (size_t)cur.k0 * kstep;
    S.a_ready(cur);
    if constexpr (SP2) {
        PG8_STAGE(PG8_SB(0, 0), cB, voffB); PG8_STAGE(PG8_SB(0, 1), cB + hstep, voffB); PG8_STAGE(PG8_SA(0, 0), cA, voffA); PG8_STAGE(PG8_SA(0, 1), cA + hstep, voffA);
        if (wr == 1) PG8_BAR;
        PG8_WAIT_V(2); PG8_BAR;
        PG8_STAGE(PG8_SB(1, 0), cB + kstep, voffB); PG8_STAGE(PG8_SA(1, 0), cA + kstep, voffA); PG8_STAGE(PG8_SB(1, 1), cB + hstep + kstep, voffB);
        PG8_WAIT_V(6); PG8_BAR;
    } else {
        PG8_STAGE(PG8_SB(0, 0), cB, voffB); PG8_STAGE(PG8_SA(0, 0), cA, voffA); PG8_STAGE(PG8_SB(0, 1), cB + hstep, voffB); PG8_STAGE(PG8_SA(0, 1), cA + hstep, voffA);
        if (wr == 1) PG8_BAR;
        PG8_WAIT_V(4); PG8_BAR;
        PG8_STAGE(PG8_SB(1, 0), cB + kstep, voffB); PG8_STAGE(PG8_SA(1, 0), cA + kstep, voffA); PG8_STAGE(PG8_SB(1, 1), cB + hstep + kstep, voffB);
        PG8_WAIT_V(6); PG8_BAR;
    }
    for (;;) {
        const bool has_next = S.next(ui + 1, nxt);
        const char* nA = has_next ? (const char*)(nxt.z ? g.A2 : g.A) + (size_t)nxt.pm * tstep + (size_t)nxt.k0 * kstep : cA; const char* nB = has_next ? (const char*)(nxt.z ? g.Bt2 : g.Bt) + (size_t)nxt.pn * tstep + (size_t)nxt.k0 * kstep : cB;
        const int nt = cur.nt;
        for (int t = 0; t < nt; t += 2) {
            const bool last = (t == nt - 2);
            const char* a1 = cA + (size_t)(t + 1) * kstep;
            const char* a2 = last ? nA : cA + (size_t)(t + 2) * kstep; const char* b2 = last ? nB : cB + (size_t)(t + 2) * kstep;
            const char* a3 = a2 + kstep; const char* b3 = b2 + kstep;
            if (last && has_next) S.a_ready(nxt);
            if constexpr (SP2) {
            PG8_LDB(B0, 0, 0); PG8_LDB(B1, 0, 1); PG8_SCHED; PG8_LDA(At, 0, 0); PG8_STAGE(PG8_SA(1, 1), a1 + hstep, voffA);
            PG8_WAIT_V(8); PG8_WAIT_L(0); PG8_BAR; PG8_MMA(0, 0, At, B0); PG8_MMA(0, 1, At, B1); PG8_BAR; PG8_SCHED;
            PG8_LDA(At, 0, 1); PG8_STAGE(PG8_SB(0, 0), b2, voffB); PG8_STAGE(PG8_SB(0, 1), b2 + hstep, voffB); PG8_STAGE(PG8_SA(0, 0), a2, voffA);
            PG8_WAIT_V(8); PG8_WAIT_L(0); PG8_BAR; PG8_MMA(1, 0, At, B0); PG8_MMA(1, 1, At, B1); PG8_BAR; PG8_SCHED;
            PG8_LDB(B0, 1, 0); PG8_LDB(B1, 1, 1); PG8_SCHED; PG8_LDA(At, 1, 0); PG8_STAGE(PG8_SA(0, 1), a2 + hstep, voffA);
            PG8_WAIT_V(8); PG8_WAIT_L(0); PG8_BAR; PG8_MMA(0, 0, At, B0); PG8_MMA(0, 1, At, B1); PG8_BAR; PG8_SCHED;
            PG8_LDA(At, 1, 1); PG8_STAGE(PG8_SB(1, 0), b3, voffB); PG8_STAGE(PG8_SB(1, 1), b3 + hstep, voffB); PG8_STAGE(PG8_SA(1, 0), a3, voffA);
            PG8_WAIT_V(8); PG8_WAIT_L(0); PG8_BAR; PG8_MMA(1, 0, At, B0); PG8_MMA(1, 1, At, B1); PG8_BAR; PG8_SCHED;
            } else {
            PG8_LDB(B0, 0, 0); PG8_SCHED; PG8_LDA(At, 0, 0); PG8_STAGE(PG8_SA(1, 1), a1 + hstep, voffA);
            PG8_WAIT_L(8); PG8_BAR; PG8_WAIT_L(0); PG8_MMA(0, 0, At, B0); PG8_BAR; PG8_SCHED;
            PG8_LDB(B1, 0, 1); PG8_STAGE(PG8_SB(0, 0), b2, voffB);
            PG8_BAR; PG8_WAIT_L(0); PG8_MMA(0, 1, At, B1); PG8_BAR;
            PG8_LDA(At, 0, 1); PG8_STAGE(PG8_SA(0, 0), a2, voffA);
            PG8_BAR; PG8_WAIT_L(0); PG8_MMA(1, 0, At, B0); PG8_BAR; PG8_SCHED;
            PG8_STAGE(PG8_SB(0, 1), b2 + hstep, voffB);
            PG8_WAIT_V(6); PG8_BAR; PG8_MMA(1, 1, At, B1); PG8_BAR;
            PG8_LDB(B0, 1, 0); PG8_SCHED; PG8_LDA(At, 1, 0); PG8_STAGE(PG8_SA(0, 1), a2 + hstep, voffA);
            PG8_WAIT_L(8); PG8_BAR; PG8_WAIT_L(0); PG8_MMA(0, 0, At, B0); PG8_BAR; PG8_SCHED;
            PG8_LDB(B1, 1, 1); PG8_STAGE(PG8_SB(1, 0), b3, voffB);
            PG8_BAR; PG8_WAIT_L(0); PG8_MMA(0, 1, At, B1); PG8_BAR;
            PG8_LDA(At, 1, 1); PG8_STAGE(PG8_SA(1, 0), a3, voffA);
            PG8_BAR; PG8_WAIT_L(0); PG8_MMA(1, 0, At, B0); PG8_BAR; PG8_SCHED;
            PG8_STAGE(PG8_SB(1, 1), b3 + hstep, voffB);
            PG8_WAIT_V(6); PG8_BAR; PG8_MMA(1, 1, At, B1); PG8_BAR;
            }
        }
        if constexpr (ALIGN_EPI) { if (wr == 0) PG8_BAR; }
        if constexpr (!Epi::AFTER_DRAIN) { E(acc, cur, wr, wc, fr, fq); S.done(cur); }
        if (!has_next) break;
#pragma unroll
        for (int a = 0; a < 2; ++a)
#pragma unroll
            for (int b = 0; b < 2; ++b)
#pragma unroll
                for (int m = 0; m < 4; ++m)
#pragma unroll
                    for (int n = 0; n < 2; ++n) acc[a][b][m][n] = (f32x4){0.f, 0.f, 0.f, 0.f};
        cur = nxt; cA = nA; cB = nB; ++ui;
        if constexpr (ALIGN_EPI) { if (wr == 1) PG8_BAR; }
    }
    PG8_WAIT_V(0);
    if constexpr (!ALIGN_EPI) { if (wr == 0) PG8_BAR; }
    PG8_BAR;
    if constexpr (Epi::AFTER_DRAIN) { E.fused(acc, cur, wr, wc, fr, fq, lds, wid, lane); S.done(cur); }
#undef PG8_SA
#undef PG8_SB
#undef PG8_STAGE
#undef PG8_LDA
#undef PG8_LDB
#undef PG8_MMA
#undef PG8_WAIT_V
#undef PG8_WAIT_L
#undef PG8_BAR
#undef PG8_SCHED
}
}
#define TR_LO 0
#define TR_HI 16


#define LAS __attribute__((address_space(3)))
typedef unsigned short bf16;
typedef unsigned v4u __attribute__((ext_vector_type(4)));
typedef unsigned v2u __attribute__((ext_vector_type(2)));
typedef float f32x4 __attribute__((ext_vector_type(4)));
typedef short bf16x8 __attribute__((ext_vector_type(8)));
using pg8::cvt_pk_bf16; using pg8::bf_lo; using pg8::bf_hi;

constexpr int DM = 1024, MP = 65536, MS = 1024, MT = MP + MS;
constexpr int TPR = 8192, TSM = 64;
constexpr int APROJ = 1792, NMIX = 3584, FH = 2816, NLORA = 1536, KLORA = 256;
constexpr float LN_EPS = 1e-5f, A_NORM_EPS = 64e-5f;
constexpr float DN_ALPHA = 1.681792830507429f;
constexpr int NWAVES = 8, NTHREADS = 512;
constexpr int LDS_BYTES = 132096;

constexpr size_t SZ_X = (size_t)MT * 1024 * 2;
constexpr size_t W_IN = 0, W_IN_SZ = (size_t)NMIX * 1024 * 2;
constexpr size_t W_LO = W_IN + 2 * W_IN_SZ, W_LO_SZ = (size_t)NLORA * KLORA * 2;
constexpr size_t W_OM = W_LO + 2 * W_LO_SZ, W_SQ_SZ = (size_t)1024 * 1024 * 2;
constexpr size_t W_QKV = W_OM + 2 * W_SQ_SZ, W_QKV_SZ = (size_t)3072 * 1024 * 2;
constexpr size_t W_O = W_QKV + 2 * W_QKV_SZ;
constexpr size_t W_FI = W_O + 2 * W_SQ_SZ, W_FI_SZ = (size_t)2 * FH * 1024 * 2;
constexpr size_t W_FO = W_FI + 4 * W_FI_SZ, W_FO_SZ = (size_t)1024 * FH * 2;
constexpr size_t OFF_XB = W_FO + 4 * W_FO_SZ;
constexpr size_t OFF_R1 = OFF_XB + SZ_X;
constexpr size_t OFF_G = OFF_R1 + SZ_X;
constexpr size_t OFF_Z = OFF_G + SZ_X / 2;
constexpr size_t OFF_BIG = OFF_Z + SZ_X;
constexpr size_t WS_END = OFF_BIG + (size_t)MT * NMIX * 2;
constexpr size_t WS_BAR = WS_END, WS_BAR_BYTES = 16384;
static_assert(OFF_XB % 256 == 0 && WS_BAR % 256 == 0 && WS_BAR + WS_BAR_BYTES <= (size_t)1073741824, "ws map");

constexpr size_t O_YP = 0, O_YS = 67108864, O_PWKV = 68157440, O_PSHIFT = 68681728, O_PGLA = 68710400, O_PK = 69234688, O_PV = 77623296,
                 O_SWKV = 86011904, O_SSHIFT = 87060480, O_SGLA = 87117824, O_SK = 88166400, O_SV = 90263552;

__device__ __forceinline__ int tid_opaque() { int t = threadIdx.x; asm volatile("" : "+v"(t)); return t; }
struct Args { const float* in[32]; float* out; unsigned char* ws; int ph_lo, ph_hi; };

__device__ __forceinline__ float wave_sum(float v) {
#pragma unroll
    for (int o = 1; o < 64; o <<= 1) v += __shfl_xor(v, o);
    return v;
}
__device__ __forceinline__ void unpack8(const v4u w, float* f) {
    f[0] = bf_lo(w.x); f[1] = bf_hi(w.x); f[2] = bf_lo(w.y); f[3] = bf_hi(w.y); f[4] = bf_lo(w.z); f[5] = bf_hi(w.z); f[6] = bf_lo(w.w); f[7] = bf_hi(w.w);
}
__device__ __forceinline__ v4u pack8(const float* f) {
    v4u w; w.x = cvt_pk_bf16(f[0], f[1]); w.y = cvt_pk_bf16(f[2], f[3]); w.z = cvt_pk_bf16(f[4], f[5]); w.w = cvt_pk_bf16(f[6], f[7]); return w;
}
__device__ __forceinline__ void load8f(const float* p, float* f) {
    const f32x4 a = *(const f32x4*)p, b = *(const f32x4*)(p + 4);
    f[0] = a.x; f[1] = a.y; f[2] = a.z; f[3] = a.w; f[4] = b.x; f[5] = b.y; f[6] = b.z; f[7] = b.w;
}
__device__ __forceinline__ float softplus_f(float x) { return fmaxf(x, 0.f) + __logf(1.0f + __expf(-fabsf(x))); }
__device__ __forceinline__ float sigmoid_f(float x) { return __builtin_amdgcn_rcpf(1.0f + __expf(-x)); }
#define LDS_WAIT() asm volatile("s_waitcnt lgkmcnt(0)" ::: "memory")

__device__ __forceinline__ int src_col(int mode, int n) {
    if (mode == 0) return n;
    if (mode == 1) {
        if (n < 1792) return n;
        if (n < 2816) { const int h = (n - 1792) >> 8, r = (n - 1792) & 255;
            if (r < 64) return 1792 + h * 64 + r; if (r < 128) return 1792 + 256 + h * 64 + (r - 64); return 1792 + 512 + h * 128 + (r - 128); }
        if (n < 3328) return 1792 + 1040 + (n - 2816);
        if (n < 3344) return 1792 + 1024 + (n - 3328);
        return -1;
    }
    const int pn = n >> 8, jj = n & 255;
    return jj < 128 ? pn * 128 + jj : FH + pn * 128 + (jj - 128);
}
__device__ __forceinline__ void transpose_item(const float* W, int ldw, int mode, bf16* WT, int K, int N, int it, int lane) {
    const int nblk = N / 64;
    const int kb = it / nblk, nb = it - kb * nblk, k0 = 64 * kb, n = 64 * nb + lane;
    const int sc = src_col(mode, n); const float msk = sc >= 0 ? 1.f : 0.f; const int scc = sc >= 0 ? sc : 0;
    const float* wp = W + (size_t)k0 * ldw + scc; bf16* op = WT + (size_t)n * K + k0;
#pragma unroll 4
    for (int k8 = 0; k8 < 8; ++k8) {
        float f[8];
#pragma unroll
        for (int i = 0; i < 8; ++i) f[i] = wp[(size_t)(8 * k8 + i) * ldw] * msk;
        *(v4u*)(op + 8 * k8) = pack8(f);
    }
}
__device__ __forceinline__ void prologue_phase(const Args& a, LAS unsigned char* lds) {
    const int tid = tid_opaque(), lane = tid & 63, wave = tid >> 6;
    const int gw = blockIdx.x * NWAVES + wave, ngw = gridDim.x * NWAVES;
    LAS float* scr = (LAS float*)(lds + wave * 8704);
    unsigned char* ws = a.ws;
    for (int itg = gw; itg < 12800; itg += ngw) {
        int j, base;
        if (itg < 1792) { j = itg / 896; base = j * 896; }
        else if (itg < 2304) { j = 2 + (itg - 1792) / 256; base = 1792 + (j - 2) * 256; }
        else if (itg < 3840) { j = 4 + (itg - 2304) / 768; base = 2304 + (j - 4) * 768; }
        else if (itg < 4352) { j = 6 + (itg - 3840) / 256; base = 3840 + (j - 6) * 256; }
        else if (itg < 9984) { j = 8 + (itg - 4352) / 1408; base = 4352 + (j - 8) * 1408; }
        else { j = 12 + (itg - 9984) / 704; base = 9984 + (j - 12) * 704; }
        const float* W; int ldw, mode, K, N; bf16* WT;
        if (j < 2)       { W = a.in[7] + (size_t)j * 1024 * 3344; ldw = 3344; mode = 1; K = 1024; N = NMIX; WT = (bf16*)(ws + W_IN + j * W_IN_SZ); }
        else if (j < 4)  { const int e = j - 2;  W = a.in[22] + (size_t)e * 1024 * 1024; ldw = 1024; mode = 0; K = 1024; N = 1024; WT = (bf16*)(ws + W_OM + e * W_SQ_SZ); }
        else if (j < 6)  { const int e = j - 4;  W = a.in[23] + (size_t)e * 1024 * 3072; ldw = 3072; mode = 0; K = 1024; N = 3072; WT = (bf16*)(ws + W_QKV + e * W_QKV_SZ); }
        else if (j < 8)  { const int e = j - 6;  W = a.in[25] + (size_t)e * 1024 * 1024; ldw = 1024; mode = 0; K = 1024; N = 1024; WT = (bf16*)(ws + W_O + e * W_SQ_SZ); }
        else if (j < 12) { const int l = j - 8;  W = a.in[30] + (size_t)l * 1024 * 2 * FH; ldw = 2 * FH; mode = 2; K = 1024; N = 2 * FH; WT = (bf16*)(ws + W_FI + l * W_FI_SZ); }
        else             { const int l = j - 12; W = a.in[31] + (size_t)l * FH * 1024; ldw = 1024; mode = 0; K = FH; N = 1024; WT = (bf16*)(ws + W_FO + l * W_FO_SZ); }
        transpose_item(W, ldw, mode, WT, K, N, itg - base, lane);
    }
    const int gt = blockIdx.x * NTHREADS + tid, ngt = gridDim.x * NTHREADS;
#ifndef SKIP_LORA
    for (int idx = gt; idx < 2 * NLORA * 32; idx += ngt) {
        const int e = idx / (NLORA * 32), r = idx - e * (NLORA * 32), n = r >> 5, k0 = (r & 31) * 8;
        float f[8];
#pragma unroll
        for (int i = 0; i < 8; ++i) { const int k = k0 + i; float v = 0.f;
            if (n < 512) { if (k < 64) v = a.in[10][((size_t)e * 64 + k) * 512 + n]; }
            else if (n < 1024) { if (k >= 64 && k < 128) v = a.in[12][((size_t)e * 64 + (k - 64)) * 512 + (n - 512)]; }
            else { if (k >= 128) v = a.in[13][((size_t)e * 128 + (k - 128)) * 512 + (n - 1024)]; }
            f[i] = v; }
        *(v4u*)((bf16*)(ws + W_LO + e * W_LO_SZ) + (size_t)n * KLORA + k0) = pack8(f);
    }
#endif
    bf16* XB = (bf16*)(ws + OFF_XB);
    for (size_t idx = gt; idx < (size_t)MT * 128; idx += ngt) {
        const size_t e0 = idx * 8; const float* src = e0 < (size_t)MP * 1024 ? a.in[0] + e0 : a.in[1] + (e0 - (size_t)MP * 1024);
        float f[8]; load8f(src, f); *(v4u*)(XB + e0) = pack8(f);
    }
}

__device__ __forceinline__ void prep1_phase(const Args& a, int e) {
    const int tid = tid_opaque(), lane = tid & 63, wave = tid >> 6;
    const int gw = blockIdx.x * NWAVES + wave, ngw = gridDim.x * NWAVES;
    const bf16* PA = (const bf16*)(a.ws + OFF_BIG); bf16* L = (bf16*)(a.ws + OFF_Z);
    const float* mu = a.in[8] + (size_t)e * APROJ; const float* shift0 = a.in[3] + (size_t)e * 16 * APROJ;
    const int c = 1536 + 4 * lane;
    const f32x4 mu4 = *(const f32x4*)(mu + c);
    for (int m = gw; m < MT; m += ngw) {
        const v2u pw = *(const v2u*)(PA + (size_t)m * APROJ + c);
        float p[4] = {bf_lo(pw.x), bf_hi(pw.x), bf_lo(pw.y), bf_hi(pw.y)}, q[4];
        const int t = m < MP ? (m & (TPR - 1)) : ((m - MP) & (TSM - 1));
        if (t > 0) { const v2u qw = *(const v2u*)(PA + (size_t)(m - 1) * APROJ + c); q[0] = bf_lo(qw.x); q[1] = bf_hi(qw.x); q[2] = bf_lo(qw.y); q[3] = bf_hi(qw.y); }
        else if (m < MP) { q[0] = q[1] = q[2] = q[3] = 0.f; }
        else { const f32x4 s = *(const f32x4*)(shift0 + (size_t)((m - MP) >> 6) * APROJ + c); q[0] = s.x; q[1] = s.y; q[2] = s.z; q[3] = s.w; }
        float r[4];
#pragma unroll
        for (int i = 0; i < 4; ++i) { const float xs = p[i] + (q[i] - p[i]) * mu4[i]; r[i] = lane < 16 ? tanhf(xs) : (lane < 32 ? xs : sigmoid_f(xs)); }
        v2u o; o.x = cvt_pk_bf16(r[0], r[1]); o.y = cvt_pk_bf16(r[2], r[3]);
        *(v2u*)(L + (size_t)m * KLORA + 4 * lane) = o;
    }
}
__device__ __forceinline__ void prep2_phase(const Args& a, int e) {
    const int tid = tid_opaque(), lane = tid & 63, wave = tid >> 6;
    const int gw = blockIdx.x * NWAVES + wave, ngw = gridDim.x * NWAVES;
    const bf16* PA = (const bf16*)(a.ws + OFF_BIG); bf16* PB = (bf16*)(a.ws + OFF_BIG) + (size_t)MT * APROJ;
    const bf16* Lw = (const bf16*)(a.ws + OFF_R1); const bf16* La = Lw + (size_t)MT * 512;
    bf16* SA = (bf16*)a.out; bf16* SB = (bf16*)(a.ws + OFF_Z);
    const float* mu = a.in[8] + (size_t)e * APROJ; const float* shift0 = a.in[3] + (size_t)e * 16 * APROJ;
    const int c8 = 8 * lane, h = lane >> 3;
    float mur[8], muk[8], muv[8], w0[8], a0[8], kkw[8], kaw[8];
    load8f(mu + c8, mur); load8f(mu + 512 + c8, muk); load8f(mu + 1024 + c8, muv);
    load8f(a.in[9] + (size_t)e * 512 + c8, w0); load8f(a.in[11] + (size_t)e * 512 + c8, a0);
    load8f(a.in[14] + (size_t)e * 512 + c8, kkw); load8f(a.in[15] + (size_t)e * 512 + c8, kaw);
    const float* aup = a.in[19] + (size_t)e * 16 * 256; const f32x4 ab = *(const f32x4*)(a.in[20] + (size_t)e * 256 + 4 * lane);
    for (int m = gw; m < MT; m += ngw) {
        const bf16* pr = PA + (size_t)m * APROJ;
        float r[8], k[8], v[8], pq[8];
        unpack8(*(const v4u*)(pr + c8), r); unpack8(*(const v4u*)(pr + 512 + c8), k); unpack8(*(const v4u*)(pr + 1024 + c8), v);
        const int t = m < MP ? (m & (TPR - 1)) : ((m - MP) & (TSM - 1));
        if (t > 0) {
            unpack8(*(const v4u*)(pr - APROJ + c8), pq);
#pragma unroll
            for (int i = 0; i < 8; ++i) r[i] += (pq[i] - r[i]) * mur[i];
            unpack8(*(const v4u*)(pr - APROJ + 512 + c8), pq);
#pragma unroll
            for (int i = 0; i < 8; ++i) k[i] += (pq[i] - k[i]) * muk[i];
            unpack8(*(const v4u*)(pr - APROJ + 1024 + c8), pq);
#pragma unroll
            for (int i = 0; i < 8; ++i) v[i] += (pq[i] - v[i]) * muv[i];
        } else if (m < MP) {
#pragma unroll
            for (int i = 0; i < 8; ++i) { r[i] -= r[i] * mur[i]; k[i] -= k[i] * muk[i]; v[i] -= v[i] * muv[i]; }
        } else {
            const float* s0 = shift0 + (size_t)((m - MP) >> 6) * APROJ;
            load8f(s0 + c8, pq);
#pragma unroll
            for (int i = 0; i < 8; ++i) r[i] += (pq[i] - r[i]) * mur[i];
            load8f(s0 + 512 + c8, pq);
#pragma unroll
            for (int i = 0; i < 8; ++i) k[i] += (pq[i] - k[i]) * muk[i];
            load8f(s0 + 1024 + c8, pq);
#pragma unroll
            for (int i = 0; i < 8; ++i) v[i] += (pq[i] - v[i]) * muv[i];
        }
        float lw[8], la[8], u[8], av[8], kk[8], km[8], ka[8];
        unpack8(*(const v4u*)(Lw + (size_t)m * 512 + c8), lw); unpack8(*(const v4u*)(La + (size_t)m * 512 + c8), la);
        float ss = 0.f;
#pragma unroll
        for (int i = 0; i < 8; ++i) {
            const float w = -softplus_f(-(w0[i] + lw[i])) - 0.5f;
            u[i] = 1.0f - __expf(-__expf(w));
            av[i] = sigmoid_f(a0[i] + la[i]);
            kk[i] = k[i] * kkw[i]; ss += kk[i] * kk[i];
            km[i] = k[i] * (1.0f + (av[i] - 1.0f) * kaw[i]);
        }
        ss += __shfl_xor(ss, 1); ss += __shfl_xor(ss, 2); ss += __shfl_xor(ss, 4);
        const float rn = rsqrtf(ss + 1e-12f);
#pragma unroll
        for (int i = 0; i < 8; ++i) { kk[i] *= rn; ka[i] = kk[i] * av[i]; }
        bf16* sa = SA + ((size_t)m * 8 + h) * 256 + (lane & 7) * 8; bf16* sb = SB + ((size_t)m * 8 + h) * 128 + (lane & 7) * 8;
        *(v4u*)(sa) = pack8(r); *(v4u*)(sa + 64) = pack8(u); *(v4u*)(sa + 128) = pack8(km); *(v4u*)(sa + 192) = pack8(v);
        *(v4u*)(sb) = pack8(kk); *(v4u*)(sb + 64) = pack8(ka);
        bf16* pb = PB + (size_t)m * APROJ + 1536;
        float xa[16]; unpack8(*(const v4u*)(pb), xa); unpack8(*(const v4u*)(pb + 8), xa + 8);
        f32x4 acc = ab;
#pragma unroll
        for (int i = 0; i < 16; ++i) { const f32x4 wv = *(const f32x4*)(aup + i * 256 + 4 * lane); acc += xa[i] * wv; }
        float ug[4];
#pragma unroll
        for (int i = 0; i < 4; ++i) ug[i] = 1.0f - __expf(-softplus_f(-acc[i]) * (1.0f / 16.0f));
        v2u o; o.x = cvt_pk_bf16(ug[0], ug[1]); o.y = cvt_pk_bf16(ug[2], ug[3]);
        *(v2u*)(pb + 4 * lane) = o;
    }
}
struct PostRaw { v4u o, r, km, v, g, og, rg; };
__device__ __forceinline__ void post_phase(const Args& a, int e) {
    const int tid = tid_opaque(), lane = tid & 63, wave = tid >> 6;
    const int gw = blockIdx.x * NWAVES + wave, ngw = gridDim.x * NWAVES;
    bf16* Y = (bf16*)(a.ws + OFF_R1); const bf16* G = (const bf16*)(a.ws + OFF_G);
    const bf16* PB = (const bf16*)(a.ws + OFF_BIG) + (size_t)MT * APROJ; const bf16* SA = (const bf16*)a.out;
    const int c8 = 8 * lane, h = lane >> 3;
    float lnw[8], lnb[8], rk[8], nw[8];
    load8f(a.in[17] + (size_t)e * 512 + c8, lnw); load8f(a.in[18] + (size_t)e * 512 + c8, lnb); load8f(a.in[16] + (size_t)e * 512 + c8, rk);
    load8f(a.in[21] + (size_t)e * 128 + (lane & 15) * 8, nw);
    for (int mb = gw; mb < MT; mb += 2 * ngw) {
        PostRaw raw[2];
#pragma unroll
        for (int j = 0; j < 2; ++j) { const int m_ = mb + j * ngw; const size_t m = m_ < MT ? m_ : mb;
            const bf16* sa = SA + (m * 8 + h) * 256 + (lane & 7) * 8;
            raw[j].o = *(const v4u*)(Y + m * 1024 + c8); raw[j].r = *(const v4u*)(sa); raw[j].km = *(const v4u*)(sa + 128); raw[j].v = *(const v4u*)(sa + 192);
            raw[j].g = *(const v4u*)(G + m * 512 + c8); raw[j].og = *(const v4u*)(Y + m * 1024 + 512 + c8); raw[j].rg = *(const v4u*)(PB + m * APROJ + 1024 + c8); }
#pragma unroll
        for (int j = 0; j < 2; ++j) {
            const int m = mb + j * ngw;
            float o[8], r[8], km[8], v[8], g[8];
            unpack8(raw[j].o, o); unpack8(raw[j].r, r); unpack8(raw[j].km, km); unpack8(raw[j].v, v); unpack8(raw[j].g, g);
            float s = 0.f, bn = 0.f;
#pragma unroll
            for (int i = 0; i < 8; ++i) { s += o[i]; bn += r[i] * km[i] * rk[i]; }
            s += __shfl_xor(s, 1); s += __shfl_xor(s, 2); s += __shfl_xor(s, 4);
            bn += __shfl_xor(bn, 1); bn += __shfl_xor(bn, 2); bn += __shfl_xor(bn, 4);
            const float mean = s * (1.0f / 64.0f); float q = 0.f;
#pragma unroll
            for (int i = 0; i < 8; ++i) { o[i] -= mean; q += o[i] * o[i]; }
            q += __shfl_xor(q, 1); q += __shfl_xor(q, 2); q += __shfl_xor(q, 4);
            const float rstd = rsqrtf(q * (1.0f / 64.0f) + A_NORM_EPS);
#pragma unroll
            for (int i = 0; i < 8; ++i) o[i] = (o[i] * rstd * lnw[i] + lnb[i] + bn * v[i]) * g[i];
            float og[8], rg[8];
            unpack8(raw[j].og, og); unpack8(raw[j].rg, rg);
            float ms = 0.f;
#pragma unroll
            for (int i = 0; i < 8; ++i) ms += og[i] * og[i];
            ms += __shfl_xor(ms, 1); ms += __shfl_xor(ms, 2); ms += __shfl_xor(ms, 4); ms += __shfl_xor(ms, 8);
            const float rr = rsqrtf(ms * (1.0f / 128.0f) + LN_EPS);
#pragma unroll
            for (int i = 0; i < 8; ++i) og[i] = og[i] * rr * nw[i] * (rg[i] * sigmoid_f(rg[i]));
            if (m < MT) { *(v4u*)(Y + (size_t)m * 1024 + c8) = pack8(o); *(v4u*)(Y + (size_t)m * 1024 + 512 + c8) = pack8(og); }
        }
    }
}
__device__ __forceinline__ void ln_row_out(float* x0, float* x1, const float* w0, const float* w1, const float* b0, const float* b1, bf16* XB, float* fout, int m, int lane) {
    float s = 0.f;
#pragma unroll
    for (int i = 0; i < 8; ++i) s += x0[i] + x1[i];
    const float mean = wave_sum(s) * (1.0f / 1024.0f); float q = 0.f;
#pragma unroll
    for (int i = 0; i < 8; ++i) { x0[i] -= mean; x1[i] -= mean; q += x0[i] * x0[i] + x1[i] * x1[i]; }
    const float rstd = rsqrtf(wave_sum(q) * (1.0f / 1024.0f) + LN_EPS);
#pragma unroll
    for (int i = 0; i < 8; ++i) { x0[i] = x0[i] * rstd * w0[i] + b0[i]; x1[i] = x1[i] * rstd * w1[i] + b1[i]; }
    if (fout) {
        float* fo = fout + (size_t)m * 1024 + 8 * lane;
        *(f32x4*)(fo) = (f32x4){x0[0], x0[1], x0[2], x0[3]}; *(f32x4*)(fo + 4) = (f32x4){x0[4], x0[5], x0[6], x0[7]};
        *(f32x4*)(fo + 512) = (f32x4){x1[0], x1[1], x1[2], x1[3]}; *(f32x4*)(fo + 516) = (f32x4){x1[4], x1[5], x1[6], x1[7]};
    } else {
        *(v4u*)(XB + (size_t)m * 1024 + 8 * lane) = pack8(x0); *(v4u*)(XB + (size_t)m * 1024 + 512 + 8 * lane) = pack8(x1);
    }
}
__device__ __forceinline__ void ln_phase(const Args& a, const float* w, const float* b, float* fout, int ns) {
    const int tid = tid_opaque(), lane = tid & 63, wave = tid >> 6;
    const int gw = blockIdx.x * NWAVES + wave, ngw = gridDim.x * NWAVES;
    const bf16* Z = (const bf16*)(a.ws + OFF_Z); bf16* XB = (bf16*)(a.ws + OFF_XB);
    float w0[8], w1[8], b0[8], b1[8];
    load8f(w + 8 * lane, w0); load8f(w + 512 + 8 * lane, w1); load8f(b + 8 * lane, b0); load8f(b + 512 + 8 * lane, b1);
    for (int mb = gw; mb < MP; mb += 4 * ngw) {
        v4u r0[4], r1[4];
#pragma unroll
        for (int j = 0; j < 4; ++j) { const int m = mb + j * ngw; const int mc = m < MP ? m : mb;
            r0[j] = *(const v4u*)(Z + (size_t)mc * 1024 + 8 * lane); r1[j] = *(const v4u*)(Z + (size_t)mc * 1024 + 512 + 8 * lane); }
#pragma unroll
        for (int j = 0; j < 4; ++j) {
            const int m = mb + j * ngw;
            float x0[8], x1[8];
            unpack8(r0[j], x0); unpack8(r1[j], x1);
            if (m < MP) ln_row_out(x0, x1, w0, w1, b0, b1, XB, fout, m, lane);
        }
    }
#pragma unroll 1
    for (int m = MP + gw; m < MT; m += ngw) {
        float x0[8], x1[8];
        unpack8(*(const v4u*)(XB + (size_t)m * 1024 + 8 * lane), x0); unpack8(*(const v4u*)(XB + (size_t)m * 1024 + 512 + 8 * lane), x1);
#pragma unroll
        for (int i = 0; i < 8; ++i) { x0[i] *= DN_ALPHA; x1[i] *= DN_ALPHA; }
        const float* zs = (const float*)(a.ws + OFF_G) + (size_t)(m - MP) * 1024 + 8 * lane;
#pragma unroll 1
        for (int sl = 0; sl < ns; ++sl) { float t0[8], t1[8]; load8f(zs + (size_t)sl * 1024 * 1024, t0); load8f(zs + (size_t)sl * 1024 * 1024 + 512, t1);
#pragma unroll
            for (int i = 0; i < 8; ++i) { x0[i] += t0[i]; x1[i] += t1[i]; } }
        ln_row_out(x0, x1, w0, w1, b0, b1, XB, fout, m, lane);
    }
}

#define TR_DPP(x, ctrl) __builtin_bit_cast(float, __builtin_amdgcn_update_dpp(0, __builtin_bit_cast(int, x), ctrl, 0xf, 0xf, false))
__device__ __forceinline__ float transpose_reduce16(const float* p, int g) {
    const bool h1 = (g & 8) != 0, h2 = (g & 4) != 0, h3 = (g & 2) != 0, h4 = (g & 1) != 0;
    float q[8], r[4], t[2];
#pragma unroll
    for (int i = 0; i < 8; ++i) { const float keep = h1 ? p[i + 8] : p[i], send = h1 ? p[i] : p[i + 8]; q[i] = keep + TR_DPP(send, 0x140); }
#pragma unroll
    for (int i = 0; i < 4; ++i) { const float keep = h2 ? q[i + 4] : q[i], send = h2 ? q[i] : q[i + 4]; r[i] = keep + TR_DPP(send, 0x141); }
#pragma unroll
    for (int i = 0; i < 2; ++i) { const float keep = h3 ? r[i + 2] : r[i], send = h3 ? r[i] : r[i + 2]; t[i] = keep + TR_DPP(send, 0x4E); }
    const float keep = h4 ? t[1] : t[0], send = h4 ? t[0] : t[1];
    return keep + TR_DPP(send, 0xB1);
}
constexpr int TC = 16;
constexpr int SCW = 384, SCG = 320;
__device__ __forceinline__ void st8(LAS float* d, const v4u w, float sc) {
    *(LAS f32x4*)(d) = (f32x4){bf_lo(w.x) * sc, bf_hi(w.x) * sc, bf_lo(w.y) * sc, bf_hi(w.y) * sc};
    *(LAS f32x4*)(d + 4) = (f32x4){bf_lo(w.z) * sc, bf_hi(w.z) * sc, bf_lo(w.w) * sc, bf_hi(w.w) * sc};
}
typedef float f32x2 __attribute__((ext_vector_type(2)));
#define LO2(v4) (__builtin_shufflevector(v4, v4, 0, 1))
#define HI2(v4) (__builtin_shufflevector(v4, v4, 2, 3))
__device__ __forceinline__ f32x2 fma2(f32x2 a, f32x2 b, f32x2 c) { return __builtin_elementwise_fma(a, b, c); }
__device__ __forceinline__ float rowsum16(float x) {
    x += __builtin_bit_cast(float, __builtin_amdgcn_update_dpp(0, __builtin_bit_cast(int, x), 0x128, 0xf, 0xf, false));
    x += __builtin_bit_cast(float, __builtin_amdgcn_update_dpp(0, __builtin_bit_cast(int, x), 0x124, 0xf, 0xf, false));
    x += __builtin_bit_cast(float, __builtin_amdgcn_update_dpp(0, __builtin_bit_cast(int, x), 0x122, 0xf, 0xf, false));
    x += __builtin_bit_cast(float, __builtin_amdgcn_update_dpp(0, __builtin_bit_cast(int, x), 0x121, 0xf, 0xf, false));
    return x;
}
struct WkvIn { f32x4 r, u, km, kk, ka; float v; };
struct GlaIn { f32x4 q, k, u; float v; };
__device__ __forceinline__ void scan_phase(const Args& a, int e, LAS unsigned char* lds) {
    const int tid = tid_opaque(), lane = tid & 63, wave = tid >> 6;
    const bool isW = wave < 4; const int ltid = tid & 255, lw = wave & 3;
    const int g = lane & 15, rl = lw * 4 + (lane >> 4);
    const bf16* SA = (const bf16*)a.out; const bf16* SB = (const bf16*)(a.ws + OFF_Z);
    const bf16* PB = (const bf16*)(a.ws + OFF_BIG) + (size_t)MT * APROJ;
    bf16* O1 = (bf16*)(a.ws + OFF_R1);
    LAS float* bufW = (LAS float*)lds;
    LAS float* bufG = (LAS float*)(lds + 2 * TC * SCW * 4);
    int ps[3], pp[3];
#pragma unroll
    for (int j = 0; j < 3; ++j) { const int p = ltid + 256 * j; if (isW) { ps[j] = p / 48; pp[j] = p - ps[j] * 48; } else { ps[j] = p / 40; pp[j] = p - ps[j] * 40; } }
    const bool v2ok = isW || (ltid + 512 < 640);
#pragma unroll 1
    for (int it = blockIdx.x; it < 768; it += gridDim.x) {
        const bool samp = it >= 256; const int wi = samp ? it - 256 : it;
        const int b = wi >> 5; const int T = samp ? TSM : TPR; const size_t row0 = samp ? (size_t)MP + b * TSM : (size_t)b * TPR;
        const int nb = samp ? 16 : 8;
        int h, sub;
        if (isW) { h = (wi >> 2) & 7; sub = wi & 3; } else { h = (wi >> 3) & 3; sub = wi & 7; }
        const int vrow = sub * 16 + rl;
        f32x2 P0 = {0.f, 0.f}, P1 = {0.f, 0.f};
        if (samp) {
            if (isW) { const f32x4 S = *(const f32x4*)(a.in[2] + ((((size_t)e * 16 + b) * 8 + h) * 64 + vrow) * 64 + 4 * g); P0 = LO2(S); P1 = HI2(S); }
            else { const float* s0 = a.in[4] + (((size_t)e * 16 + b) * 4 + h) * 8192 + vrow;
                P0 = (f32x2){s0[(4 * g + 0) * 128], s0[(4 * g + 1) * 128]}; P1 = (f32x2){s0[(4 * g + 2) * 128], s0[(4 * g + 3) * 128]}; }
        }
        const int nc = T / TC;
        bf16* obase = isW ? O1 + (row0 + g) * 1024 + h * 64 + vrow : O1 + (row0 + g) * 1024 + 512 + h * 128 + vrow;
        v4u pre[3];
#define SCAN_ISSUE(t0) do { _Pragma("unroll") for (int j = 0; j < 3; ++j) { const size_t row = row0 + (t0) + ps[j]; const bf16* src; \
            if (isW) src = pp[j] < 32 ? SA + (row * 8 + h) * 256 + pp[j] * 8 : SB + (row * 8 + h) * 128 + (pp[j] - 32) * 8; \
            else src = pp[j] < 32 ? PB + row * APROJ + h * 256 + pp[j] * 8 : PB + row * APROJ + 1536 + h * 64 + (pp[j] - 32) * 8; \
            if (j < 2 || v2ok) pre[j] = *(const v4u*)src; } } while (0)
#define SCAN_COMMIT(bi) do { _Pragma("unroll") for (int j = 0; j < 3; ++j) { if (j < 2 || v2ok) { \
            if (isW) st8(bufW + ((bi) * TC + ps[j]) * SCW + pp[j] * 8, pre[j], 1.0f); \
            else st8(bufG + ((bi) * TC + ps[j]) * SCG + pp[j] * 8, pre[j], pp[j] < 8 ? 0.125f : 1.0f); } } } while (0)
        __syncthreads();
        SCAN_ISSUE(0); SCAN_COMMIT(0);
        __syncthreads();
#pragma unroll 1
        for (int c = 0; c < nc; ++c) {
            const int bi = c & 1;
            if (c + 1 < nc) SCAN_ISSUE((c + 1) * TC);
            float oacc = 0.f; float op[16];
            if (isW) {
                const LAS float* bw = bufW + bi * TC * SCW + 4 * g; const LAS float* bv = bufW + bi * TC * SCW + 192 + vrow;
#define WKV_LOAD(d, s) do { const LAS float* p_ = bw + (s) * SCW; d.r = *(const LAS f32x4*)(p_); d.u = *(const LAS f32x4*)(p_ + 64); d.km = *(const LAS f32x4*)(p_ + 128); \
                    d.kk = *(const LAS f32x4*)(p_ + 256); d.ka = *(const LAS f32x4*)(p_ + 320); d.v = bv[(s) * SCW]; } while (0)
                WkvIn in[3];
                WKV_LOAD(in[0], 0); WKV_LOAD(in[1], 1);
#pragma unroll
                for (int s = 0; s < TC; ++s) {
                    if (s + 2 < TC) WKV_LOAD(in[(s + 2) % 3], s + 2);
                    __builtin_amdgcn_sched_barrier(0);
                    const WkvIn& x = in[s % 3];
                    const f32x2 vv = {x.v, x.v};
                    const f32x2 s2 = fma2(P1, HI2(x.kk), P0 * LO2(x.kk));
                    const f32x2 T0 = fma2(vv, LO2(x.km), fma2(-LO2(x.u), P0, P0)), T1 = fma2(vv, HI2(x.km), fma2(-HI2(x.u), P1, P1));
                    const float sa = rowsum16(s2.x + s2.y);
                    const f32x2 ns = {-sa, -sa};
                    P0 = fma2(ns, LO2(x.ka), T0); P1 = fma2(ns, HI2(x.ka), T1);
                    const f32x2 o2 = fma2(P1, HI2(x.r), P0 * LO2(x.r));
                    op[s] = o2.x + o2.y;
                }
                oacc = transpose_reduce16(op, g);
#undef WKV_LOAD
            } else {
                const LAS float* bg = bufG + bi * TC * SCG + 4 * g; const LAS float* bv = bufG + bi * TC * SCG + 128 + vrow;
#define GLA_LOAD(d, s) do { const LAS float* p_ = bg + (s) * SCG; d.q = *(const LAS f32x4*)(p_); d.k = *(const LAS f32x4*)(p_ + 64); d.u = *(const LAS f32x4*)(p_ + 256); d.v = bv[(s) * SCG]; } while (0)
                GlaIn in[3];
                GLA_LOAD(in[0], 0); GLA_LOAD(in[1], 1);
#pragma unroll
                for (int s = 0; s < TC; ++s) {
                    if (s + 2 < TC) GLA_LOAD(in[(s + 2) % 3], s + 2);
                    __builtin_amdgcn_sched_barrier(0);
                    const GlaIn& x = in[s % 3];
                    const f32x2 vv = {x.v, x.v};
                    P0 = fma2(vv, LO2(x.k), fma2(-LO2(x.u), P0, P0)); P1 = fma2(vv, HI2(x.k), fma2(-HI2(x.u), P1, P1));
                    const f32x2 o2 = fma2(P1, HI2(x.q), P0 * LO2(x.q));
                    op[s] = o2.x + o2.y;
                }
                oacc = transpose_reduce16(op, g);
#undef GLA_LOAD
            }
            obase[(size_t)c * TC * 1024] = (bf16)(cvt_pk_bf16(oacc, 0.f) & 0xffffu);
            if (c + 1 < nc) SCAN_COMMIT(bi ^ 1);
            __syncthreads();
        }
#undef SCAN_ISSUE
#undef SCAN_COMMIT
        if (isW) { float* so = a.out + (samp ? O_SWKV : O_PWKV) + ((((size_t)e * nb + b) * 8 + h) * 64 + vrow) * 64 + 4 * g; *(f32x4*)so = (f32x4){P0.x, P0.y, P1.x, P1.y}; }
        else { float* so = a.out + (samp ? O_SGLA : O_PGLA) + (((size_t)e * nb + b) * 4 + h) * 8192 + vrow;
            so[(4 * g + 0) * 128] = P0.x; so[(4 * g + 1) * 128] = P0.y; so[(4 * g + 2) * 128] = P1.x; so[(4 * g + 3) * 128] = P1.y; }
    }
    const bf16* PA = (const bf16*)(a.ws + OFF_BIG);
    for (int idx = blockIdx.x * NTHREADS + tid; idx < 24 * APROJ; idx += gridDim.x * NTHREADS) {
        const int bb = idx / APROJ, c = idx - bb * APROJ;
        if (bb < 8) a.out[O_PSHIFT + ((size_t)e * 8 + bb) * APROJ + c] = bf_lo((unsigned)PA[((size_t)bb * TPR + TPR - 1) * APROJ + c]);
        else a.out[O_SSHIFT + ((size_t)e * 16 + (bb - 8)) * APROJ + c] = bf_lo((unsigned)PA[((size_t)MP + (bb - 8) * TSM + TSM - 1) * APROJ + c]);
    }
}

constexpr int KEXT = 8192, LDV = MT + KEXT;
constexpr size_t BIG_K = (size_t)MT * 1024, BIG_VT = (size_t)(2 * MT + KEXT) * 1024;
__device__ __forceinline__ bf16x8 ld_frag(const bf16* p) { return __builtin_bit_cast(bf16x8, *(const v4u*)p); }
__device__ __forceinline__ void cache_convert(const Args& a, int o) {
    const int tid = tid_opaque();
    const int gt = blockIdx.x * NTHREADS + tid, ngt = gridDim.x * NTHREADS;
    bf16* Kb = (bf16*)(a.ws + OFF_BIG) + BIG_K; bf16* Vt = (bf16*)(a.ws + OFF_BIG) + BIG_VT;
    const float* ck = a.in[5] + (size_t)o * 16 * 16 * 512 * 64; const float* cv = a.in[6] + (size_t)o * 16 * 16 * 512 * 64;
    for (int idx = gt; idx < 16 * 16 * 512 * 8; idx += ngt) {
        const int d8 = idx & 7, key = (idx >> 3) & 511, h = (idx >> 12) & 15, b = idx >> 16;
        float f[8]; load8f(ck + (size_t)idx * 8, f);
        *(v4u*)(Kb + ((size_t)MT + b * 512 + key) * 1024 + h * 64 + d8 * 8) = pack8(f);
    }
    for (int idx = gt; idx < 16 * 16 * 64 * 64; idx += ngt) {
        const int d = idx & 63, k8 = (idx >> 6) & 63, h = (idx >> 12) & 15, b = idx >> 16;
        const float* src = cv + (((size_t)b * 16 + h) * 512 + k8 * 8) * 64 + d; float f[8];
#pragma unroll
        for (int j = 0; j < 8; ++j) f[j] = src[j * 64];
        *(v4u*)(Vt + (size_t)(h * 64 + d) * LDV + MT + b * 512 + k8 * 8) = pack8(f);
    }
}
__device__ __forceinline__ void attn_phase(const Args& a, int o, LAS unsigned char* lds) {
    const int tid = tid_opaque(), lane = tid & 63, wave = tid >> 6;
    const int gw = blockIdx.x * NWAVES + wave, ngw = gridDim.x * NWAVES;
    const bf16* Q = (const bf16*)(a.ws + OFF_BIG); const bf16* Kb = Q + BIG_K; const bf16* Vt = Q + BIG_VT;
    bf16* O = (bf16*)(a.ws + OFF_R1);
    LAS float* bias = (LAS float*)lds;
    constexpr int KVP = 72;
    LAS bf16* KT = (LAS bf16*)(lds + 16512);
    LAS bf16* VT = KT + 2 * 64 * KVP;
    for (int i = tid; i < 16 * 257; i += NTHREADS) bias[i] = a.in[24][(size_t)o * 16 * 257 + i] * 1.4426950408889634f;
    __syncthreads();
    const int i16 = lane & 15, g = lane >> 4;
    const int keyoff = 8 * (i16 >> 2) + (i16 & 3);
    {
        const int wu = __builtin_amdgcn_readfirstlane(wave);
        const int srow = tid >> 3, sseg = (tid & 7) * 8;
#pragma unroll 1
        for (int unit = blockIdx.x; unit < 4096; unit += gridDim.x) {
            const int b = unit >> 9, h = (unit >> 5) & 15, c0 = (unit & 31) * 4;
            const int c = c0 + (wu >> 1), half = wu & 1;
            const size_t qrow0 = (size_t)b * TPR + c * 64 + half * 32;
            const int qpos0 = c * 64 + half * 32;
            const int kc_lo = c0 >= 8 ? c0 - 8 : 0, kc_hi = c0 + 3, my_lo = c >= 8 ? c - 8 : 0;
            const LAS float* bh = bias + h * 257 + 128;
            const float bfar = bh[128];
            bf16x8 qf[2][2];
#pragma unroll
            for (int qt = 0; qt < 2; ++qt)
#pragma unroll
                for (int kk = 0; kk < 2; ++kk) qf[qt][kk] = ld_frag(Q + (qrow0 + 16 * qt + i16) * 1024 + h * 64 + 32 * kk + 8 * g);
            f32x4 ot[4][2];
#pragma unroll
            for (int dt = 0; dt < 4; ++dt) { ot[dt][0] = (f32x4){0.f, 0.f, 0.f, 0.f}; ot[dt][1] = (f32x4){0.f, 0.f, 0.f, 0.f}; }
            float mrun[2] = {-1e30f, -1e30f}, lrun[2] = {0.f, 0.f};
            const bf16* kg_ = Kb + ((size_t)b * TPR + srow) * 1024 + h * 64 + sseg;
            const bf16* vg_ = Vt + (size_t)(h * 64 + srow) * LDV + (size_t)b * TPR + sseg;
            v4u kreg = *(const v4u*)(kg_ + (size_t)(64 * kc_lo) * 1024), vreg = *(const v4u*)(vg_ + 64 * kc_lo);
            *(LAS v4u*)(KT + srow * KVP + sseg) = kreg; *(LAS v4u*)(VT + srow * KVP + sseg) = vreg;
            __syncthreads();
#pragma unroll 1
            for (int kc = kc_lo; kc <= kc_hi; ++kc) {
                const int buf = (kc - kc_lo) & 1;
                if (kc < kc_hi) { kreg = *(const v4u*)(kg_ + (size_t)(64 * (kc + 1)) * 1024); vreg = *(const v4u*)(vg_ + 64 * (kc + 1)); }
                if (kc >= my_lo && kc <= c) {
                    const int kpos0 = 64 * kc;
                    const LAS bf16* kt = KT + buf * 64 * KVP + keyoff * KVP + 8 * g; const LAS bf16* vt = VT + buf * 64 * KVP + i16 * KVP + 8 * g;
                    f32x4 st[4][2];
#pragma unroll
                    for (int t4 = 0; t4 < 4; ++t4) {
                        const LAS bf16* p = kt + (32 * (t4 >> 1) + 4 * (t4 & 1)) * KVP;
                        const bf16x8 k0 = *(const LAS bf16x8*)p, k1 = *(const LAS bf16x8*)(p + 32);
#pragma unroll
                        for (int qt = 0; qt < 2; ++qt) {
                            f32x4 acc = {0.f, 0.f, 0.f, 0.f};
                            acc = __builtin_amdgcn_mfma_f32_16x16x32_bf16(k0, qf[qt][0], acc, 0, 0, 0);
                            acc = __builtin_amdgcn_mfma_f32_16x16x32_bf16(k1, qf[qt][1], acc, 0, 0, 0);
                            st[t4][qt] = acc;
                        }
                    }
                    const bool far = qpos0 - (kpos0 + 63) >= 128;
                    bf16x8 pf[2][2];
#pragma unroll
                    for (int qt = 0; qt < 2; ++qt) {
                        const int qpos = qpos0 + 16 * qt + i16;
                        float mx = -1e30f;
                        float boff = 0.f;
                        if (far) {
#pragma unroll
                            for (int t4 = 0; t4 < 4; ++t4)
#pragma unroll
                                for (int j = 0; j < 4; ++j) mx = fmaxf(mx, st[t4][qt][j]);
                            mx += bfar; boff = bfar;
                        } else {
#pragma unroll
                            for (int t4 = 0; t4 < 4; ++t4)
#pragma unroll
                                for (int j = 0; j < 4; ++j) {
                                    int rel = qpos - (kpos0 + 32 * (t4 >> 1) + 8 * g + 4 * (t4 & 1) + j); rel = rel > 128 ? 128 : (rel < -128 ? -128 : rel);
                                    const float sv = st[t4][qt][j] + bh[rel]; st[t4][qt][j] = sv; mx = fmaxf(mx, sv);
                                }
                        }
                        mx = fmaxf(mx, __shfl_xor(mx, 16)); mx = fmaxf(mx, __shfl_xor(mx, 32));
                        const float mnew = fmaxf(mrun[qt], mx), corr = __builtin_amdgcn_exp2f(mrun[qt] - mnew), msub = mnew - boff; mrun[qt] = mnew;
                        float psum = 0.f;
#pragma unroll
                        for (int sb = 0; sb < 2; ++sb) {
                            float p[8];
#pragma unroll
                            for (int T = 0; T < 2; ++T)
#pragma unroll
                                for (int j = 0; j < 4; ++j) { p[4 * T + j] = __builtin_amdgcn_exp2f(st[2 * sb + T][qt][j] - msub); psum += p[4 * T + j]; }
                            pf[sb][qt] = __builtin_bit_cast(bf16x8, pack8(p));
                        }
                        lrun[qt] = lrun[qt] * corr + psum;
#pragma unroll
                        for (int dt = 0; dt < 4; ++dt) ot[dt][qt] *= corr;
                    }
#pragma unroll
                    for (int sb = 0; sb < 2; ++sb)
#pragma unroll
                        for (int dt = 0; dt < 4; ++dt) {
                            const bf16x8 vf = *(const LAS bf16x8*)(vt + 16 * dt * KVP + 32 * sb);
#pragma unroll
                            for (int qt = 0; qt < 2; ++qt) ot[dt][qt] = __builtin_amdgcn_mfma_f32_16x16x32_bf16(vf, pf[sb][qt], ot[dt][qt], 0, 0, 0);
                        }
                }
                if (kc < kc_hi) { *(LAS v4u*)(KT + (buf ^ 1) * 64 * KVP + srow * KVP + sseg) = kreg; *(LAS v4u*)(VT + (buf ^ 1) * 64 * KVP + srow * KVP + sseg) = vreg; }
                __syncthreads();
            }
#pragma unroll
            for (int qt = 0; qt < 2; ++qt) {
                float l = lrun[qt]; l += __shfl_xor(l, 16); l += __shfl_xor(l, 32);
                const float inv = 1.0f / l;
                bf16* op = O + (qrow0 + 16 * qt + i16) * 1024 + h * 64 + 4 * g;
#pragma unroll
                for (int dt = 0; dt < 4; ++dt) { const f32x4 v = ot[dt][qt] * inv; v2u w; w.x = cvt_pk_bf16(v[0], v[1]); w.y = cvt_pk_bf16(v[2], v[3]); *(v2u*)(op + 16 * dt) = w; }
            }
        }
    }
#pragma unroll 1
    for (int it = 32768 + gw; it < 32768 + 512; it += ngw) {
        const bool samp = it >= 32768;
        int b, c, h, half;
        if (!samp) { b = it >> 12; c = (it >> 5) & 127; h = (it >> 1) & 15; half = it & 1; }
        else { const int r = it - 32768; b = r >> 5; c = 8; h = (r >> 1) & 15; half = r & 1; }
        const size_t qrow0 = samp ? (size_t)MP + b * 64 + half * 32 : (size_t)b * TPR + c * 64 + half * 32;
        const int qpos0 = c * 64 + half * 32;
        const int kstart = c >= 8 ? c * 64 - 512 : 0, nkb = (c * 64 + 64 - kstart) >> 6;
        const size_t kbase = samp ? (size_t)MT + b * 512 : (size_t)b * TPR + kstart;
        const size_t knew = (size_t)MP + b * 64;
        const LAS float* bh = bias + h * 257 + 128;
        const float bfar = bh[128];
        bf16x8 qf[2][2];
#pragma unroll
        for (int qt = 0; qt < 2; ++qt)
#pragma unroll
            for (int kk = 0; kk < 2; ++kk) qf[qt][kk] = ld_frag(Q + (qrow0 + 16 * qt + i16) * 1024 + h * 64 + 32 * kk + 8 * g);
        f32x4 ot[4][2];
#pragma unroll
        for (int dt = 0; dt < 4; ++dt) { ot[dt][0] = (f32x4){0.f, 0.f, 0.f, 0.f}; ot[dt][1] = (f32x4){0.f, 0.f, 0.f, 0.f}; }
        float mrun[2] = {-1e30f, -1e30f}, lrun[2] = {0.f, 0.f};
        bf16x8 kc[4][2], kn[4][2];
        {   const bf16* kp = Kb + (kbase + keyoff) * 1024 + h * 64 + 8 * g;
#pragma unroll
            for (int t4 = 0; t4 < 4; ++t4) { const bf16* p = kp + (size_t)(32 * (t4 >> 1) + 4 * (t4 & 1)) * 1024; kc[t4][0] = ld_frag(p); kc[t4][1] = ld_frag(p + 32); } }
#pragma unroll 1
        for (int kb = 0; kb < nkb; ++kb) {
            const int kpos0 = kstart + 64 * kb;
            const size_t krow0 = (samp && kb == 8) ? knew : kbase + 64 * kb;
            bf16x8 vf[2][4];
            {   const bf16* vp = Vt + (size_t)(h * 64 + i16) * LDV + krow0 + 8 * g;
#pragma unroll
                for (int sb = 0; sb < 2; ++sb)
#pragma unroll
                    for (int dt = 0; dt < 4; ++dt) vf[sb][dt] = ld_frag(vp + (size_t)(16 * dt) * LDV + 32 * sb); }
            if (kb + 1 < nkb) {
                const size_t krow1 = (samp && kb + 1 == 8) ? knew : kbase + 64 * (kb + 1);
                const bf16* kp = Kb + (krow1 + keyoff) * 1024 + h * 64 + 8 * g;
#pragma unroll
                for (int t4 = 0; t4 < 4; ++t4) { const bf16* p = kp + (size_t)(32 * (t4 >> 1) + 4 * (t4 & 1)) * 1024; kn[t4][0] = ld_frag(p); kn[t4][1] = ld_frag(p + 32); }
            }
            f32x4 st[4][2];
#pragma unroll
            for (int t4 = 0; t4 < 4; ++t4)
#pragma unroll
                for (int qt = 0; qt < 2; ++qt) {
                    f32x4 acc = {0.f, 0.f, 0.f, 0.f};
                    acc = __builtin_amdgcn_mfma_f32_16x16x32_bf16(kc[t4][0], qf[qt][0], acc, 0, 0, 0);
                    acc = __builtin_amdgcn_mfma_f32_16x16x32_bf16(kc[t4][1], qf[qt][1], acc, 0, 0, 0);
                    st[t4][qt] = acc;
                }
            const bool far = qpos0 - (kpos0 + 63) >= 128;
            bf16x8 pf[2][2];
#pragma unroll
            for (int qt = 0; qt < 2; ++qt) {
                const int qpos = qpos0 + 16 * qt + i16;
                float mx = -1e30f;
                float boff = 0.f;
                if (far) {
#pragma unroll
                    for (int t4 = 0; t4 < 4; ++t4)
#pragma unroll
                        for (int j = 0; j < 4; ++j) mx = fmaxf(mx, st[t4][qt][j]);
                    mx += bfar; boff = bfar;
                } else {
#pragma unroll
                    for (int t4 = 0; t4 < 4; ++t4)
#pragma unroll
                        for (int j = 0; j < 4; ++j) {
                            int rel = qpos - (kpos0 + 32 * (t4 >> 1) + 8 * g + 4 * (t4 & 1) + j); rel = rel > 128 ? 128 : (rel < -128 ? -128 : rel);
                            const float s = st[t4][qt][j] + bh[rel]; st[t4][qt][j] = s; mx = fmaxf(mx, s);
                        }
                }
                mx = fmaxf(mx, __shfl_xor(mx, 16)); mx = fmaxf(mx, __shfl_xor(mx, 32));
                const float mnew = fmaxf(mrun[qt], mx), corr = __builtin_amdgcn_exp2f(mrun[qt] - mnew), msub = mnew - boff; mrun[qt] = mnew;
                float psum = 0.f;
#pragma unroll
                for (int sb = 0; sb < 2; ++sb) {
                    float p[8];
#pragma unroll
                    for (int T = 0; T < 2; ++T)
#pragma unroll
                        for (int j = 0; j < 4; ++j) { p[4 * T + j] = __builtin_amdgcn_exp2f(st[2 * sb + T][qt][j] - msub); psum += p[4 * T + j]; }
                    pf[sb][qt] = __builtin_bit_cast(bf16x8, pack8(p));
                }
                lrun[qt] = lrun[qt] * corr + psum;
#pragma unroll
                for (int dt = 0; dt < 4; ++dt) ot[dt][qt] *= corr;
            }
#pragma unroll
            for (int sb = 0; sb < 2; ++sb)
#pragma unroll
                for (int dt = 0; dt < 4; ++dt)
#pragma unroll
                    for (int qt = 0; qt < 2; ++qt) ot[dt][qt] = __builtin_amdgcn_mfma_f32_16x16x32_bf16(vf[sb][dt], pf[sb][qt], ot[dt][qt], 0, 0, 0);
#pragma unroll
            for (int t4 = 0; t4 < 4; ++t4) { kc[t4][0] = kn[t4][0]; kc[t4][1] = kn[t4][1]; }
        }
#pragma unroll
        for (int qt = 0; qt < 2; ++qt) {
            float l = lrun[qt]; l += __shfl_xor(l, 16); l += __shfl_xor(l, 32);
            const float inv = 1.0f / l;
            bf16* op = O + (qrow0 + 16 * qt + i16) * 1024 + h * 64 + 4 * g;
#pragma unroll
            for (int dt = 0; dt < 4; ++dt) { const f32x4 v = ot[dt][qt] * inv; v2u w; w.x = cvt_pk_bf16(v[0], v[1]); w.y = cvt_pk_bf16(v[2], v[3]); *(v2u*)(op + 16 * dt) = w; }
        }
    }
    const int gt = blockIdx.x * NTHREADS + tid, ngt = gridDim.x * NTHREADS;
    for (int idx = gt; idx < 8 * 16 * 512 * 8; idx += ngt) {
        const int d8 = idx & 7, r = (idx >> 3) & 511, h = (idx >> 12) & 15, b = idx >> 16;
        float f[8]; unpack8(*(const v4u*)(Kb + ((size_t)b * TPR + 7680 + r) * 1024 + h * 64 + d8 * 8), f);
        float* dst = a.out + O_PK + ((((size_t)o * 8 + b) * 16 + h) * 512 + r) * 64 + d8 * 8;
        *(f32x4*)dst = (f32x4){f[0], f[1], f[2], f[3]}; *(f32x4*)(dst + 4) = (f32x4){f[4], f[5], f[6], f[7]};
    }
    for (int idx = gt; idx < 8 * 16 * 64 * 64; idx += ngt) {
        const int r8 = idx & 63, d = (idx >> 6) & 63, h = (idx >> 12) & 15, b = idx >> 16;
        float f[8]; unpack8(*(const v4u*)(Vt + (size_t)(h * 64 + d) * LDV + (size_t)b * TPR + 7680 + r8 * 8), f);
        float* dst = a.out + O_PV + ((((size_t)o * 8 + b) * 16 + h) * 512 + r8 * 8) * 64 + d;
#pragma unroll
        for (int j = 0; j < 8; ++j) dst[j * 64] = f[j];
    }
    for (int idx = gt; idx < 16 * 16 * 64 * 8; idx += ngt) {
        const int d8 = idx & 7, t = (idx >> 3) & 63, h = (idx >> 9) & 15, b = idx >> 13;
        float f[8]; unpack8(*(const v4u*)(Kb + ((size_t)MP + b * 64 + t) * 1024 + h * 64 + d8 * 8), f);
        float* dst = a.out + O_SK + ((((size_t)o * 16 + b) * 16 + h) * 64 + t) * 64 + d8 * 8;
        *(f32x4*)dst = (f32x4){f[0], f[1], f[2], f[3]}; *(f32x4*)(dst + 4) = (f32x4){f[4], f[5], f[6], f[7]};
    }
    for (int idx = gt; idx < 16 * 16 * 64 * 8; idx += ngt) {
        const int t8 = idx & 7, d = (idx >> 3) & 63, h = (idx >> 9) & 15, b = idx >> 13;
        float f[8]; unpack8(*(const v4u*)(Vt + (size_t)(h * 64 + d) * LDV + (size_t)MP + b * 64 + t8 * 8), f);
        float* dst = a.out + O_SV + ((((size_t)o * 16 + b) * 16 + h) * 64 + t8 * 8) * 64 + d;
#pragma unroll
        for (int j = 0; j < 8; ++j) dst[j * 64] = f[j];
    }
}

#define XB_TMO      128
#define XB_XCNT(j)  (256  + 64 * (j))
#define XB_XSUB(j)  (1280 + 64 * (j))
#define XB_XGEN(j)  (2304 + 64 * (j))
#define XB_TOP      3328
#define XB_TOPGEN   3392
#define XCD_BAR_WORDS 3456
#define XB_SPIN_CAP (1u << 18)

__device__ __forceinline__ unsigned xb_ld(unsigned* p)              { return __hip_atomic_load(p, __ATOMIC_RELAXED, __HIP_MEMORY_SCOPE_AGENT); }
__device__ __forceinline__ unsigned xb_add(unsigned* p, unsigned v) { return __hip_atomic_fetch_add(p, v, __ATOMIC_RELAXED, __HIP_MEMORY_SCOPE_AGENT); }
__device__ __forceinline__ unsigned xb_xcc_id() { return (unsigned)__builtin_amdgcn_s_getreg((3 << 11) | 20) & 0xFu; }
#define XB_SPIN(cond, bar) do { unsigned _sp = 0; while (cond) { __builtin_amdgcn_s_sleep(1); \
    if ((++_sp & 255u) == 0u) { if (xb_ld(&(bar)[XB_TMO])) break; if (_sp > XB_SPIN_CAP) { atomicAdd(&(bar)[XB_TMO], 1u); break; } } } } while (0)

struct XcdBarrier {
    unsigned* bar; unsigned x;
    volatile LAS unsigned* st;
};

__device__ __forceinline__ XcdBarrier xcd_barrier_post(unsigned* bar, volatile LAS unsigned* st) {
    XcdBarrier b; b.bar = bar; b.x = xb_xcc_id(); b.st = st;
    if (threadIdx.x == 0) (void)xb_add(&bar[XB_XCNT(b.x)], 1u);
    return b;
}
__device__ __forceinline__ void xcd_barrier_complete(unsigned* bar, unsigned x, unsigned& nloc, unsigned& nx) {
    const unsigned G = gridDim.x * gridDim.y * gridDim.z;
    unsigned sum, cnt, mine, sp = 0u;
    for (;;) {
        sum = 0u; cnt = 0u; mine = 0u;
#pragma unroll
        for (unsigned j = 0; j < 16; ++j) { const unsigned c = xb_ld(&bar[XB_XCNT(j)]); sum += c; cnt += (c > 0u) ? 1u : 0u; mine = (j == x) ? c : mine; }
        if (sum == G) break;
        __builtin_amdgcn_s_sleep(1);
        if ((++sp & 255u) == 0u) { if (xb_ld(&bar[XB_TMO])) break; if (sp > XB_SPIN_CAP) { atomicAdd(&bar[XB_TMO], 1u); break; } }
    }
    nloc = mine > 0u ? mine : 1u; nx = cnt > 0u ? cnt : 1u;
}

__device__ __forceinline__ void xcd_barrier(const XcdBarrier& b) {
    asm volatile("s_waitcnt vmcnt(0)" ::: "memory");
    __syncthreads();
    if (threadIdx.x == 0) {
        unsigned* bar = b.bar;
        __builtin_amdgcn_s_waitcnt(0);
        unsigned nloc = b.st[0], nx = b.st[1];
        if (nloc == 0u) { xcd_barrier_complete(bar, b.x, nloc, nx); b.st[0] = nloc; b.st[1] = nx; }
        const unsigned old = xb_add(&bar[XB_XSUB(b.x)], 1u);
        const unsigned gen = old / nloc;
        if (old + 1u == (gen + 1u) * nloc) {
            __builtin_amdgcn_fence(__ATOMIC_RELEASE, "agent");
            asm volatile("s_waitcnt vmcnt(0)" ::: "memory");
            const unsigned og = xb_add(&bar[XB_TOP], 1u);
            const unsigned tg = og / nx;
            if (og + 1u == (tg + 1u) * nx) xb_add(&bar[XB_TOPGEN], 1u);
            else XB_SPIN(xb_ld(&bar[XB_TOPGEN]) == tg, bar);
            __builtin_amdgcn_fence(__ATOMIC_ACQUIRE, "agent");
            xb_add(&bar[XB_XGEN(b.x)], 1u);
            asm volatile("s_waitcnt vmcnt(0)" ::: "memory");
        } else {
            XB_SPIN(xb_ld(&bar[XB_XGEN(b.x)]) == gen, bar);
            __builtin_amdgcn_fence(__ATOMIC_ACQUIRE, "agent");
            asm volatile("s_waitcnt vmcnt(0)" ::: "memory");
        }
    }
    __syncthreads();
}

#ifndef REP_GEMM
#define REP_GEMM 1
#endif
#ifndef REP_SCAN
#define REP_SCAN 1
#endif
#ifndef REP_ATTN
#define REP_ATTN 1
#endif
#ifndef REP_LN
#define REP_LN 1
#endif
#ifndef EXTRA_SYNC
#define EXTRA_SYNC 2
#endif
#ifndef PH_STOP
#define PH_STOP N_PHASES
#endif
#ifndef PHMASK
#define PHMASK 0xffff
#endif
#define PHM(i) (((PHMASK) >> (i)) & 1)
constexpr int NS_K1 = 4, NS_K2 = 11;
constexpr int PH_PER_PAIR = 19, N_PHASES = 1 + 2 * PH_PER_PAIR;
__global__ void __launch_bounds__(NTHREADS, 2) trunk_fwd(Args a) {
    __shared__ __attribute__((aligned(16))) unsigned char lds_raw[LDS_BYTES];
    LAS unsigned char* lds = (LAS unsigned char*)lds_raw;
    cg::grid_group grid = cg::this_grid();
    volatile LAS unsigned* bar_st = (volatile LAS unsigned*)(lds + 131072);
    if (threadIdx.x < 2) bar_st[threadIdx.x] = 0u;
    __syncthreads();
    XcdBarrier xbar = xcd_barrier_post((unsigned*)(a.ws + WS_BAR), bar_st);
    unsigned char* ws = a.ws;
    bf16* XB = (bf16*)(ws + OFF_XB); bf16* R1 = (bf16*)(ws + OFF_R1); bf16* Z = (bf16*)(ws + OFF_Z); bf16* BIG = (bf16*)(ws + OFF_BIG);
    const int G = gridDim.x, cb = blockIdx.x;
#pragma unroll 1
    for (int ph = a.ph_lo; ph < a.ph_hi; ++ph) {
        bool nosync = false;
        if (ph == 0) { if (PHM(0)) prologue_phase(a, lds); }
        else {
            const int e = (ph - 1) / PH_PER_PAIR, q = (ph - 1) - e * PH_PER_PAIR;
            const int layer = 2 * e + (q >= 11 ? 1 : 0);
            int kind = -1; pg8::Gemm g{nullptr, nullptr, MT, 0, 0, nullptr, nullptr};
            pg8::EpiBf16 eb{nullptr, 0, 0, 0, 1.f, nullptr, 0}; int m2 = 0, n2 = 0;
            switch (q) {
            case 0:  kind = 0; g = pg8::Gemm{XB, (const bf16*)(ws + W_IN + e * W_IN_SZ), MT, NMIX, 1024, nullptr, nullptr}; eb = pg8::EpiBf16{BIG, APROJ, APROJ, (size_t)MT * APROJ, 1.f, nullptr, 0}; break;
            case 2:  kind = 0; g = pg8::Gemm{Z, (const bf16*)(ws + W_LO + e * W_LO_SZ), MT, NLORA, KLORA, nullptr, nullptr}; eb = pg8::EpiBf16{R1, 512, 512, (size_t)MT * 512, 1.f, nullptr, 0}; break;
            case 11: kind = 0; g = pg8::Gemm{XB, (const bf16*)(ws + W_QKV + e * W_QKV_SZ), MT, 2048, 1024, (const bf16*)(ws + W_QKV + e * W_QKV_SZ) + (size_t)2048 * 1024, XB};
                     eb = pg8::EpiBf16{BIG, 1024, 1024, (size_t)MT * 1024, 0.125f * 1.4426950408889634f, BIG + BIG_VT, LDV}; m2 = 1024; n2 = MT; break;
            case 12: nosync = true; break;
            case 8: case 16: kind = 1; g = pg8::Gemm{XB, (const bf16*)(ws + W_FI + layer * W_FI_SZ), MT, 2 * FH, 1024, nullptr, nullptr}; break;
            case 6:  kind = 2; g = pg8::Gemm{R1, (const bf16*)(ws + W_OM + e * W_SQ_SZ), MT, 1024, 1024, nullptr, nullptr}; break;
            case 14: kind = 2; g = pg8::Gemm{R1, (const bf16*)(ws + W_O + e * W_SQ_SZ), MT, 1024, 1024, nullptr, nullptr}; break;
            case 9: case 17: kind = 2; g = pg8::Gemm{BIG, (const bf16*)(ws + W_FO + layer * W_FO_SZ), MT, 1024, FH, nullptr, nullptr}; break;
            default: break;
            }
            const int nrep = kind >= 0 ? REP_GEMM : (q == 4 ? REP_SCAN : (q == 13 ? REP_ATTN : ((q == 7 || q == 15 || q == 10 || q == 18) ? REP_LN : 1)));
            if (q == 11) cache_convert(a, e);
#pragma unroll 1
            for (int rep = 0; rep < nrep; ++rep) {
            if (kind == 0 && PHM(1)) { pg8::StaticOrder S; S.init(g.M, g.N, G, cb, g.K, q == 2 ? 1 : 0); if (m2) S.second(m2, n2); pg8::gemm_phase<pg8::EpiBf16, pg8::StaticOrder, true, true>(lds, g, S, eb); }
            else if (kind == 1 && PHM(2)) { pg8::StaticOrder S; S.init(g.M, g.N, G, cb, g.K); pg8::EpiSwiglu es{BIG, FH}; pg8::gemm_phase<pg8::EpiSwiglu, pg8::StaticOrder, true, true>(lds, g, S, es); }
            else if (kind == 2 && PHM(3)) { pg8::SplitOrder S; S.init(G, cb, g.K, g.K == 1024 ? NS_K1 : NS_K2); pg8::EpiResid er{XB, Z, 1024, DN_ALPHA, (float*)(ws + OFF_G)}; pg8::gemm_phase<pg8::EpiResid, pg8::SplitOrder, true, true>(lds, g, S, er); }
            else if (q == 1 && PHM(4)) prep1_phase(a, e);
            else if (q == 3 && PHM(5)) prep2_phase(a, e);
            else if (q == 4 && PHM(6)) scan_phase(a, e, lds);
            else if (q == 5 && PHM(7)) post_phase(a, e);
            else if (q == 13 && PHM(8)) attn_phase(a, e, lds);
            else if ((q == 7 || q == 15) && PHM(9)) ln_phase(a, a.in[26] + (size_t)layer * 1024, a.in[27] + (size_t)layer * 1024, nullptr, NS_K1);
            else if ((q == 10 || q == 18) && PHM(9)) ln_phase(a, a.in[28] + (size_t)layer * 1024, a.in[29] + (size_t)layer * 1024, (layer == 3) ? a.out : nullptr, NS_K2);
        }
        }
        if (ph + 1 < a.ph_hi && !nosync) { if (ph == 0) grid.sync(); else xcd_barrier(xbar); }
        else __syncthreads();
    }
}

extern "C" void kernel_launch(void* const* d_in, const int* in_sizes, int n_in, void* d_out, int out_size, void* d_ws, size_t ws_size, hipStream_t stream) {
    static int grid = 0; static int badsz = 0;
    if (grid == 0) {
        if (n_in != 32 || ws_size < WS_BAR + WS_BAR_BYTES || out_size != 92360704) { fprintf(stderr, "kernel_launch: unexpected shapes (n_in %d, ws %zu, out %d)\n", n_in, ws_size, out_size); grid = -1; return; }
        static const long long exp_sz[32] = {67108864LL, 1048576, 1048576, 57344, 1048576, 16777216, 16777216, 6848512, 3584, 1024, 65536, 1024, 65536, 131072, 1024, 1024, 1024, 1024, 1024, 8192, 512, 256, 2097152, 6291456, 8224, 2097152, 4096, 4096, 4096, 4096, 23068672, 11534336};
        for (int i = 0; i < 32; ++i) if ((long long)in_sizes[i] != exp_sz[i]) { fprintf(stderr, "kernel_launch: input %d has %d elements, expected %lld\n", i, in_sizes[i], exp_sz[i]); badsz = 1; }
        int dev = 0, cus = 0, per_cu = 0;
        hipGetDevice(&dev); hipDeviceGetAttribute(&cus, hipDeviceAttributeMultiprocessorCount, dev);
        if (hipOccupancyMaxActiveBlocksPerMultiprocessor(&per_cu, (const void*)trunk_fwd, NTHREADS, 0) != hipSuccess || per_cu < 1) { fprintf(stderr, "kernel_launch: occupancy query says %d\n", per_cu); per_cu = 1; }
        (void)hipGetLastError();
        grid = cus * per_cu;
    }
    if (grid < 0) return;
    Args a{};
    for (int i = 0; i < 32; ++i) a.in[i] = (const float*)d_in[i];
    a.out = (float*)d_out; a.ws = (unsigned char*)d_ws;
#if defined(MK_PER_PHASE)
    for (int p = 0; p < N_PHASES; ++p) { a.ph_lo = p; a.ph_hi = p + 1; hipLaunchKernelGGL(trunk_fwd, dim3(grid), dim3(NTHREADS), 0, stream, a); }
#else
    a.ph_lo = 0; a.ph_hi = badsz ? 0 : PH_STOP;
    if (hipMemsetAsync((char*)d_ws + WS_BAR, 0, WS_BAR_BYTES, stream) != hipSuccess) { fprintf(stderr, "kernel_launch: memset of the barrier words failed\n"); return; }
    void* args[] = {&a};
    hipError_t err = hipLaunchCooperativeKernel((const void*)trunk_fwd, dim3(grid), dim3(NTHREADS), args, 0, stream);
    if (err != hipSuccess) fprintf(stderr, "kernel_launch: cooperative launch failed: %s (grid %d)\n", hipGetErrorString(err), grid);
#endif
}
```

```cpp
#include <hip/hip_runtime.h>
#include <hip/hip_cooperative_groups.h>
#include <cstdio>
#include <cstdint>
namespace cg = cooperative_groups;
namespace pg8 {
#define PG8_LAS __attribute__((address_space(3)))
typedef unsigned short bf16_t;
typedef short bf16x8 __attribute__((ext_vector_type(8)));
typedef float f32x4 __attribute__((ext_vector_type(4)));
typedef unsigned u32x4 __attribute__((ext_vector_type(4)));
constexpr int BM = 256, BK = 64, HALF = 128, HTB = HALF * BK * 2  , STAGE_BYTES = 8 * HTB, NXCD = 8, WGM = 8;

__host__ __device__ __forceinline__ int lds_byte(int r, int c) { const int st = (r >> 4) * 2 + (c >> 5), rr = r & 15, cc = c & 31, ob = rr * 64 + cc * 2; return st * 1024 + (ob ^ (((ob >> 9) & 1) << 5)); }
__host__ __device__ __forceinline__ void stage_rc(int b, int& R, int& C) { const int st = b / 1024, sb = b % 1024, swz = sb ^ (((sb >> 9) & 1) << 5); R = (st >> 1) * 16 + swz / 64; C = (st & 1) * 32 + (swz % 64) / 2; }
__host__ __device__ __forceinline__ int perm32(int rho) { const int n = rho >> 4, i = rho & 15; return 8 * (i >> 2) + 4 * n + (i & 3); }

struct Unit { int pm, pn, k0, nt, sl, z; };
struct Gemm { const bf16_t* A; const bf16_t* Bt; int M, N, K; const bf16_t* A2; const bf16_t* Bt2; };

struct StaticOrder {
    int nM, nN, nwg, G, c, ntk, lora, nM2, nN2, nwg2;
    __host__ __device__ void init(int M, int N, int G_, int c_, int K_, int lora_ = 0) { nM = M / BM; nN = N / BM; nwg = nM * nN; G = G_; c = c_; ntk = K_ / BK; lora = lora_; nM2 = 0; nN2 = 0; nwg2 = 0; }
    __host__ __device__ void second(int M2, int N2) { nM2 = M2 / BM; nN2 = N2 / BM; nwg2 = nM2 * nN2; }
    __host__ __device__ bool next(int i, Unit& u) const {
        long L = (long)i * G + c; int nM_ = nM, nN_ = nN, nwg_ = nwg, z_ = 0;
        if (L >= nwg) { L -= nwg; if (L >= nwg2) return false; nM_ = nM2; nN_ = nN2; nwg_ = nwg2; z_ = 1; }
        int wgid = (int)L; { const int q = nwg_ / NXCD, r = nwg_ % NXCD, xcd = wgid % NXCD, off = wgid / NXCD; wgid = (xcd < r ? xcd * (q + 1) : r * (q + 1) + (xcd - r) * q) + off; }
        const int nig = WGM * nN_, gid = wgid / nig, fm = gid * WGM, gsz = (nM_ - fm) < WGM ? (nM_ - fm) : WGM;
        u.pm = fm + ((wgid % nig) % gsz); u.pn = (wgid % nig) / gsz; u.k0 = 0; u.nt = ntk; u.sl = -1; u.z = z_; if (lora) { u.k0 = u.pn < 4 ? 0 : 2; u.nt = 2; } return true;
    }
    __device__ __forceinline__ void a_ready(const Unit&) const {}
    __device__ __forceinline__ void done(const Unit&) const {}
};

struct SplitOrder {
    StaticOrder so; int NS, nts, G, c;
    __host__ __device__ void init(int G_, int c_, int K_, int NS_) { so.init(65536, 1024, G_, c_, K_); NS = NS_; nts = (K_ / BK) / NS_; G = G_; c = c_; }
    __host__ __device__ bool next(int i, Unit& u) const {
        if (so.next(i, u)) return true;
        const long L = (long)i * G + c - 1024; if (L < 0 || L >= 16 * NS) return false;
        const int tile = (int)L / NS, sl = (int)L - tile * NS;
        u.pm = 256 + (tile >> 2); u.pn = tile & 3; u.k0 = sl * nts; u.nt = nts; u.sl = sl; u.z = 0; return true;
    }
    __device__ __forceinline__ void a_ready(const Unit&) const {}
    __device__ __forceinline__ void done(const Unit&) const {}
};

__device__ __forceinline__ unsigned cvt_pk_bf16(float lo, float hi) { unsigned r; asm volatile("v_cvt_pk_bf16_f32 %0, %1, %2" : "=v"(r) : "v"(lo), "v"(hi)); return r; }
__device__ __forceinline__ float bf_lo(unsigned w) { return __uint_as_float(w << 16); }
__device__ __forceinline__ float bf_hi(unsigned w) { return __uint_as_float(w & 0xffff0000u); }
struct EpiBf16 {
    static constexpr bool PERM = true, AFTER_DRAIN = false;
    bf16_t* O; int ldc; int split_cols; size_t split_stride; float scale0; bf16_t* O2; int ldc2;
    __device__ __forceinline__ void operator()(const f32x4 (&acc)[2][2][4][2], const Unit& u, int wr, int wc, int fr, int fq) const {
        const int row0 = u.pm * BM + wr * 64 + fr; int colt = u.pn * BM; bf16_t* base = u.z ? O2 : O; const int ldc = u.z ? ldc2 : this->ldc;
        float sc = 1.f; if (split_cols && !u.z) { const int t = colt / split_cols; base += (size_t)t * split_stride; colt -= t * split_cols; if (t == 0) sc = scale0; }
        const int col0 = colt + wc * 32 + 8 * fq;
#pragma unroll
        for (int ai = 0; ai < 2; ++ai)
#pragma unroll
            for (int m = 0; m < 4; ++m) { bf16_t* rowp = base + (size_t)(row0 + ai * HALF + m * 16) * ldc + col0;
#pragma unroll
                for (int bj = 0; bj < 2; ++bj) { const f32x4 v0 = acc[ai][bj][m][0] * sc, v1 = acc[ai][bj][m][1] * sc;
                    u32x4 w; w.x = cvt_pk_bf16(v0[0], v0[1]); w.y = cvt_pk_bf16(v0[2], v0[3]); w.z = cvt_pk_bf16(v1[0], v1[1]); w.w = cvt_pk_bf16(v1[2], v1[3]);
                    *(u32x4*)(rowp + bj * HALF) = w; } }
    }
};
__device__ __forceinline__ float silu_f(float x) { return x * __builtin_amdgcn_rcpf(1.0f + __expf(-x)); }
struct EpiSwiglu {
    static constexpr bool PERM = true, AFTER_DRAIN = false;
    bf16_t* O; int ldc;
    __device__ __forceinline__ void operator()(const f32x4 (&acc)[2][2][4][2], const Unit& u, int wr, int wc, int fr, int fq) const {
        const int row0 = u.pm * BM + wr * 64 + fr; const int col0 = u.pn * HALF + wc * 32 + 8 * fq;
#pragma unroll
        for (int ai = 0; ai < 2; ++ai)
#pragma unroll
            for (int m = 0; m < 4; ++m) { bf16_t* rowp = O + (size_t)(row0 + ai * HALF + m * 16) * ldc + col0;
                const f32x4 g0 = acc[ai][0][m][0], g1 = acc[ai][0][m][1], u0 = acc[ai][1][m][0], u1 = acc[ai][1][m][1];
                u32x4 w;
                w.x = cvt_pk_bf16(silu_f(g0[0]) * u0[0], silu_f(g0[1]) * u0[1]); w.y = cvt_pk_bf16(silu_f(g0[2]) * u0[2], silu_f(g0[3]) * u0[3]);
                w.z = cvt_pk_bf16(silu_f(g1[0]) * u1[0], silu_f(g1[1]) * u1[1]); w.w = cvt_pk_bf16(silu_f(g1[2]) * u1[2], silu_f(g1[3]) * u1[3]);
                *(u32x4*)rowp = w; }
    }
};
struct EpiResid {
    static constexpr bool PERM = true, AFTER_DRAIN = false;
    const bf16_t* X; bf16_t* Z; int ldc; float alpha; float* ZS;
    __device__ __forceinline__ void operator()(const f32x4 (&acc)[2][2][4][2], const Unit& u, int wr, int wc, int fr, int fq) const {
        const int row0 = u.pm * BM + wr * 64 + fr; const int col0 = u.pn * BM + wc * 32 + 8 * fq;
        if (u.sl >= 0) {
            float* zs = ZS + ((size_t)u.sl * 1024 + (row0 - 65536)) * 1024 + col0;
#pragma unroll
            for (int ai = 0; ai < 2; ++ai)
#pragma unroll
                for (int m = 0; m < 4; ++m)
#pragma unroll
                    for (int bj = 0; bj < 2; ++bj) { float* q = zs + (size_t)(ai * HALF + m * 16) * 1024 + bj * HALF; *(f32x4*)q = acc[ai][bj][m][0]; *(f32x4*)(q + 4) = acc[ai][bj][m][1]; }
            return;
        }
#pragma unroll
        for (int ai = 0; ai < 2; ++ai)
#pragma unroll
            for (int m = 0; m < 4; ++m) { const size_t off = (size_t)(row0 + ai * HALF + m * 16) * ldc + col0;
#pragma unroll
                for (int bj = 0; bj < 2; ++bj) { const u32x4 x = *(const u32x4*)(X + off + bj * HALF);
                    const f32x4 v0 = acc[ai][bj][m][0], v1 = acc[ai][bj][m][1];
                    u32x4 w;
                    w.x = cvt_pk_bf16(alpha * bf_lo(x.x) + v0[0], alpha * bf_hi(x.x) + v0[1]); w.y = cvt_pk_bf16(alpha * bf_lo(x.y) + v0[2], alpha * bf_hi(x.y) + v0[3]);
                    w.z = cvt_pk_bf16(alpha * bf_lo(x.z) + v1[0], alpha * bf_hi(x.z) + v1[1]); w.w = cvt_pk_bf16(alpha * bf_lo(x.w) + v1[2], alpha * bf_hi(x.w) + v1[3]);
                    *(u32x4*)(Z + off + bj * HALF) = w; } }
    }
};
template <class Epi, class Sched, bool ALIGN_EPI = false, bool SP2 = false>
__device__ __forceinline__ void gemm_phase(PG8_LAS unsigned char* lds, const Gemm g, const Sched& S, const Epi& E) {
    int tid = threadIdx.x; asm volatile("" : "+v"(tid)); const int wid = __builtin_amdgcn_readfirstlane(tid >> 6), lane = tid & 63, wr = wid >> 2, wc = wid & 3, fr = lane & 15, fq = lane >> 4;
    const int K = g.K;
    unsigned voffA[2], voffB[2];
#pragma unroll
    for (int i = 0; i < 2; ++i) { int R, C; stage_rc(tid * 16 + i * 8192, R, C); const int Rb = Epi::PERM ? ((R & ~31) + perm32(R & 31)) : R;
        voffA[i] = (unsigned)(R * K + C) * 2u; voffB[i] = (unsigned)(Rb * K + C) * 2u; }
    const size_t kstep = (size_t)(BK * 2);
    const size_t hstep = (size_t)HALF * K * 2;
    const size_t tstep = 2 * hstep;
    const unsigned ldsw = (unsigned)wid * 1024u;
    const int aoff = lds_byte(wr * 64 + fr, fq * 8), boff = lds_byte(wc * 32 + fr, fq * 8);
#define PG8_SA(b, h) (((b) * 2 + (h)) * HTB)
#define PG8_SB(b, h) ((4 + (b) * 2 + (h)) * HTB)
#define PG8_STAGE(bufoff, gbase, voff) do { _Pragma("unroll") for (int _i = 0; _i < 2; ++_i) \
        __builtin_amdgcn_global_load_lds((const unsigned*)((const char*)(gbase) + (voff)[_i]), (PG8_LAS unsigned*)(lds + (bufoff) + ldsw + _i * 8192), 16, 0, 0); } while (0)
#define PG8_LDA(dst, b, h) do { _Pragma("unroll") for (int m = 0; m < 4; ++m) _Pragma("unroll") for (int k = 0; k < 2; ++k) dst[m][k] = *(const PG8_LAS bf16x8*)(lds + PG8_SA(b, h) + aoff + m * 2048 + k * 1024); } while (0)
#define PG8_LDB(dst, b, h) do { _Pragma("unroll") for (int n = 0; n < 2; ++n) _Pragma("unroll") for (int k = 0; k < 2; ++k) dst[n][k] = *(const PG8_LAS bf16x8*)(lds + PG8_SB(b, h) + boff + n * 2048 + k * 1024); } while (0)
#define PG8_MMA(ai, bj, At, Bt) do { __builtin_amdgcn_s_setprio(1); _Pragma("unroll") for (int m = 0; m < 4; ++m) _Pragma("unroll") for (int n = 0; n < 2; ++n) _Pragma("unroll") for (int k = 0; k < 2; ++k) \
        acc[ai][bj][m][n] = __builtin_amdgcn_mfma_f32_16x16x32_bf16(Bt[n][k], At[m][k], acc[ai][bj][m][n], 0, 0, 0); __builtin_amdgcn_s_setprio(0); } while (0)
#define PG8_WAIT_V(n) asm volatile("s_waitcnt vmcnt(" #n ")" ::: "memory")
#define PG8_WAIT_L(n) asm volatile("s_waitcnt lgkmcnt(" #n ")" ::: "memory")
#define PG8_BAR __builtin_amdgcn_s_barrier()
#define PG8_SCHED __builtin_amdgcn_sched_barrier(0)
    Unit cur, nxt; int ui = 0;
    if (!S.next(0, cur)) return;
    f32x4 acc[2][2][4][2];
#pragma unroll
    for (int a = 0; a < 2; ++a)
#pragma unroll
        for (int b = 0; b < 2; ++b)
#pragma unroll
            for (int m = 0; m < 4; ++m)
#pragma unroll
                for (int n = 0; n < 2; ++n) acc[a][b][m][n] = (f32x4){0.f, 0.f, 0.f, 0.f};
    bf16x8 At[4][2], B0[2][2], B1[2][2];
    const char* cA = (const char*)(cur.z ? g.A2 : g.A) + (size_t)cur.pm * tstep + (size_t)cur.k0 * kstep; const char* cB = (const char*)(cur.z ? g.Bt2 : g.Bt) + (size_t)cur.pn * tstep + (size_t)cur.k0 * kstep;
    S.a_ready(cur);
    if constexpr (SP2) {
        PG8_STAGE(PG8_SB(0, 0), cB, voffB); PG8_STAGE(PG8_SB(0, 1), cB + hstep, voffB); PG8_STAGE(PG8_SA(0, 0), cA, voffA); PG8_STAGE(PG8_SA(0, 1), cA + hstep, voffA);
        if (wr == 1) PG8_BAR;
        PG8_WAIT_V(2); PG8_BAR;
        PG8_STAGE(PG8_SB(1, 0), cB + kstep, voffB); PG8_STAGE(PG8_SA(1, 0), cA + kstep, voffA); PG8_STAGE(PG8_SB(1, 1), cB + hstep + kstep, voffB);
        PG8_WAIT_V(6); PG8_BAR;
    } else {
        PG8_STAGE(PG8_SB(0, 0), cB, voffB); PG8_STAGE(PG8_SA(0, 0), cA, voffA); PG8_STAGE(PG8_SB(0, 1), cB + hstep, voffB); PG8_STAGE(PG8_SA(0, 1), cA + hstep, voffA);
        if (wr == 1) PG8_BAR;
        PG8_WAIT_V(4); PG8_BAR;
        PG8_STAGE(PG8_SB(1, 0), cB + kstep, voffB); PG8_STAGE(PG8_SA(1, 0), cA + kstep, voffA); PG8_STAGE(PG8_SB(1, 1), cB + hstep + kstep, voffB);
        PG8_WAIT_V(6); PG8_BAR;
    }
    for (;;) {
        const bool has_next = S.next(ui + 1, nxt);
        const char* nA = has_next ? (const char*)(nxt.z ? g.A2 : g.A) + (size_t)nxt.pm * tstep + (size_t)nxt.k0 * kstep : cA; const char* nB = has_next ? (const char*)(nxt.z ? g.Bt2 : g.Bt) + (size_t)nxt.pn * tstep + (size_t)nxt.k0 * kstep : cB;
        const int nt = cur.nt;
        for (int t = 0; t < nt; t += 2) {
            const bool last = (t == nt - 2);
            const char* a1 = cA + (size_t)(t + 1) * kstep;
            const char* a2 = last ? nA : cA + (size_t)(t + 2) * kstep; const char* b2 = last ? nB : cB + (size_t)(t + 2) * kstep;
            const char* a3 = a2 + kstep; const char* b3 = b2 + kstep;
            if (last && has_next) S.a_ready(nxt);
            if constexpr (SP2) {
            PG8_LDB(B0, 0, 0); PG8_LDB(B1, 0, 1); PG8_SCHED; PG8_LDA(At, 0, 0); PG8_STAGE(PG8_SA(1, 1), a1 + hstep, voffA);
            PG8_WAIT_V(8); PG8_WAIT_L(0); PG8_BAR; PG8_MMA(0, 0, At, B0); PG8_MMA(0, 1, At, B1); PG8_BAR; PG8_SCHED;
            PG8_LDA(At, 0, 1); PG8_STAGE(PG8_SB(0, 0), b2, voffB); PG8_STAGE(PG8_SB(0, 1), b2 + hstep, voffB); PG8_STAGE(PG8_SA(0, 0), a2, voffA);
            PG8_WAIT_V(8); PG8_WAIT_L(0); PG8_BAR; PG8_MMA(1, 0, At, B0); PG8_MMA(1, 1, At, B1); PG8_BAR; PG8_SCHED;
            PG8_LDB(B0, 1, 0); PG8_LDB(B1, 1, 1); PG8_SCHED; PG8_LDA(At, 1, 0); PG8_STAGE(PG8_SA(0, 1), a2 + hstep, voffA);
            PG8_WAIT_V(8); PG8_WAIT_L(0); PG8_BAR; PG8_MMA(0, 0, At, B0); PG8_MMA(0, 1, At, B1); PG8_BAR; PG8_SCHED;
            PG8_LDA(At, 1, 1); PG8_STAGE(PG8_SB(1, 0), b3, voffB); PG8_STAGE(PG8_SB(1, 1), b3 + hstep, voffB); PG8_STAGE(PG8_SA(1, 0), a3, voffA);
            PG8_WAIT_V(8); PG8_WAIT_L(0); PG8_BAR; PG8_MMA(1, 0, At, B0); PG8_MMA(1, 1, At, B1); PG8_BAR; PG8_SCHED;
            } else {
            PG8_LDB(B0, 0, 0); PG8_SCHED; PG8_LDA(At, 0, 0); PG8_STAGE(PG8_SA(1, 1), a1 + hstep, voffA);
            PG8_WAIT_L(8); PG8_BAR; PG8_WAIT_L(0); PG8_MMA(0, 0, At, B0); PG8_BAR; PG8_SCHED;
            PG8_LDB(B1, 0, 1); PG8_STAGE(PG8_SB(0, 0), b2, voffB);
            PG8_BAR; PG8_WAIT_L(0); PG8_MMA(0, 1, At, B1); PG8_BAR;
            PG8_LDA(At, 0, 1); PG8_STAGE(PG8_SA(0, 0), a2, voffA);
            PG8_BAR; PG8_WAIT_L(0); PG8_MMA(1, 0, At, B0); PG8_BAR; PG8_SCHED;
            PG8_STAGE(PG8_SB(0, 1), b2 + hstep, voffB);
            PG8_WAIT_V(6); PG8_BAR; PG8_MMA(1, 1, At, B1); PG8_BAR;
            PG8_LDB(B0, 1, 0); PG8_SCHED; PG8_LDA(At, 1, 0); PG8_STAGE(PG8_SA(0, 1), a2 + hstep, voffA);
            PG8_WAIT_L(8); PG8_BAR; PG8_WAIT_L(0); PG8_MMA(0, 0, At, B0); PG8_BAR; PG8_SCHED;
            PG8_LDB(B1, 1, 1); PG8_STAGE(PG8_SB(1, 0), b3, voffB);
            PG8_BAR; PG8_WAIT_L(0); PG8_MMA(0, 1, At, B1); PG8_BAR;
            PG8_LDA(At, 1, 1); PG8_STAGE(PG8_SA(1, 0), a3, voffA);
            PG8_BAR; PG8_WAIT_L(0); PG8_MMA(1, 0, At, B0); PG8_BAR; PG8_SCHED;
            PG8_STAGE(PG8_SB(1, 1), b3 + hstep, voffB);
            PG8_WAIT_V(6); PG8_BAR; PG8_MMA(1, 1, At, B1); PG8_BAR;
            }
        }
        if constexpr (ALIGN_EPI) { if (wr == 0) PG8_BAR; }
        if constexpr (!Epi::AFTER_DRAIN) { E(acc, cur, wr, wc, fr, fq); S.done(cur); }
        if (!has_next) break;
#pragma unroll
        for (int a = 0; a < 2; ++a)
#pragma unroll
            for (int b = 0; b < 2; ++b)
#pragma unroll
                for (int m = 0; m < 4; ++m)
#pragma unroll
                    for (int n = 0; n < 2; ++n) acc[a][b][m][n] = (f32x4){0.f, 0.f, 0.f, 0.f};
        cur = nxt; cA = nA; cB = nB; ++ui;
        if constexpr (ALIGN_EPI) { if (wr == 1) PG8_BAR; }
    }
    PG8_WAIT_V(0);
    if constexpr (!ALIGN_EPI) { if (wr == 0) PG8_BAR; }
    PG8_BAR;
    if constexpr (Epi::AFTER_DRAIN) { E.fused(acc, cur, wr, wc, fr, fq, lds, wid, lane); S.done(cur); }
#undef PG8_SA
#undef PG8_SB
#undef PG8_STAGE
#undef PG8_LDA
#undef PG8_LDB
#undef PG8_MMA
#undef PG8_WAIT_V
#undef PG8_WAIT_L
#undef PG8_BAR
#undef PG8_SCHED
}
}
#define TR_LO 0
#define TR_HI 16


#define LAS __attribute__((address_space(3)))
typedef unsigned short bf16;
typedef unsigned v4u __attribute__((ext_vector_type(4)));
typedef unsigned v2u __attribute__((ext_vector_type(2)));
typedef float f32x4 __attribute__((ext_vector_type(4)));
typedef short bf16x8 __attribute__((ext_vector_type(8)));
using pg8::cvt_pk_bf16; using pg8::bf_lo; using pg8::bf_hi;

constexpr int DM = 1024, MP = 65536, MS = 1024, MT = MP + MS;
constexpr int TPR = 8192, TSM = 64;
constexpr int APROJ = 1792, NMIX = 3584, FH = 2816, NLORA = 1536, KLORA = 256;
constexpr float LN_EPS = 1e-5f, A_NORM_EPS = 64e-5f;
constexpr float DN_ALPHA = 1.681792830507429f;
constexpr int NWAVES = 8, NTHREADS = 512;
constexpr int LDS_BYTES = 132096;

constexpr size_t SZ_X = (size_t)MT * 1024 * 2;
constexpr size_t W_IN = 0, W_IN_SZ = (size_t)NMIX * 1024 * 2;
constexpr size_t W_LO = W_IN + 2 * W_IN_SZ, W_LO_SZ = (size_t)NLORA * KLORA * 2;
constexpr size_t W_OM = W_LO + 2 * W_LO_SZ, W_SQ_SZ = (size_t)1024 * 1024 * 2;
constexpr size_t W_QKV = W_OM + 2 * W_SQ_SZ, W_QKV_SZ = (size_t)3072 * 1024 * 2;
constexpr size_t W_O = W_QKV + 2 * W_QKV_SZ;
constexpr size_t W_FI = W_O + 2 * W_SQ_SZ, W_FI_SZ = (size_t)2 * FH * 1024 * 2;
constexpr size_t W_FO = W_FI + 4 * W_FI_SZ, W_FO_SZ = (size_t)1024 * FH * 2;
constexpr size_t OFF_XB = W_FO + 4 * W_FO_SZ;
constexpr size_t OFF_R1 = OFF_XB + SZ_X;
constexpr size_t OFF_G = OFF_R1 + SZ_X;
constexpr size_t OFF_Z = OFF_G + SZ_X / 2;
constexpr size_t OFF_BIG = OFF_Z + SZ_X;
constexpr size_t WS_END = OFF_BIG + (size_t)MT * NMIX * 2;
constexpr size_t WS_BAR = WS_END, WS_BAR_BYTES = 16384;
static_assert(OFF_XB % 256 == 0 && WS_BAR % 256 == 0 && WS_BAR + WS_BAR_BYTES <= (size_t)1073741824, "ws map");

constexpr size_t O_YP = 0, O_YS = 67108864, O_PWKV = 68157440, O_PSHIFT = 68681728, O_PGLA = 68710400, O_PK = 69234688, O_PV = 77623296,
                 O_SWKV = 86011904, O_SSHIFT = 87060480, O_SGLA = 87117824, O_SK = 88166400, O_SV = 90263552;

__device__ __forceinline__ int tid_opaque() { int t = threadIdx.x; asm volatile("" : "+v"(t)); return t; }
struct Args { const float* in[32]; float* out; unsigned char* ws; int ph_lo, ph_hi; };

__device__ __forceinline__ float wave_sum(float v) {
#pragma unroll
    for (int o = 1; o < 64; o <<= 1) v += __shfl_xor(v, o);
    return v;
}
__device__ __forceinline__ void unpack8(const v4u w, float* f) {
    f[0] = bf_lo(w.x); f[1] = bf_hi(w.x); f[2] = bf_lo(w.y); f[3] = bf_hi(w.y); f[4] = bf_lo(w.z); f[5] = bf_hi(w.z); f[6] = bf_lo(w.w); f[7] = bf_hi(w.w);
}
__device__ __forceinline__ v4u pack8(const float* f) {
    v4u w; w.x = cvt_pk_bf16(f[0], f[1]); w.y = cvt_pk_bf16(f[2], f[3]); w.z = cvt_pk_bf16(f[4], f[5]); w.w = cvt_pk_bf16(f[6], f[7]); return w;
}
__device__ __forceinline__ void load8f(const float* p, float* f) {
    const f32x4 a = *(const f32x4*)p, b = *(const f32x4*)(p + 4);
    f[0] = a.x; f[1] = a.y; f[2] = a.z; f[3] = a.w; f[4] = b.x; f[5] = b.y; f[6] = b.z; f[7] = b.w;
}
__device__ __forceinline__ float softplus_f(float x) { return fmaxf(x, 0.f) + __logf(1.0f + __expf(-fabsf(x))); }
__device__ __forceinline__ float sigmoid_f(float x) { return __builtin_amdgcn_rcpf(1.0f + __expf(-x)); }
#define LDS_WAIT() asm volatile("s_waitcnt lgkmcnt(0)" ::: "memory")

__device__ __forceinline__ int xcd_vcu() { const int G = gridDim.x, bx = blockIdx.x; return (G % 8 == 0) ? (bx % 8) * (G / 8) + bx / 8 : bx; }
__device__ __forceinline__ int src_col(int mode, int n) {
    if (mode == 0) return n;
    if (mode == 1) {
        if (n < 1792) return n;
        if (n < 2816) { const int h = (n - 1792) >> 8, r = (n - 1792) & 255;
            if (r < 64) return 1792 + h * 64 + r; if (r < 128) return 1792 + 256 + h * 64 + (r - 64); return 1792 + 512 + h * 128 + (r - 128); }
        if (n < 3328) return 1792 + 1040 + (n - 2816);
        if (n < 3344) return 1792 + 1024 + (n - 3328);
        return -1;
    }
    const int pn = n >> 8, jj = n & 255;
    return jj < 128 ? pn * 128 + jj : FH + pn * 128 + (jj - 128);
}
__device__ __forceinline__ void transpose_item(const float* W, int ldw, int mode, bf16* WT, int K, int N, int it, int lane) {
    const int nblk = N / 64;
    const int kb = it / nblk, nb = it - kb * nblk, k0 = 64 * kb, n = 64 * nb + lane;
    const int sc = src_col(mode, n); const float msk = sc >= 0 ? 1.f : 0.f; const int scc = sc >= 0 ? sc : 0;
    const float* wp = W + (size_t)k0 * ldw + scc; bf16* op = WT + (size_t)n * K + k0;
#pragma unroll 4
    for (int k8 = 0; k8 < 8; ++k8) {
        float f[8];
#pragma unroll
        for (int i = 0; i < 8; ++i) f[i] = wp[(size_t)(8 * k8 + i) * ldw] * msk;
        *(v4u*)(op + 8 * k8) = pack8(f);
    }
}
__device__ __forceinline__ void prologue_phase(const Args& a, LAS unsigned char* lds) {
    const int tid = tid_opaque(), lane = tid & 63, wave = tid >> 6;
    const int gw = blockIdx.x * NWAVES + wave, ngw = gridDim.x * NWAVES;
    LAS float* scr = (LAS float*)(lds + wave * 8704);
    unsigned char* ws = a.ws;
    for (int itg = gw; itg < 12800; itg += ngw) {
        int j, base;
        if (itg < 1792) { j = itg / 896; base = j * 896; }
        else if (itg < 2304) { j = 2 + (itg - 1792) / 256; base = 1792 + (j - 2) * 256; }
        else if (itg < 3840) { j = 4 + (itg - 2304) / 768; base = 2304 + (j - 4) * 768; }
        else if (itg < 4352) { j = 6 + (itg - 3840) / 256; base = 3840 + (j - 6) * 256; }
        else if (itg < 9984) { j = 8 + (itg - 4352) / 1408; base = 4352 + (j - 8) * 1408; }
        else { j = 12 + (itg - 9984) / 704; base = 9984 + (j - 12) * 704; }
        const float* W; int ldw, mode, K, N; bf16* WT;
        if (j < 2)       { W = a.in[7] + (size_t)j * 1024 * 3344; ldw = 3344; mode = 1; K = 1024; N = NMIX; WT = (bf16*)(ws + W_IN + j * W_IN_SZ); }
        else if (j < 4)  { const int e = j - 2;  W = a.in[22] + (size_t)e * 1024 * 1024; ldw = 1024; mode = 0; K = 1024; N = 1024; WT = (bf16*)(ws + W_OM + e * W_SQ_SZ); }
        else if (j < 6)  { const int e = j - 4;  W = a.in[23] + (size_t)e * 1024 * 3072; ldw = 3072; mode = 0; K = 1024; N = 3072; WT = (bf16*)(ws + W_QKV + e * W_QKV_SZ); }
        else if (j < 8)  { const int e = j - 6;  W = a.in[25] + (size_t)e * 1024 * 1024; ldw = 1024; mode = 0; K = 1024; N = 1024; WT = (bf16*)(ws + W_O + e * W_SQ_SZ); }
        else if (j < 12) { const int l = j - 8;  W = a.in[30] + (size_t)l * 1024 * 2 * FH; ldw = 2 * FH; mode = 2; K = 1024; N = 2 * FH; WT = (bf16*)(ws + W_FI + l * W_FI_SZ); }
        else             { const int l = j - 12; W = a.in[31] + (size_t)l * FH * 1024; ldw = 1024; mode = 0; K = FH; N = 1024; WT = (bf16*)(ws + W_FO + l * W_FO_SZ); }
        transpose_item(W, ldw, mode, WT, K, N, itg - base, lane);
    }
    const int gt = blockIdx.x * NTHREADS + tid, ngt = gridDim.x * NTHREADS;
#ifndef SKIP_LORA
    for (int idx = gt; idx < 2 * NLORA * 32; idx += ngt) {
        const int e = idx / (NLORA * 32), r = idx - e * (NLORA * 32), n = r >> 5, k0 = (r & 31) * 8;
        float f[8];
#pragma unroll
        for (int i = 0; i < 8; ++i) { const int k = k0 + i; float v = 0.f;
            if (n < 512) { if (k < 64) v = a.in[10][((size_t)e * 64 + k) * 512 + n]; }
            else if (n < 1024) { if (k >= 64 && k < 128) v = a.in[12][((size_t)e * 64 + (k - 64)) * 512 + (n - 512)]; }
            else { if (k >= 128) v = a.in[13][((size_t)e * 128 + (k - 128)) * 512 + (n - 1024)]; }
            f[i] = v; }
        *(v4u*)((bf16*)(ws + W_LO + e * W_LO_SZ) + (size_t)n * KLORA + k0) = pack8(f);
    }
#endif
    bf16* XB = (bf16*)(ws + OFF_XB);
    for (size_t idx = gt; idx < (size_t)MT * 128; idx += ngt) {
        const size_t e0 = idx * 8; const float* src = e0 < (size_t)MP * 1024 ? a.in[0] + e0 : a.in[1] + (e0 - (size_t)MP * 1024);
        float f[8]; load8f(src, f); *(v4u*)(XB + e0) = pack8(f);
    }
}

__device__ __forceinline__ void prep1_phase(const Args& a, int e) {
    const int tid = tid_opaque(), lane = tid & 63, wave = tid >> 6;
    const int gw = blockIdx.x * NWAVES + wave, ngw = gridDim.x * NWAVES;
    const bf16* PA = (const bf16*)(a.ws + OFF_BIG); bf16* L = (bf16*)(a.ws + OFF_Z);
    const float* mu = a.in[8] + (size_t)e * APROJ; const float* shift0 = a.in[3] + (size_t)e * 16 * APROJ;
    const int c = 1536 + 4 * lane;
    const f32x4 mu4 = *(const f32x4*)(mu + c);
    for (int m = gw; m < MT; m += ngw) {
        const v2u pw = *(const v2u*)(PA + (size_t)m * APROJ + c);
        float p[4] = {bf_lo(pw.x), bf_hi(pw.x), bf_lo(pw.y), bf_hi(pw.y)}, q[4];
        const int t = m < MP ? (m & (TPR - 1)) : ((m - MP) & (TSM - 1));
        if (t > 0) { const v2u qw = *(const v2u*)(PA + (size_t)(m - 1) * APROJ + c); q[0] = bf_lo(qw.x); q[1] = bf_hi(qw.x); q[2] = bf_lo(qw.y); q[3] = bf_hi(qw.y); }
        else if (m < MP) { q[0] = q[1] = q[2] = q[3] = 0.f; }
        else { const f32x4 s = *(const f32x4*)(shift0 + (size_t)((m - MP) >> 6) * APROJ + c); q[0] = s.x; q[1] = s.y; q[2] = s.z; q[3] = s.w; }
        float r[4];
#pragma unroll
        for (int i = 0; i < 4; ++i) { const float xs = p[i] + (q[i] - p[i]) * mu4[i]; r[i] = lane < 16 ? tanhf(xs) : (lane < 32 ? xs : sigmoid_f(xs)); }
        v2u o; o.x = cvt_pk_bf16(r[0], r[1]); o.y = cvt_pk_bf16(r[2], r[3]);
        *(v2u*)(L + (size_t)m * KLORA + 4 * lane) = o;
    }
}
__device__ __forceinline__ void prep2_phase(const Args& a, int e) {
    const int tid = tid_opaque(), lane = tid & 63, wave = tid >> 6;
    const int gw = blockIdx.x * NWAVES + wave, ngw = gridDim.x * NWAVES;
    const bf16* PA = (const bf16*)(a.ws + OFF_BIG); bf16* PB = (bf16*)(a.ws + OFF_BIG) + (size_t)MT * APROJ;
    const bf16* Lw = (const bf16*)(a.ws + OFF_R1); const bf16* La = Lw + (size_t)MT * 512;
    bf16* SA = (bf16*)a.out; bf16* SB = (bf16*)(a.ws + OFF_Z);
    const float* mu = a.in[8] + (size_t)e * APROJ; const float* shift0 = a.in[3] + (size_t)e * 16 * APROJ;
    const int c8 = 8 * lane, h = lane >> 3;
    float mur[8], muk[8], muv[8], w0[8], a0[8], kkw[8], kaw[8];
    load8f(mu + c8, mur); load8f(mu + 512 + c8, muk); load8f(mu + 1024 + c8, muv);
    load8f(a.in[9] + (size_t)e * 512 + c8, w0); load8f(a.in[11] + (size_t)e * 512 + c8, a0);
    load8f(a.in[14] + (size_t)e * 512 + c8, kkw); load8f(a.in[15] + (size_t)e * 512 + c8, kaw);
    const float* aup = a.in[19] + (size_t)e * 16 * 256; const f32x4 ab = *(const f32x4*)(a.in[20] + (size_t)e * 256 + 4 * lane);
    for (int m = gw; m < MT; m += ngw) {
        const bf16* pr = PA + (size_t)m * APROJ;
        float r[8], k[8], v[8], pq[8];
        unpack8(*(const v4u*)(pr + c8), r); unpack8(*(const v4u*)(pr + 512 + c8), k); unpack8(*(const v4u*)(pr + 1024 + c8), v);
        const int t = m < MP ? (m & (TPR - 1)) : ((m - MP) & (TSM - 1));
        if (t > 0) {
            unpack8(*(const v4u*)(pr - APROJ + c8), pq);
#pragma unroll
            for (int i = 0; i < 8; ++i) r[i] += (pq[i] - r[i]) * mur[i];
            unpack8(*(const v4u*)(pr - APROJ + 512 + c8), pq);
#pragma unroll
            for (int i = 0; i < 8; ++i) k[i] += (pq[i] - k[i]) * muk[i];
            unpack8(*(const v4u*)(pr - APROJ + 1024 + c8), pq);
#pragma unroll
            for (int i = 0; i < 8; ++i) v[i] += (pq[i] - v[i]) * muv[i];
        } else if (m < MP) {
#pragma unroll
            for (int i = 0; i < 8; ++i) { r[i] -= r[i] * mur[i]; k[i] -= k[i] * muk[i]; v[i] -= v[i] * muv[i]; }
        } else {
            const float* s0 = shift0 + (size_t)((m - MP) >> 6) * APROJ;
            load8f(s0 + c8, pq);
#pragma unroll
            for (int i = 0; i < 8; ++i) r[i] += (pq[i] - r[i]) * mur[i];
            load8f(s0 + 512 + c8, pq);
#pragma unroll
            for (int i = 0; i < 8; ++i) k[i] += (pq[i] - k[i]) * muk[i];
            load8f(s0 + 1024 + c8, pq);
#pragma unroll
            for (int i = 0; i < 8; ++i) v[i] += (pq[i] - v[i]) * muv[i];
        }
        float lw[8], la[8], u[8], av[8], kk[8], km[8], ka[8];
        unpack8(*(const v4u*)(Lw + (size_t)m * 512 + c8), lw); unpack8(*(const v4u*)(La + (size_t)m * 512 + c8), la);
        float ss = 0.f;
#pragma unroll
        for (int i = 0; i < 8; ++i) {
            const float w = -softplus_f(-(w0[i] + lw[i])) - 0.5f;
            u[i] = 1.0f - __expf(-__expf(w));
            av[i] = sigmoid_f(a0[i] + la[i]);
            kk[i] = k[i] * kkw[i]; ss += kk[i] * kk[i];
            km[i] = k[i] * (1.0f + (av[i] - 1.0f) * kaw[i]);
        }
        ss += __shfl_xor(ss, 1); ss += __shfl_xor(ss, 2); ss += __shfl_xor(ss, 4);
        const float rn = rsqrtf(ss + 1e-12f);
#pragma unroll
        for (int i = 0; i < 8; ++i) { kk[i] *= rn; ka[i] = kk[i] * av[i]; }
        bf16* sa = SA + ((size_t)m * 8 + h) * 256 + (lane & 7) * 8; bf16* sb = SB + ((size_t)m * 8 + h) * 128 + (lane & 7) * 8;
        *(v4u*)(sa) = pack8(r); *(v4u*)(sa + 64) = pack8(u); *(v4u*)(sa + 128) = pack8(km); *(v4u*)(sa + 192) = pack8(v);
        *(v4u*)(sb) = pack8(kk); *(v4u*)(sb + 64) = pack8(ka);
        bf16* pb = PB + (size_t)m * APROJ + 1536;
        float xa[16]; unpack8(*(const v4u*)(pb), xa); unpack8(*(const v4u*)(pb + 8), xa + 8);
        f32x4 acc = ab;
#pragma unroll
        for (int i = 0; i < 16; ++i) { const f32x4 wv = *(const f32x4*)(aup + i * 256 + 4 * lane); acc += xa[i] * wv; }
        float ug[4];
#pragma unroll
        for (int i = 0; i < 4; ++i) ug[i] = 1.0f - __expf(-softplus_f(-acc[i]) * (1.0f / 16.0f));
        v2u o; o.x = cvt_pk_bf16(ug[0], ug[1]); o.y = cvt_pk_bf16(ug[2], ug[3]);
        *(v2u*)(pb + 4 * lane) = o;
    }
}
struct PostRaw { v4u o, r, km, v, g, og, rg; };
__device__ __forceinline__ void post_phase(const Args& a, int e) {
    const int tid = tid_opaque(), lane = tid & 63, wave = tid >> 6;
    const int gw = blockIdx.x * NWAVES + wave, ngw = gridDim.x * NWAVES;
    bf16* Y = (bf16*)(a.ws + OFF_R1); const bf16* G = (const bf16*)(a.ws + OFF_G);
    const bf16* PB = (const bf16*)(a.ws + OFF_BIG) + (size_t)MT * APROJ; const bf16* SA = (const bf16*)a.out;
    const int c8 = 8 * lane, h = lane >> 3;
    float lnw[8], lnb[8], rk[8], nw[8];
    load8f(a.in[17] + (size_t)e * 512 + c8, lnw); load8f(a.in[18] + (size_t)e * 512 + c8, lnb); load8f(a.in[16] + (size_t)e * 512 + c8, rk);
    load8f(a.in[21] + (size_t)e * 128 + (lane & 15) * 8, nw);
    for (int mb = gw; mb < MT; mb += 2 * ngw) {
        PostRaw raw[2];
#pragma unroll
        for (int j = 0; j < 2; ++j) { const int m_ = mb + j * ngw; const size_t m = m_ < MT ? m_ : mb;
            const bf16* sa = SA + (m * 8 + h) * 256 + (lane & 7) * 8;
            raw[j].o = *(const v4u*)(Y + m * 1024 + c8); raw[j].r = *(const v4u*)(sa); raw[j].km = *(const v4u*)(sa + 128); raw[j].v = *(const v4u*)(sa + 192);
            raw[j].g = *(const v4u*)(G + m * 512 + c8); raw[j].og = *(const v4u*)(Y + m * 1024 + 512 + c8); raw[j].rg = *(const v4u*)(PB + m * APROJ + 1024 + c8); }
#pragma unroll
        for (int j = 0; j < 2; ++j) {
            const int m = mb + j * ngw;
            float o[8], r[8], km[8], v[8], g[8];
            unpack8(raw[j].o, o); unpack8(raw[j].r, r); unpack8(raw[j].km, km); unpack8(raw[j].v, v); unpack8(raw[j].g, g);
            float s = 0.f, bn = 0.f;
#pragma unroll
            for (int i = 0; i < 8; ++i) { s += o[i]; bn += r[i] * km[i] * rk[i]; }
            s += __shfl_xor(s, 1); s += __shfl_xor(s, 2); s += __shfl_xor(s, 4);
            bn += __shfl_xor(bn, 1); bn += __shfl_xor(bn, 2); bn += __shfl_xor(bn, 4);
            const float mean = s * (1.0f / 64.0f); float q = 0.f;
#pragma unroll
            for (int i = 0; i < 8; ++i) { o[i] -= mean; q += o[i] * o[i]; }
            q += __shfl_xor(q, 1); q += __shfl_xor(q, 2); q += __shfl_xor(q, 4);
            const float rstd = rsqrtf(q * (1.0f / 64.0f) + A_NORM_EPS);
#pragma unroll
            for (int i = 0; i < 8; ++i) o[i] = (o[i] * rstd * lnw[i] + lnb[i] + bn * v[i]) * g[i];
            float og[8], rg[8];
            unpack8(raw[j].og, og); unpack8(raw[j].rg, rg);
            float ms = 0.f;
#pragma unroll
            for (int i = 0; i < 8; ++i) ms += og[i] * og[i];
            ms += __shfl_xor(ms, 1); ms += __shfl_xor(ms, 2); ms += __shfl_xor(ms, 4); ms += __shfl_xor(ms, 8);
            const float rr = rsqrtf(ms * (1.0f / 128.0f) + LN_EPS);
#pragma unroll
            for (int i = 0; i < 8; ++i) og[i] = og[i] * rr * nw[i] * (rg[i] * sigmoid_f(rg[i]));
            if (m < MT) { *(v4u*)(Y + (size_t)m * 1024 + c8) = pack8(o); *(v4u*)(Y + (size_t)m * 1024 + 512 + c8) = pack8(og); }
        }
    }
}
__device__ __forceinline__ void ln_row_out(float* x0, float* x1, const float* w0, const float* w1, const float* b0, const float* b1, bf16* XB, float* fout, int m, int lane) {
    float s = 0.f;
#pragma unroll
    for (int i = 0; i < 8; ++i) s += x0[i] + x1[i];
    const float mean = wave_sum(s) * (1.0f / 1024.0f); float q = 0.f;
#pragma unroll
    for (int i = 0; i < 8; ++i) { x0[i] -= mean; x1[i] -= mean; q += x0[i] * x0[i] + x1[i] * x1[i]; }
    const float rstd = rsqrtf(wave_sum(q) * (1.0f / 1024.0f) + LN_EPS);
#pragma unroll
    for (int i = 0; i < 8; ++i) { x0[i] = x0[i] * rstd * w0[i] + b0[i]; x1[i] = x1[i] * rstd * w1[i] + b1[i]; }
    if (fout) {
        float* fo = fout + (size_t)m * 1024 + 8 * lane;
        *(f32x4*)(fo) = (f32x4){x0[0], x0[1], x0[2], x0[3]}; *(f32x4*)(fo + 4) = (f32x4){x0[4], x0[5], x0[6], x0[7]};
        *(f32x4*)(fo + 512) = (f32x4){x1[0], x1[1], x1[2], x1[3]}; *(f32x4*)(fo + 516) = (f32x4){x1[4], x1[5], x1[6], x1[7]};
    } else {
        *(v4u*)(XB + (size_t)m * 1024 + 8 * lane) = pack8(x0); *(v4u*)(XB + (size_t)m * 1024 + 512 + 8 * lane) = pack8(x1);
    }
}
__device__ __forceinline__ void ln_phase(const Args& a, const float* w, const float* b, float* fout, int ns) {
    const int tid = tid_opaque(), lane = tid & 63, wave = tid >> 6;
    const int gw = blockIdx.x * NWAVES + wave, ngw = gridDim.x * NWAVES;
    const bf16* Z = (const bf16*)(a.ws + OFF_Z); bf16* XB = (bf16*)(a.ws + OFF_XB);
    float w0[8], w1[8], b0[8], b1[8];
    load8f(w + 8 * lane, w0); load8f(w + 512 + 8 * lane, w1); load8f(b + 8 * lane, b0); load8f(b + 512 + 8 * lane, b1);
    for (int mb = gw; mb < MP; mb += 4 * ngw) {
        v4u r0[4], r1[4];
#pragma unroll
        for (int j = 0; j < 4; ++j) { const int m = mb + j * ngw; const int mc = m < MP ? m : mb;
            r0[j] = *(const v4u*)(Z + (size_t)mc * 1024 + 8 * lane); r1[j] = *(const v4u*)(Z + (size_t)mc * 1024 + 512 + 8 * lane); }
#pragma unroll
        for (int j = 0; j < 4; ++j) {
            const int m = mb + j * ngw;
            float x0[8], x1[8];
            unpack8(r0[j], x0); unpack8(r1[j], x1);
            if (m < MP) ln_row_out(x0, x1, w0, w1, b0, b1, XB, fout, m, lane);
        }
    }
#pragma unroll 1
    for (int m = MP + gw; m < MT; m += ngw) {
        float x0[8], x1[8];
        unpack8(*(const v4u*)(XB + (size_t)m * 1024 + 8 * lane), x0); unpack8(*(const v4u*)(XB + (size_t)m * 1024 + 512 + 8 * lane), x1);
#pragma unroll
        for (int i = 0; i < 8; ++i) { x0[i] *= DN_ALPHA; x1[i] *= DN_ALPHA; }
        const float* zs = (const float*)(a.ws + OFF_G) + (size_t)(m - MP) * 1024 + 8 * lane;
#pragma unroll 1
        for (int sl = 0; sl < ns; ++sl) { float t0[8], t1[8]; load8f(zs + (size_t)sl * 1024 * 1024, t0); load8f(zs + (size_t)sl * 1024 * 1024 + 512, t1);
#pragma unroll
            for (int i = 0; i < 8; ++i) { x0[i] += t0[i]; x1[i] += t1[i]; } }
        ln_row_out(x0, x1, w0, w1, b0, b1, XB, fout, m, lane);
    }
}

#define TR_DPP(x, ctrl) __builtin_bit_cast(float, __builtin_amdgcn_update_dpp(0, __builtin_bit_cast(int, x), ctrl, 0xf, 0xf, false))
__device__ __forceinline__ float transpose_reduce16(const float* p, int g) {
    const bool h1 = (g & 8) != 0, h2 = (g & 4) != 0, h3 = (g & 2) != 0, h4 = (g & 1) != 0;
    float q[8], r[4], t[2];
#pragma unroll
    for (int i = 0; i < 8; ++i) { const float keep = h1 ? p[i + 8] : p[i], send = h1 ? p[i] : p[i + 8]; q[i] = keep + TR_DPP(send, 0x140); }
#pragma unroll
    for (int i = 0; i < 4; ++i) { const float keep = h2 ? q[i + 4] : q[i], send = h2 ? q[i] : q[i + 4]; r[i] = keep + TR_DPP(send, 0x141); }
#pragma unroll
    for (int i = 0; i < 2; ++i) { const float keep = h3 ? r[i + 2] : r[i], send = h3 ? r[i] : r[i + 2]; t[i] = keep + TR_DPP(send, 0x4E); }
    const float keep = h4 ? t[1] : t[0], send = h4 ? t[0] : t[1];
    return keep + TR_DPP(send, 0xB1);
}
constexpr int TC = 16;
constexpr int SCW = 384, SCG = 320;
__device__ __forceinline__ void st8(LAS float* d, const v4u w, float sc) {
    *(LAS f32x4*)(d) = (f32x4){bf_lo(w.x) * sc, bf_hi(w.x) * sc, bf_lo(w.y) * sc, bf_hi(w.y) * sc};
    *(LAS f32x4*)(d + 4) = (f32x4){bf_lo(w.z) * sc, bf_hi(w.z) * sc, bf_lo(w.w) * sc, bf_hi(w.w) * sc};
}
typedef float f32x2 __attribute__((ext_vector_type(2)));
#define LO2(v4) (__builtin_shufflevector(v4, v4, 0, 1))
#define HI2(v4) (__builtin_shufflevector(v4, v4, 2, 3))
__device__ __forceinline__ f32x2 fma2(f32x2 a, f32x2 b, f32x2 c) { return __builtin_elementwise_fma(a, b, c); }
__device__ __forceinline__ float rowsum16(float x) {
    x += __builtin_bit_cast(float, __builtin_amdgcn_update_dpp(0, __builtin_bit_cast(int, x), 0x128, 0xf, 0xf, false));
    x += __builtin_bit_cast(float, __builtin_amdgcn_update_dpp(0, __builtin_bit_cast(int, x), 0x124, 0xf, 0xf, false));
    x += __builtin_bit_cast(float, __builtin_amdgcn_update_dpp(0, __builtin_bit_cast(int, x), 0x122, 0xf, 0xf, false));
    x += __builtin_bit_cast(float, __builtin_amdgcn_update_dpp(0, __builtin_bit_cast(int, x), 0x121, 0xf, 0xf, false));
    return x;
}
struct WkvIn { f32x4 r, u, km, kk, ka; float v; };
struct GlaIn { f32x4 q, k, u; float v; };
__device__ __forceinline__ void scan_phase(const Args& a, int e, LAS unsigned char* lds) {
    const int tid = tid_opaque(), lane = tid & 63, wave = tid >> 6;
    const bool isW = wave < 4; const int ltid = tid & 255, lw = wave & 3;
    const int g = lane & 15, rl = lw * 4 + (lane >> 4);
    const bf16* SA = (const bf16*)a.out; const bf16* SB = (const bf16*)(a.ws + OFF_Z);
    const bf16* PB = (const bf16*)(a.ws + OFF_BIG) + (size_t)MT * APROJ;
    bf16* O1 = (bf16*)(a.ws + OFF_R1);
    LAS float* bufW = (LAS float*)lds;
    LAS float* bufG = (LAS float*)(lds + 2 * TC * SCW * 4);
    int ps[3], pp[3];
#pragma unroll
    for (int j = 0; j < 3; ++j) { const int p = ltid + 256 * j; if (isW) { ps[j] = p / 48; pp[j] = p - ps[j] * 48; } else { ps[j] = p / 40; pp[j] = p - ps[j] * 40; } }
    const bool v2ok = isW || (ltid + 512 < 640);
#pragma unroll 1
    for (int it = xcd_vcu(); it < 768; it += gridDim.x) {
        const bool samp = it >= 256; const int wi = samp ? it - 256 : it;
        const int b = wi >> 5; const int T = samp ? TSM : TPR; const size_t row0 = samp ? (size_t)MP + b * TSM : (size_t)b * TPR;
        const int nb = samp ? 16 : 8;
        int h, sub;
        if (isW) { h = (wi >> 2) & 7; sub = wi & 3; } else { h = (wi >> 3) & 3; sub = wi & 7; }
        const int vrow = sub * 16 + rl;
        f32x2 P0 = {0.f, 0.f}, P1 = {0.f, 0.f};
        if (samp) {
            if (isW) { const f32x4 S = *(const f32x4*)(a.in[2] + ((((size_t)e * 16 + b) * 8 + h) * 64 + vrow) * 64 + 4 * g); P0 = LO2(S); P1 = HI2(S); }
            else { const float* s0 = a.in[4] + (((size_t)e * 16 + b) * 4 + h) * 8192 + vrow;
                P0 = (f32x2){s0[(4 * g + 0) * 128], s0[(4 * g + 1) * 128]}; P1 = (f32x2){s0[(4 * g + 2) * 128], s0[(4 * g + 3) * 128]}; }
        }
        const int nc = T / TC;
        bf16* obase = isW ? O1 + (row0 + g) * 1024 + h * 64 + vrow : O1 + (row0 + g) * 1024 + 512 + h * 128 + vrow;
        v4u pre[3];
#define SCAN_ISSUE(t0) do { _Pragma("unroll") for (int j = 0; j < 3; ++j) { const size_t row = row0 + (t0) + ps[j]; const bf16* src; \
            if (isW) src = pp[j] < 32 ? SA + (row * 8 + h) * 256 + pp[j] * 8 : SB + (row * 8 + h) * 128 + (pp[j] - 32) * 8; \
            else src = pp[j] < 32 ? PB + row * APROJ + h * 256 + pp[j] * 8 : PB + row * APROJ + 1536 + h * 64 + (pp[j] - 32) * 8; \
            if (j < 2 || v2ok) pre[j] = *(const v4u*)src; } } while (0)
#define SCAN_COMMIT(bi) do { _Pragma("unroll") for (int j = 0; j < 3; ++j) { if (j < 2 || v2ok) { \
            if (isW) st8(bufW + ((bi) * TC + ps[j]) * SCW + pp[j] * 8, pre[j], 1.0f); \
            else st8(bufG + ((bi) * TC + ps[j]) * SCG + pp[j] * 8, pre[j], pp[j] < 8 ? 0.125f : 1.0f); } } } while (0)
        __syncthreads();
        SCAN_ISSUE(0); SCAN_COMMIT(0);
        __syncthreads();
#pragma unroll 1
        for (int c = 0; c < nc; ++c) {
            const int bi = c & 1;
            if (c + 1 < nc) SCAN_ISSUE((c + 1) * TC);
            float oacc = 0.f; float op[16];
            if (isW) {
                const LAS float* bw = bufW + bi * TC * SCW + 4 * g; const LAS float* bv = bufW + bi * TC * SCW + 192 + vrow;
#define WKV_LOAD(d, s) do { const LAS float* p_ = bw + (s) * SCW; d.r = *(const LAS f32x4*)(p_); d.u = *(const LAS f32x4*)(p_ + 64); d.km = *(const LAS f32x4*)(p_ + 128); \
                    d.kk = *(const LAS f32x4*)(p_ + 256); d.ka = *(const LAS f32x4*)(p_ + 320); d.v = bv[(s) * SCW]; } while (0)
                WkvIn in[3];
                WKV_LOAD(in[0], 0); WKV_LOAD(in[1], 1);
#pragma unroll
                for (int s = 0; s < TC; ++s) {
                    if (s + 2 < TC) WKV_LOAD(in[(s + 2) % 3], s + 2);
                    __builtin_amdgcn_sched_barrier(0);
                    const WkvIn& x = in[s % 3];
                    const f32x2 vv = {x.v, x.v};
                    const f32x2 s2 = fma2(P1, HI2(x.kk), P0 * LO2(x.kk));
                    const f32x2 T0 = fma2(vv, LO2(x.km), fma2(-LO2(x.u), P0, P0)), T1 = fma2(vv, HI2(x.km), fma2(-HI2(x.u), P1, P1));
                    const float sa = rowsum16(s2.x + s2.y);
                    const f32x2 ns = {-sa, -sa};
                    P0 = fma2(ns, LO2(x.ka), T0); P1 = fma2(ns, HI2(x.ka), T1);
                    const f32x2 o2 = fma2(P1, HI2(x.r), P0 * LO2(x.r));
                    op[s] = o2.x + o2.y;
                }
                oacc = transpose_reduce16(op, g);
#undef WKV_LOAD
            } else {
                const LAS float* bg = bufG + bi * TC * SCG + 4 * g; const LAS float* bv = bufG + bi * TC * SCG + 128 + vrow;
#define GLA_LOAD(d, s) do { const LAS float* p_ = bg + (s) * SCG; d.q = *(const LAS f32x4*)(p_); d.k = *(const LAS f32x4*)(p_ + 64); d.u = *(const LAS f32x4*)(p_ + 256); d.v = bv[(s) * SCG]; } while (0)
                GlaIn in[3];
                GLA_LOAD(in[0], 0); GLA_LOAD(in[1], 1);
#pragma unroll
                for (int s = 0; s < TC; ++s) {
                    if (s + 2 < TC) GLA_LOAD(in[(s + 2) % 3], s + 2);
                    __builtin_amdgcn_sched_barrier(0);
                    const GlaIn& x = in[s % 3];
                    const f32x2 vv = {x.v, x.v};
                    P0 = fma2(vv, LO2(x.k), fma2(-LO2(x.u), P0, P0)); P1 = fma2(vv, HI2(x.k), fma2(-HI2(x.u), P1, P1));
                    const f32x2 o2 = fma2(P1, HI2(x.q), P0 * LO2(x.q));
                    op[s] = o2.x + o2.y;
                }
                oacc = transpose_reduce16(op, g);
#undef GLA_LOAD
            }
            obase[(size_t)c * TC * 1024] = (bf16)(cvt_pk_bf16(oacc, 0.f) & 0xffffu);
            if (c + 1 < nc) SCAN_COMMIT(bi ^ 1);
            __syncthreads();
        }
#undef SCAN_ISSUE
#undef SCAN_COMMIT
        if (isW) { float* so = a.out + (samp ? O_SWKV : O_PWKV) + ((((size_t)e * nb + b) * 8 + h) * 64 + vrow) * 64 + 4 * g; *(f32x4*)so = (f32x4){P0.x, P0.y, P1.x, P1.y}; }
        else { float* so = a.out + (samp ? O_SGLA : O_PGLA) + (((size_t)e * nb + b) * 4 + h) * 8192 + vrow;
            so[(4 * g + 0) * 128] = P0.x; so[(4 * g + 1) * 128] = P0.y; so[(4 * g + 2) * 128] = P1.x; so[(4 * g + 3) * 128] = P1.y; }
    }
    const bf16* PA = (const bf16*)(a.ws + OFF_BIG);
    for (int idx = blockIdx.x * NTHREADS + tid; idx < 24 * APROJ; idx += gridDim.x * NTHREADS) {
        const int bb = idx / APROJ, c = idx - bb * APROJ;
        if (bb < 8) a.out[O_PSHIFT + ((size_t)e * 8 + bb) * APROJ + c] = bf_lo((unsigned)PA[((size_t)bb * TPR + TPR - 1) * APROJ + c]);
        else a.out[O_SSHIFT + ((size_t)e * 16 + (bb - 8)) * APROJ + c] = bf_lo((unsigned)PA[((size_t)MP + (bb - 8) * TSM + TSM - 1) * APROJ + c]);
    }
}

constexpr int KEXT = 8192, LDV = MT + KEXT;
constexpr size_t BIG_K = (size_t)MT * 1024, BIG_VT = (size_t)(2 * MT + KEXT) * 1024;
__device__ __forceinline__ bf16x8 ld_frag(const bf16* p) { return __builtin_bit_cast(bf16x8, *(const v4u*)p); }
__device__ __forceinline__ void cache_convert(const Args& a, int o) {
    const int tid = tid_opaque();
    const int gt = blockIdx.x * NTHREADS + tid, ngt = gridDim.x * NTHREADS;
    bf16* Kb = (bf16*)(a.ws + OFF_BIG) + BIG_K; bf16* Vt = (bf16*)(a.ws + OFF_BIG) + BIG_VT;
    const float* ck = a.in[5] + (size_t)o * 16 * 16 * 512 * 64; const float* cv = a.in[6] + (size_t)o * 16 * 16 * 512 * 64;
    for (int idx = gt; idx < 16 * 16 * 512 * 8; idx += ngt) {
        const int d8 = idx & 7, key = (idx >> 3) & 511, h = (idx >> 12) & 15, b = idx >> 16;
        float f[8]; load8f(ck + (size_t)idx * 8, f);
        *(v4u*)(Kb + ((size_t)MT + b * 512 + key) * 1024 + h * 64 + d8 * 8) = pack8(f);
    }
    for (int idx = gt; idx < 16 * 16 * 64 * 64; idx += ngt) {
        const int d = idx & 63, k8 = (idx >> 6) & 63, h = (idx >> 12) & 15, b = idx >> 16;
        const float* src = cv + (((size_t)b * 16 + h) * 512 + k8 * 8) * 64 + d; float f[8];
#pragma unroll
        for (int j = 0; j < 8; ++j) f[j] = src[j * 64];
        *(v4u*)(Vt + (size_t)(h * 64 + d) * LDV + MT + b * 512 + k8 * 8) = pack8(f);
    }
}
__device__ __forceinline__ void attn_phase(const Args& a, int o, LAS unsigned char* lds) {
    const int tid = tid_opaque(), lane = tid & 63, wave = tid >> 6;
    const int gw = blockIdx.x * NWAVES + wave, ngw = gridDim.x * NWAVES;
    const bf16* Q = (const bf16*)(a.ws + OFF_BIG); const bf16* Kb = Q + BIG_K; const bf16* Vt = Q + BIG_VT;
    bf16* O = (bf16*)(a.ws + OFF_R1);
    LAS float* bias = (LAS float*)lds;
    constexpr int KVP = 72;
    LAS bf16* KT = (LAS bf16*)(lds + 16512);
    LAS bf16* VT = KT + 2 * 64 * KVP;
    for (int i = tid; i < 16 * 257; i += NTHREADS) bias[i] = a.in[24][(size_t)o * 16 * 257 + i] * 1.4426950408889634f;
    __syncthreads();
    const int i16 = lane & 15, g = lane >> 4;
    const int keyoff = 8 * (i16 >> 2) + (i16 & 3);
    {
        const int wu = __builtin_amdgcn_readfirstlane(wave);
        const int srow = tid >> 3, sseg = (tid & 7) * 8;
#pragma unroll 1
        for (int unit = xcd_vcu(); unit < 4096; unit += gridDim.x) {
            const int b = unit >> 9, h = (unit >> 5) & 15, c0 = (unit & 31) * 4;
            const int c = c0 + (wu >> 1), half = wu & 1;
            const size_t qrow0 = (size_t)b * TPR + c * 64 + half * 32;
            const int qpos0 = c * 64 + half * 32;
            const int kc_lo = c0 >= 8 ? c0 - 8 : 0, kc_hi = c0 + 3, my_lo = c >= 8 ? c - 8 : 0;
            const LAS float* bh = bias + h * 257 + 128;
            const float bfar = bh[128];
            bf16x8 qf[2][2];
#pragma unroll
            for (int qt = 0; qt < 2; ++qt)
#pragma unroll
                for (int kk = 0; kk < 2; ++kk) qf[qt][kk] = ld_frag(Q + (qrow0 + 16 * qt + i16) * 1024 + h * 64 + 32 * kk + 8 * g);
            f32x4 ot[4][2];
#pragma unroll
            for (int dt = 0; dt < 4; ++dt) { ot[dt][0] = (f32x4){0.f, 0.f, 0.f, 0.f}; ot[dt][1] = (f32x4){0.f, 0.f, 0.f, 0.f}; }
            float mrun[2] = {-1e30f, -1e30f}, lrun[2] = {0.f, 0.f};
            const bf16* kg_ = Kb + ((size_t)b * TPR + srow) * 1024 + h * 64 + sseg;
            const bf16* vg_ = Vt + (size_t)(h * 64 + srow) * LDV + (size_t)b * TPR + sseg;
            v4u kreg = *(const v4u*)(kg_ + (size_t)(64 * kc_lo) * 1024), vreg = *(const v4u*)(vg_ + 64 * kc_lo);
            *(LAS v4u*)(KT + srow * KVP + sseg) = kreg; *(LAS v4u*)(VT + srow * KVP + sseg) = vreg;
            __syncthreads();
#pragma unroll 1
            for (int kc = kc_lo; kc <= kc_hi; ++kc) {
                const int buf = (kc - kc_lo) & 1;
                if (kc < kc_hi) { kreg = *(const v4u*)(kg_ + (size_t)(64 * (kc + 1)) * 1024); vreg = *(const v4u*)(vg_ + 64 * (kc + 1)); }
                if (kc >= my_lo && kc <= c) {
                    const int kpos0 = 64 * kc;
                    const LAS bf16* kt = KT + buf * 64 * KVP + keyoff * KVP + 8 * g; const LAS bf16* vt = VT + buf * 64 * KVP + i16 * KVP + 8 * g;
                    f32x4 st[4][2];
#pragma unroll
                    for (int t4 = 0; t4 < 4; ++t4) {
                        const LAS bf16* p = kt + (32 * (t4 >> 1) + 4 * (t4 & 1)) * KVP;
                        const bf16x8 k0 = *(const LAS bf16x8*)p, k1 = *(const LAS bf16x8*)(p + 32);
#pragma unroll
                        for (int qt = 0; qt < 2; ++qt) {
                            f32x4 acc = {0.f, 0.f, 0.f, 0.f};
                            acc = __builtin_amdgcn_mfma_f32_16x16x32_bf16(k0, qf[qt][0], acc, 0, 0, 0);
                            acc = __builtin_amdgcn_mfma_f32_16x16x32_bf16(k1, qf[qt][1], acc, 0, 0, 0);
                            st[t4][qt] = acc;
                        }
                    }
                    const bool far = qpos0 - (kpos0 + 63) >= 128;
                    bf16x8 pf[2][2];
#pragma unroll
                    for (int qt = 0; qt < 2; ++qt) {
                        const int qpos = qpos0 + 16 * qt + i16;
                        float mx = -1e30f;
                        float boff = 0.f;
                        if (far) {
#pragma unroll
                            for (int t4 = 0; t4 < 4; ++t4)
#pragma unroll
                                for (int j = 0; j < 4; ++j) mx = fmaxf(mx, st[t4][qt][j]);
                            mx += bfar; boff = bfar;
                        } else {
#pragma unroll
                            for (int t4 = 0; t4 < 4; ++t4)
#pragma unroll
                                for (int j = 0; j < 4; ++j) {
                                    int rel = qpos - (kpos0 + 32 * (t4 >> 1) + 8 * g + 4 * (t4 & 1) + j); rel = rel > 128 ? 128 : (rel < -128 ? -128 : rel);
                                    const float sv = st[t4][qt][j] + bh[rel]; st[t4][qt][j] = sv; mx = fmaxf(mx, sv);
                                }
                        }
                        mx = fmaxf(mx, __shfl_xor(mx, 16)); mx = fmaxf(mx, __shfl_xor(mx, 32));
                        const float mnew = fmaxf(mrun[qt], mx), corr = __builtin_amdgcn_exp2f(mrun[qt] - mnew), msub = mnew - boff; mrun[qt] = mnew;
                        float psum = 0.f;
#pragma unroll
                        for (int sb = 0; sb < 2; ++sb) {
                            float p[8];
#pragma unroll
                            for (int T = 0; T < 2; ++T)
#pragma unroll
                                for (int j = 0; j < 4; ++j) { p[4 * T + j] = __builtin_amdgcn_exp2f(st[2 * sb + T][qt][j] - msub); psum += p[4 * T + j]; }
                            pf[sb][qt] = __builtin_bit_cast(bf16x8, pack8(p));
                        }
                        lrun[qt] = lrun[qt] * corr + psum;
#pragma unroll
                        for (int dt = 0; dt < 4; ++dt) ot[dt][qt] *= corr;
                    }
#pragma unroll
                    for (int sb = 0; sb < 2; ++sb)
#pragma unroll
                        for (int dt = 0; dt < 4; ++dt) {
                            const bf16x8 vf = *(const LAS bf16x8*)(vt + 16 * dt * KVP + 32 * sb);
#pragma unroll
                            for (int qt = 0; qt < 2; ++qt) ot[dt][qt] = __builtin_amdgcn_mfma_f32_16x16x32_bf16(vf, pf[sb][qt], ot[dt][qt], 0, 0, 0);
                        }
                }
                if (kc < kc_hi) { *(LAS v4u*)(KT + (buf ^ 1) * 64 * KVP + srow * KVP + sseg) = kreg; *(LAS v4u*)(VT + (buf ^ 1) * 64 * KVP + srow * KVP + sseg) = vreg; }
                __syncthreads();
            }
#pragma unroll
            for (int qt = 0; qt < 2; ++qt) {
                float l = lrun[qt]; l += __shfl_xor(l, 16); l += __shfl_xor(l, 32);
                const float inv = 1.0f / l;
                bf16* op = O + (qrow0 + 16 * qt + i16) * 1024 + h * 64 + 4 * g;
#pragma unroll
                for (int dt = 0; dt < 4; ++dt) { const f32x4 v = ot[dt][qt] * inv; v2u w; w.x = cvt_pk_bf16(v[0], v[1]); w.y = cvt_pk_bf16(v[2], v[3]); *(v2u*)(op + 16 * dt) = w; }
            }
        }
    }
#pragma unroll 1
    for (int it = 32768 + gw; it < 32768 + 512; it += ngw) {
        const bool samp = it >= 32768;
        int b, c, h, half;
        if (!samp) { b = it >> 12; c = (it >> 5) & 127; h = (it >> 1) & 15; half = it & 1; }
        else { const int r = it - 32768; b = r >> 5; c = 8; h = (r >> 1) & 15; half = r & 1; }
        const size_t qrow0 = samp ? (size_t)MP + b * 64 + half * 32 : (size_t)b * TPR + c * 64 + half * 32;
        const int qpos0 = c * 64 + half * 32;
        const int kstart = c >= 8 ? c * 64 - 512 : 0, nkb = (c * 64 + 64 - kstart) >> 6;
        const size_t kbase = samp ? (size_t)MT + b * 512 : (size_t)b * TPR + kstart;
        const size_t knew = (size_t)MP + b * 64;
        const LAS float* bh = bias + h * 257 + 128;
        const float bfar = bh[128];
        bf16x8 qf[2][2];
#pragma unroll
        for (int qt = 0; qt < 2; ++qt)
#pragma unroll
            for (int kk = 0; kk < 2; ++kk) qf[qt][kk] = ld_frag(Q + (qrow0 + 16 * qt + i16) * 1024 + h * 64 + 32 * kk + 8 * g);
        f32x4 ot[4][2];
#pragma unroll
        for (int dt = 0; dt < 4; ++dt) { ot[dt][0] = (f32x4){0.f, 0.f, 0.f, 0.f}; ot[dt][1] = (f32x4){0.f, 0.f, 0.f, 0.f}; }
        float mrun[2] = {-1e30f, -1e30f}, lrun[2] = {0.f, 0.f};
        bf16x8 kc[4][2], kn[4][2];
        {   const bf16* kp = Kb + (kbase + keyoff) * 1024 + h * 64 + 8 * g;
#pragma unroll
            for (int t4 = 0; t4 < 4; ++t4) { const bf16* p = kp + (size_t)(32 * (t4 >> 1) + 4 * (t4 & 1)) * 1024; kc[t4][0] = ld_frag(p); kc[t4][1] = ld_frag(p + 32); } }
#pragma unroll 1
        for (int kb = 0; kb < nkb; ++kb) {
            const int kpos0 = kstart + 64 * kb;
            const size_t krow0 = (samp && kb == 8) ? knew : kbase + 64 * kb;
            bf16x8 vf[2][4];
            {   const bf16* vp = Vt + (size_t)(h * 64 + i16) * LDV + krow0 + 8 * g;
#pragma unroll
                for (int sb = 0; sb < 2; ++sb)
#pragma unroll
                    for (int dt = 0; dt < 4; ++dt) vf[sb][dt] = ld_frag(vp + (size_t)(16 * dt) * LDV + 32 * sb); }
            if (kb + 1 < nkb) {
                const size_t krow1 = (samp && kb + 1 == 8) ? knew : kbase + 64 * (kb + 1);
                const bf16* kp = Kb + (krow1 + keyoff) * 1024 + h * 64 + 8 * g;
#pragma unroll
                for (int t4 = 0; t4 < 4; ++t4) { const bf16* p = kp + (size_t)(32 * (t4 >> 1) + 4 * (t4 & 1)) * 1024; kn[t4][0] = ld_frag(p); kn[t4][1] = ld_frag(p + 32); }
            }
            f32x4 st[4][2];
#pragma unroll
            for (int t4 = 0; t4 < 4; ++t4)
#pragma unroll
                for (int qt = 0; qt < 2; ++qt) {
                    f32x4 acc = {0.f, 0.f, 0.f, 0.f};
                    acc = __builtin_amdgcn_mfma_f32_16x16x32_bf16(kc[t4][0], qf[qt][0], acc, 0, 0, 0);
                    acc = __builtin_amdgcn_mfma_f32_16x16x32_bf16(kc[t4][1], qf[qt][1], acc, 0, 0, 0);
                    st[t4][qt] = acc;
                }
            const bool far = qpos0 - (kpos0 + 63) >= 128;
            bf16x8 pf[2][2];
#pragma unroll
            for (int qt = 0; qt < 2; ++qt) {
                const int qpos = qpos0 + 16 * qt + i16;
                float mx = -1e30f;
                float boff = 0.f;
                if (far) {
#pragma unroll
                    for (int t4 = 0; t4 < 4; ++t4)
#pragma unroll
                        for (int j = 0; j < 4; ++j) mx = fmaxf(mx, st[t4][qt][j]);
                    mx += bfar; boff = bfar;
                } else {
#pragma unroll
                    for (int t4 = 0; t4 < 4; ++t4)
#pragma unroll
                        for (int j = 0; j < 4; ++j) {
                            int rel = qpos - (kpos0 + 32 * (t4 >> 1) + 8 * g + 4 * (t4 & 1) + j); rel = rel > 128 ? 128 : (rel < -128 ? -128 : rel);
                            const float s = st[t4][qt][j] + bh[rel]; st[t4][qt][j] = s; mx = fmaxf(mx, s);
                        }
                }
                mx = fmaxf(mx, __shfl_xor(mx, 16)); mx = fmaxf(mx, __shfl_xor(mx, 32));
                const float mnew = fmaxf(mrun[qt], mx), corr = __builtin_amdgcn_exp2f(mrun[qt] - mnew), msub = mnew - boff; mrun[qt] = mnew;
                float psum = 0.f;
#pragma unroll
                for (int sb = 0; sb < 2; ++sb) {
                    float p[8];
#pragma unroll
                    for (int T = 0; T < 2; ++T)
#pragma unroll
                        for (int j = 0; j < 4; ++j) { p[4 * T + j] = __builtin_amdgcn_exp2f(st[2 * sb + T][qt][j] - msub); psum += p[4 * T + j]; }
                    pf[sb][qt] = __builtin_bit_cast(bf16x8, pack8(p));
                }
                lrun[qt] = lrun[qt] * corr + psum;
#pragma unroll
                for (int dt = 0; dt < 4; ++dt) ot[dt][qt] *= corr;
            }
#pragma unroll
            for (int sb = 0; sb < 2; ++sb)
#pragma unroll
                for (int dt = 0; dt < 4; ++dt)
#pragma unroll
                    for (int qt = 0; qt < 2; ++qt) ot[dt][qt] = __builtin_amdgcn_mfma_f32_16x16x32_bf16(vf[sb][dt], pf[sb][qt], ot[dt][qt], 0, 0, 0);
#pragma unroll
            for (int t4 = 0; t4 < 4; ++t4) { kc[t4][0] = kn[t4][0]; kc[t4][1] = kn[t4][1]; }
        }
#pragma unroll
        for (int qt = 0; qt < 2; ++qt) {
            float l = lrun[qt]; l += __shfl_xor(l, 16); l += __shfl_xor(l, 32);
            const float inv = 1.0f / l;
            bf16* op = O + (qrow0 + 16 * qt + i16) * 1024 + h * 64 + 4 * g;
#pragma unroll
            for (int dt = 0; dt < 4; ++dt) { const f32x4 v = ot[dt][qt] * inv; v2u w; w.x = cvt_pk_bf16(v[0], v[1]); w.y = cvt_pk_bf16(v[2], v[3]); *(v2u*)(op + 16 * dt) = w; }
        }
    }
    const int gt = blockIdx.x * NTHREADS + tid, ngt = gridDim.x * NTHREADS;
    for (int idx = gt; idx < 8 * 16 * 512 * 8; idx += ngt) {
        const int d8 = idx & 7, r = (idx >> 3) & 511, h = (idx >> 12) & 15, b = idx >> 16;
        float f[8]; unpack8(*(const v4u*)(Kb + ((size_t)b * TPR + 7680 + r) * 1024 + h * 64 + d8 * 8), f);
        float* dst = a.out + O_PK + ((((size_t)o * 8 + b) * 16 + h) * 512 + r) * 64 + d8 * 8;
        *(f32x4*)dst = (f32x4){f[0], f[1], f[2], f[3]}; *(f32x4*)(dst + 4) = (f32x4){f[4], f[5], f[6], f[7]};
    }
    for (int idx = gt; idx < 8 * 16 * 64 * 64; idx += ngt) {
        const int r8 = idx & 63, d = (idx >> 6) & 63, h = (idx >> 12) & 15, b = idx >> 16;
        float f[8]; unpack8(*(const v4u*)(Vt + (size_t)(h * 64 + d) * LDV + (size_t)b * TPR + 7680 + r8 * 8), f);
        float* dst = a.out + O_PV + ((((size_t)o * 8 + b) * 16 + h) * 512 + r8 * 8) * 64 + d;
#pragma unroll
        for (int j = 0; j < 8; ++j) dst[j * 64] = f[j];
    }
    for (int idx = gt; idx < 16 * 16 * 64 * 8; idx += ngt) {
        const int d8 = idx & 7, t = (idx >> 3) & 63, h = (idx >> 9) & 15, b = idx >> 13;
        float f[8]; unpack8(*(const v4u*)(Kb + ((size_t)MP + b * 64 + t) * 1024 + h * 64 + d8 * 8), f);
        float* dst = a.out + O_SK + ((((size_t)o * 16 + b) * 16 + h) * 64 + t) * 64 + d8 * 8;
        *(f32x4*)dst = (f32x4){f[0], f[1], f[2], f[3]}; *(f32x4*)(dst + 4) = (f32x4){f[4], f[5], f[6], f[7]};
    }
    for (int idx = gt; idx < 16 * 16 * 64 * 8; idx += ngt) {
        const int t8 = idx & 7, d = (idx >> 3) & 63, h = (idx >> 9) & 15, b = idx >> 13;
        float f[8]; unpack8(*(const v4u*)(Vt + (size_t)(h * 64 + d) * LDV + (size_t)MP + b * 64 + t8 * 8), f);
        float* dst = a.out + O_SV + ((((size_t)o * 16 + b) * 16 + h) * 64 + t8 * 8) * 64 + d;
#pragma unroll
        for (int j = 0; j < 8; ++j) dst[j * 64] = f[j];
    }
}

#define XB_TMO      128
#define XB_XCNT(j)  (256  + 64 * (j))
#define XB_XSUB(j)  (1280 + 64 * (j))
#define XB_XGEN(j)  (2304 + 64 * (j))
#define XB_TOP      3328
#define XB_TOPGEN   3392
#define XCD_BAR_WORDS 3456
#define XB_SPIN_CAP (1u << 18)

__device__ __forceinline__ unsigned xb_ld(unsigned* p)              { return __hip_atomic_load(p, __ATOMIC_RELAXED, __HIP_MEMORY_SCOPE_AGENT); }
__device__ __forceinline__ unsigned xb_add(unsigned* p, unsigned v) { return __hip_atomic_fetch_add(p, v, __ATOMIC_RELAXED, __HIP_MEMORY_SCOPE_AGENT); }
__device__ __forceinline__ unsigned xb_xcc_id() { return (unsigned)__builtin_amdgcn_s_getreg((3 << 11) | 20) & 0xFu; }
#define XB_SPIN(cond, bar) do { unsigned _sp = 0; while (cond) { __builtin_amdgcn_s_sleep(1); \
    if ((++_sp & 255u) == 0u) { if (xb_ld(&(bar)[XB_TMO])) break; if (_sp > XB_SPIN_CAP) { atomicAdd(&(bar)[XB_TMO], 1u); break; } } } } while (0)

struct XcdBarrier {
    unsigned* bar; unsigned x;
    volatile LAS unsigned* st;
};

__device__ __forceinline__ XcdBarrier xcd_barrier_post(unsigned* bar, volatile LAS unsigned* st) {
    XcdBarrier b; b.bar = bar; b.x = xb_xcc_id(); b.st = st;
    if (threadIdx.x == 0) (void)xb_add(&bar[XB_XCNT(b.x)], 1u);
    return b;
}
__device__ __forceinline__ void xcd_barrier_complete(unsigned* bar, unsigned x, unsigned& nloc, unsigned& nx) {
    const unsigned G = gridDim.x * gridDim.y * gridDim.z;
    unsigned sum, cnt, mine, sp = 0u;
    for (;;) {
        sum = 0u; cnt = 0u; mine = 0u;
#pragma unroll
        for (unsigned j = 0; j < 16; ++j) { const unsigned c = xb_ld(&bar[XB_XCNT(j)]); sum += c; cnt += (c > 0u) ? 1u : 0u; mine = (j == x) ? c : mine; }
        if (sum == G) break;
        __builtin_amdgcn_s_sleep(1);
        if ((++sp & 255u) == 0u) { if (xb_ld(&bar[XB_TMO])) break; if (sp > XB_SPIN_CAP) { atomicAdd(&bar[XB_TMO], 1u); break; } }
    }
    nloc = mine > 0u ? mine : 1u; nx = cnt > 0u ? cnt : 1u;
}

__device__ __forceinline__ void xcd_barrier(const XcdBarrier& b) {
    asm volatile("s_waitcnt vmcnt(0)" ::: "memory");
    __syncthreads();
    if (threadIdx.x == 0) {
        unsigned* bar = b.bar;
        __builtin_amdgcn_s_waitcnt(0);
        unsigned nloc = b.st[0], nx = b.st[1];
        if (nloc == 0u) { xcd_barrier_complete(bar, b.x, nloc, nx); b.st[0] = nloc; b.st[1] = nx; }
        const unsigned old = xb_add(&bar[XB_XSUB(b.x)], 1u);
        const unsigned gen = old / nloc;
        if (old + 1u == (gen + 1u) * nloc) {
            __builtin_amdgcn_fence(__ATOMIC_RELEASE, "agent");
            asm volatile("s_waitcnt vmcnt(0)" ::: "memory");
            const unsigned og = xb_add(&bar[XB_TOP], 1u);
            const unsigned tg = og / nx;
            if (og + 1u == (tg + 1u) * nx) xb_add(&bar[XB_TOPGEN], 1u);
            else XB_SPIN(xb_ld(&bar[XB_TOPGEN]) == tg, bar);
            __builtin_amdgcn_fence(__ATOMIC_ACQUIRE, "agent");
            xb_add(&bar[XB_XGEN(b.x)], 1u);
            asm volatile("s_waitcnt vmcnt(0)" ::: "memory");
        } else {
            XB_SPIN(xb_ld(&bar[XB_XGEN(b.x)]) == gen, bar);
            __builtin_amdgcn_fence(__ATOMIC_ACQUIRE, "agent");
            asm volatile("s_waitcnt vmcnt(0)" ::: "memory");
        }
    }
    __syncthreads();
}

#ifndef REP_GEMM
#define REP_GEMM 1
#endif
#ifndef REP_SCAN
#define REP_SCAN 1
#endif
#ifndef REP_ATTN
#define REP_ATTN 1
#endif
#ifndef REP_LN
#define REP_LN 1
#endif
#ifndef EXTRA_SYNC
#define EXTRA_SYNC 2
#endif
#ifndef PH_STOP
#define PH_STOP N_PHASES
#endif
#ifndef PHMASK
#define PHMASK 0xffff
#endif
#define PHM(i) (((PHMASK) >> (i)) & 1)
constexpr int NS_K1 = 4, NS_K2 = 11;
constexpr int PH_PER_PAIR = 19, N_PHASES = 1 + 2 * PH_PER_PAIR;
__global__ void __launch_bounds__(NTHREADS, 2) trunk_fwd(Args a) {
    __shared__ __attribute__((aligned(16))) unsigned char lds_raw[LDS_BYTES];
    LAS unsigned char* lds = (LAS unsigned char*)lds_raw;
    cg::grid_group grid = cg::this_grid();
    volatile LAS unsigned* bar_st = (volatile LAS unsigned*)(lds + 131072);
    if (threadIdx.x < 2) bar_st[threadIdx.x] = 0u;
    __syncthreads();
    XcdBarrier xbar = xcd_barrier_post((unsigned*)(a.ws + WS_BAR), bar_st);
    unsigned char* ws = a.ws;
    bf16* XB = (bf16*)(ws + OFF_XB); bf16* R1 = (bf16*)(ws + OFF_R1); bf16* Z = (bf16*)(ws + OFF_Z); bf16* BIG = (bf16*)(ws + OFF_BIG);
    const int G = gridDim.x, cb = blockIdx.x;
#pragma unroll 1
    for (int ph = a.ph_lo; ph < a.ph_hi; ++ph) {
        bool nosync = false;
        if (ph == 0) { if (PHM(0)) prologue_phase(a, lds); }
        else {
            const int e = (ph - 1) / PH_PER_PAIR, q = (ph - 1) - e * PH_PER_PAIR;
            const int layer = 2 * e + (q >= 11 ? 1 : 0);
            int kind = -1; pg8::Gemm g{nullptr, nullptr, MT, 0, 0, nullptr, nullptr};
            pg8::EpiBf16 eb{nullptr, 0, 0, 0, 1.f, nullptr, 0}; int m2 = 0, n2 = 0;
            switch (q) {
            case 0:  kind = 0; g = pg8::Gemm{XB, (const bf16*)(ws + W_IN + e * W_IN_SZ), MT, NMIX, 1024, nullptr, nullptr}; eb = pg8::EpiBf16{BIG, APROJ, APROJ, (size_t)MT * APROJ, 1.f, nullptr, 0}; break;
            case 2:  kind = 0; g = pg8::Gemm{Z, (const bf16*)(ws + W_LO + e * W_LO_SZ), MT, NLORA, KLORA, nullptr, nullptr}; eb = pg8::EpiBf16{R1, 512, 512, (size_t)MT * 512, 1.f, nullptr, 0}; break;
            case 11: kind = 0; g = pg8::Gemm{XB, (const bf16*)(ws + W_QKV + e * W_QKV_SZ), MT, 2048, 1024, (const bf16*)(ws + W_QKV + e * W_QKV_SZ) + (size_t)2048 * 1024, XB};
                     eb = pg8::EpiBf16{BIG, 1024, 1024, (size_t)MT * 1024, 0.125f * 1.4426950408889634f, BIG + BIG_VT, LDV}; m2 = 1024; n2 = MT; break;
            case 12: nosync = true; break;
            case 8: case 16: kind = 1; g = pg8::Gemm{XB, (const bf16*)(ws + W_FI + layer * W_FI_SZ), MT, 2 * FH, 1024, nullptr, nullptr}; break;
            case 6:  kind = 2; g = pg8::Gemm{R1, (const bf16*)(ws + W_OM + e * W_SQ_SZ), MT, 1024, 1024, nullptr, nullptr}; break;
            case 14: kind = 2; g = pg8::Gemm{R1, (const bf16*)(ws + W_O + e * W_SQ_SZ), MT, 1024, 1024, nullptr, nullptr}; break;
            case 9: case 17: kind = 2; g = pg8::Gemm{BIG, (const bf16*)(ws + W_FO + layer * W_FO_SZ), MT, 1024, FH, nullptr, nullptr}; break;
            default: break;
            }
            const int nrep = kind >= 0 ? REP_GEMM : (q == 4 ? REP_SCAN : (q == 13 ? REP_ATTN : ((q == 7 || q == 15 || q == 10 || q == 18) ? REP_LN : 1)));
            if (q == 11) cache_convert(a, e);
#pragma unroll 1
            for (int rep = 0; rep < nrep; ++rep) {
            if (kind == 0 && PHM(1)) { pg8::StaticOrder S; S.init(g.M, g.N, G, cb, g.K, q == 2 ? 1 : 0); if (m2) S.second(m2, n2); pg8::gemm_phase<pg8::EpiBf16, pg8::StaticOrder, true, true>(lds, g, S, eb); }
            else if (kind == 1 && PHM(2)) { pg8::StaticOrder S; S.init(g.M, g.N, G, cb, g.K); pg8::EpiSwiglu es{BIG, FH}; pg8::gemm_phase<pg8::EpiSwiglu, pg8::StaticOrder, true, true>(lds, g, S, es); }
            else if (kind == 2 && PHM(3)) { pg8::SplitOrder S; S.init(G, cb, g.K, g.K == 1024 ? NS_K1 : NS_K2); pg8::EpiResid er{XB, Z, 1024, DN_ALPHA, (float*)(ws + OFF_G)}; pg8::gemm_phase<pg8::EpiResid, pg8::SplitOrder, true, true>(lds, g, S, er); }
            else if (q == 1 && PHM(4)) prep1_phase(a, e);
            else if (q == 3 && PHM(5)) prep2_phase(a, e);
            else if (q == 4 && PHM(6)) scan_phase(a, e, lds);
            else if (q == 5 && PHM(7)) post_phase(a, e);
            else if (q == 13 && PHM(8)) attn_phase(a, e, lds);
            else if ((q == 7 || q == 15) && PHM(9)) ln_phase(a, a.in[26] + (size_t)layer * 1024, a.in[27] + (size_t)layer * 1024, nullptr, NS_K1);
            else if ((q == 10 || q == 18) && PHM(9)) ln_phase(a, a.in[28] + (size_t)layer * 1024, a.in[29] + (size_t)layer * 1024, (layer == 3) ? a.out : nullptr, NS_K2);
        }
        }
        if (ph + 1 < a.ph_hi && !nosync) { if (ph == 0) grid.sync(); else xcd_barrier(xbar); }
        else __syncthreads();
    }
}

extern "C" void kernel_launch(void* const* d_in, const int* in_sizes, int n_in, void* d_out, int out_size, void* d_ws, size_t ws_size, hipStream_t stream) {
    static int grid = 0; static int badsz = 0;
    if (grid == 0) {
        if (n_in != 32 || ws_size < WS_BAR + WS_BAR_BYTES || out_size != 92360704) { fprintf(stderr, "kernel_launch: unexpected shapes (n_in %d, ws %zu, out %d)\n", n_in, ws_size, out_size); grid = -1; return; }
        static const long long exp_sz[32] = {67108864LL, 1048576, 1048576, 57344, 1048576, 16777216, 16777216, 6848512, 3584, 1024, 65536, 1024, 65536, 131072, 1024, 1024, 1024, 1024, 1024, 8192, 512, 256, 2097152, 6291456, 8224, 2097152, 4096, 4096, 4096, 4096, 23068672, 11534336};
        for (int i = 0; i < 32; ++i) if ((long long)in_sizes[i] != exp_sz[i]) { fprintf(stderr, "kernel_launch: input %d has %d elements, expected %lld\n", i, in_sizes[i], exp_sz[i]); badsz = 1; }
        int dev = 0, cus = 0, per_cu = 0;
        hipGetDevice(&dev); hipDeviceGetAttribute(&cus, hipDeviceAttributeMultiprocessorCount, dev);
        if (hipOccupancyMaxActiveBlocksPerMultiprocessor(&per_cu, (const void*)trunk_fwd, NTHREADS, 0) != hipSuccess || per_cu < 1) { fprintf(stderr, "kernel_launch: occupancy query says %d\n", per_cu); per_cu = 1; }
        (void)hipGetLastError();
        grid = cus * per_cu;
    }
    if (grid < 0) return;
    Args a{};
    for (int i = 0; i < 32; ++i) a.in[i] = (const float*)d_in[i];
    a.out = (float*)d_out; a.ws = (unsigned char*)d_ws;
#if defined(MK_PER_PHASE)
    for (int p = 0; p < N_PHASES; ++p) { a.ph_lo = p; a.ph_hi = p + 1; hipLaunchKernelGGL(trunk_fwd, dim3(grid), dim3(NTHREADS), 0, stream, a); }
#else
    a.ph_lo = 0; a.ph_hi = badsz ? 0 : PH_STOP;
    if (hipMemsetAsync((char*)d_ws + WS_BAR, 0, WS_BAR_BYTES, stream) != hipSuccess) { fprintf(stderr, "kernel_launch: memset of the barrier words failed\n"); return; }
    void* args[] = {&a};
    hipError_t err = hipLaunchCooperativeKernel((const void*)trunk_fwd, dim3(grid), dim3(NTHREADS), args, 0, stream);
    if (err != hipSuccess) fprintf(stderr, "kernel_launch: cooperative launch failed: %s (grid %d)\n", hipGetErrorString(err), grid);
#endif
}
```

```cpp
#include <hip/hip_runtime.h>
#include <hip/hip_cooperative_groups.h>
#include <cstdio>
#include <cstdint>
namespace cg = cooperative_groups;
namespace pg8 {
#define PG8_LAS __attribute__((address_space(3)))
typedef unsigned short bf16_t;
typedef short bf16x8 __attribute__((ext_vector_type(8)));
typedef float f32x4 __attribute__((ext_vector_type(4)));
typedef unsigned u32x4 __attribute__((ext_vector_type(4)));
constexpr int BM = 256, BK = 64, HALF = 128, HTB = HALF * BK * 2  , STAGE_BYTES = 8 * HTB, NXCD = 8, WGM = 8;

__host__ __device__ __forceinline__ int lds_byte(int r, int c) { const int st = (r >> 4) * 2 + (c >> 5), rr = r & 15, cc = c & 31, ob = rr * 64 + cc * 2; return st * 1024 + (ob ^ (((ob >> 9) & 1) << 5)); }
__host__ __device__ __forceinline__ void stage_rc(int b, int& R, int& C) { const int st = b / 1024, sb = b % 1024, swz = sb ^ (((sb >> 9) & 1) << 5); R = (st >> 1) * 16 + swz / 64; C = (st & 1) * 32 + (swz % 64) / 2; }
__host__ __device__ __forceinline__ int perm32(int rho) { const int n = rho >> 4, i = rho & 15; return 8 * (i >> 2) + 4 * n + (i & 3); }

struct Unit { int pm, pn, k0, nt, sl, z; };
struct Gemm { const bf16_t* A; const bf16_t* Bt; int M, N, K; const bf16_t* A2; const bf16_t* Bt2; };

struct StaticOrder {
    int nM, nN, nwg, G, c, ntk, lora, nM2, nN2, nwg2;
    __host__ __device__ void init(int M, int N, int G_, int c_, int K_, int lora_ = 0) { nM = M / BM; nN = N / BM; nwg = nM * nN; G = G_; c = c_; ntk = K_ / BK; lora = lora_; nM2 = 0; nN2 = 0; nwg2 = 0; }
    __host__ __device__ void second(int M2, int N2) { nM2 = M2 / BM; nN2 = N2 / BM; nwg2 = nM2 * nN2; }
    __host__ __device__ bool next(int i, Unit& u) const {
        long L = (long)i * G + c; int nM_ = nM, nN_ = nN, nwg_ = nwg, z_ = 0;
        if (L >= nwg) { L -= nwg; if (L >= nwg2) return false; nM_ = nM2; nN_ = nN2; nwg_ = nwg2; z_ = 1; }
        int wgid = (int)L; { const int q = nwg_ / NXCD, r = nwg_ % NXCD, xcd = wgid % NXCD, off = wgid / NXCD; wgid = (xcd < r ? xcd * (q + 1) : r * (q + 1) + (xcd - r) * q) + off; }
        const int nig = WGM * nN_, gid = wgid / nig, fm = gid * WGM, gsz = (nM_ - fm) < WGM ? (nM_ - fm) : WGM;
        u.pm = fm + ((wgid % nig) % gsz); u.pn = (wgid % nig) / gsz; u.k0 = 0; u.nt = ntk; u.sl = -1; u.z = z_; if (lora) { u.k0 = u.pn < 4 ? 0 : 2; u.nt = 2; } return true;
    }
    __device__ __forceinline__ void a_ready(const Unit&) const {}
    __device__ __forceinline__ void done(const Unit&) const {}
};

struct SplitOrder {
    StaticOrder so; int NS, nts, G, c;
    __host__ __device__ void init(int G_, int c_, int K_, int NS_) { so.init(65536, 1024, G_, c_, K_); NS = NS_; nts = (K_ / BK) / NS_; G = G_; c = c_; }
    __host__ __device__ bool next(int i, Unit& u) const {
        if (so.next(i, u)) return true;
        const long L = (long)i * G + c - 1024; if (L < 0 || L >= 16 * NS) return false;
        const int tile = (int)L / NS, sl = (int)L - tile * NS;
        u.pm = 256 + (tile >> 2); u.pn = tile & 3; u.k0 = sl * nts; u.nt = nts; u.sl = sl; u.z = 0; return true;
    }
    __device__ __forceinline__ void a_ready(const Unit&) const {}
    __device__ __forceinline__ void done(const Unit&) const {}
};

__device__ __forceinline__ unsigned cvt_pk_bf16(float lo, float hi) { unsigned r; asm volatile("v_cvt_pk_bf16_f32 %0, %1, %2" : "=v"(r) : "v"(lo), "v"(hi)); return r; }
__device__ __forceinline__ float bf_lo(unsigned w) { return __uint_as_float(w << 16); }
__device__ __forceinline__ float bf_hi(unsigned w) { return __uint_as_float(w & 0xffff0000u); }
struct EpiBf16 {
    static constexpr bool PERM = true, AFTER_DRAIN = false;
    bf16_t* O; int ldc; int split_cols; size_t split_stride; float scale0; bf16_t* O2; int ldc2;
    __device__ __forceinline__ void operator()(const f32x4 (&acc)[2][2][4][2], const Unit& u, int wr, int wc, int fr, int fq) const {
        const int row0 = u.pm * BM + wr * 64 + fr; int colt = u.pn * BM; bf16_t* base = u.z ? O2 : O; const int ldc = u.z ? ldc2 : this->ldc;
        float sc = 1.f; if (split_cols && !u.z) { const int t = colt / split_cols; base += (size_t)t * split_stride; colt -= t * split_cols; if (t == 0) sc = scale0; }
        const int col0 = colt + wc * 32 + 8 * fq;
#pragma unroll
        for (int ai = 0; ai < 2; ++ai)
#pragma unroll
            for (int m = 0; m < 4; ++m) { bf16_t* rowp = base + (size_t)(row0 + ai * HALF + m * 16) * ldc + col0;
#pragma unroll
                for (int bj = 0; bj < 2; ++bj) { const f32x4 v0 = acc[ai][bj][m][0] * sc, v1 = acc[ai][bj][m][1] * sc;
                    u32x4 w; w.x = cvt_pk_bf16(v0[0], v0[1]); w.y = cvt_pk_bf16(v0[2], v0[3]); w.z = cvt_pk_bf16(v1[0], v1[1]); w.w = cvt_pk_bf16(v1[2], v1[3]);
                    *(u32x4*)(rowp + bj * HALF) = w; } }
    }
};
__device__ __forceinline__ float silu_f(float x) { return x * __builtin_amdgcn_rcpf(1.0f + __expf(-x)); }
struct EpiSwiglu {
    static constexpr bool PERM = true, AFTER_DRAIN = false;
    bf16_t* O; int ldc;
    __device__ __forceinline__ void operator()(const f32x4 (&acc)[2][2][4][2], const Unit& u, int wr, int wc, int fr, int fq) const {
        const int row0 = u.pm * BM + wr * 64 + fr; const int col0 = u.pn * HALF + wc * 32 + 8 * fq;
#pragma unroll
        for (int ai = 0; ai < 2; ++ai)
#pragma unroll
            for (int m = 0; m < 4; ++m) { bf16_t* rowp = O + (size_t)(row0 + ai * HALF + m * 16) * ldc + col0;
                const f32x4 g0 = acc[ai][0][m][0], g1 = acc[ai][0][m][1], u0 = acc[ai][1][m][0], u1 = acc[ai][1][m][1];
                u32x4 w;
                w.x = cvt_pk_bf16(silu_f(g0[0]) * u0[0], silu_f(g0[1]) * u0[1]); w.y = cvt_pk_bf16(silu_f(g0[2]) * u0[2], silu_f(g0[3]) * u0[3]);
                w.z = cvt_pk_bf16(silu_f(g1[0]) * u1[0], silu_f(g1[1]) * u1[1]); w.w = cvt_pk_bf16(silu_f(g1[2]) * u1[2], silu_f(g1[3]) * u1[3]);
                *(u32x4*)rowp = w; }
    }
};
struct EpiResid {
    static constexpr bool PERM = true, AFTER_DRAIN = false;
    const bf16_t* X; bf16_t* Z; int ldc; float alpha; float* ZS;
    __device__ __forceinline__ void operator()(const f32x4 (&acc)[2][2][4][2], const Unit& u, int wr, int wc, int fr, int fq) const {
        const int row0 = u.pm * BM + wr * 64 + fr; const int col0 = u.pn * BM + wc * 32 + 8 * fq;
        if (u.sl >= 0) {
            float* zs = ZS + ((size_t)u.sl * 1024 + (row0 - 65536)) * 1024 + col0;
#pragma unroll
            for (int ai = 0; ai < 2; ++ai)
#pragma unroll
                for (int m = 0; m < 4; ++m)
#pragma unroll
                    for (int bj = 0; bj < 2; ++bj) { float* q = zs + (size_t)(ai * HALF + m * 16) * 1024 + bj * HALF; *(f32x4*)q = acc[ai][bj][m][0]; *(f32x4*)(q + 4) = acc[ai][bj][m][1]; }
            return;
        }
#pragma unroll
        for (int ai = 0; ai < 2; ++ai)
#pragma unroll
            for (int m = 0; m < 4; ++m) { const size_t off = (size_t)(row0 + ai * HALF + m * 16) * ldc + col0;
#pragma unroll
                for (int bj = 0; bj < 2; ++bj) { const u32x4 x = *(const u32x4*)(X + off + bj * HALF);
                    const f32x4 v0 = acc[ai][bj][m][0], v1 = acc[ai][bj][m][1];
                    u32x4 w;
                    w.x = cvt_pk_bf16(alpha * bf_lo(x.x) + v0[0], alpha * bf_hi(x.x) + v0[1]); w.y = cvt_pk_bf16(alpha * bf_lo(x.y) + v0[2], alpha * bf_hi(x.y) + v0[3]);
                    w.z = cvt_pk_bf16(alpha * bf_lo(x.z) + v1[0], alpha * bf_hi(x.z) + v1[1]); w.w = cvt_pk_bf16(alpha * bf_lo(x.w) + v1[2], alpha * bf_hi(x.w) + v1[3]);
                    *(u32x4*)(Z + off + bj * HALF) = w; } }
    }
};
template <class Epi, class Sched, bool ALIGN_EPI = false, bool SP2 = false>
__device__ __forceinline__ void gemm_phase(PG8_LAS unsigned char* lds, const Gemm g, const Sched& S, const Epi& E) {
    int tid = threadIdx.x; asm volatile("" : "+v"(tid)); const int wid = __builtin_amdgcn_readfirstlane(tid >> 6), lane = tid & 63, wr = wid >> 2, wc = wid & 3, fr = lane & 15, fq = lane >> 4;
    const int K = g.K;
    unsigned voffA[2], voffB[2];
#pragma unroll
    for (int i = 0; i < 2; ++i) { int R, C; stage_rc(tid * 16 + i * 8192, R, C); const int Rb = Epi::PERM ? ((R & ~31) + perm32(R & 31)) : R;
        voffA[i] = (unsigned)(R * K + C) * 2u; voffB[i] = (unsigned)(Rb * K + C) * 2u; }
    const size_t kstep = (size_t)(BK * 2);
    const size_t hstep = (size_t)HALF * K * 2;
    const size_t tstep = 2 * hstep;
    const unsigned ldsw = (unsigned)wid * 1024u;
    const int aoff = lds_byte(wr * 64 + fr, fq * 8), boff = lds_byte(wc * 32 + fr, fq * 8);
#define PG8_SA(b, h) (((b) * 2 + (h)) * HTB)
#define PG8_SB(b, h) ((4 + (b) * 2 + (h)) * HTB)
#define PG8_STAGE(bufoff, gbase, voff) do { _Pragma("unroll") for (int _i = 0; _i < 2; ++_i) \
        __builtin_amdgcn_global_load_lds((const unsigned*)((const char*)(gbase) + (voff)[_i]), (PG8_LAS unsigned*)(lds + (bufoff) + ldsw + _i * 8192), 16, 0, 0); } while (0)
#define PG8_LDA(dst, b, h) do { _Pragma("unroll") for (int m = 0; m < 4; ++m) _Pragma("unroll") for (int k = 0; k < 2; ++k) dst[m][k] = *(const PG8_LAS bf16x8*)(lds + PG8_SA(b, h) + aoff + m * 2048 + k * 1024); } while (0)
#define PG8_LDB(dst, b, h) do { _Pragma("unroll") for (int n = 0; n < 2; ++n) _Pragma("unroll") for (int k = 0; k < 2; ++k) dst[n][k] = *(const PG8_LAS bf16x8*)(lds + PG8_SB(b, h) + boff + n * 2048 + k * 1024); } while (0)
#define PG8_MMA(ai, bj, At, Bt) do { __builtin_amdgcn_s_setprio(1); _Pragma("unroll") for (int m = 0; m < 4; ++m) _Pragma("unroll") for (int n = 0; n < 2; ++n) _Pragma("unroll") for (int k = 0; k < 2; ++k) \
        acc[ai][bj][m][n] = __builtin_amdgcn_mfma_f32_16x16x32_bf16(Bt[n][k], At[m][k], acc[ai][bj][m][n], 0, 0, 0); __builtin_amdgcn_s_setprio(0); } while (0)
#define PG8_WAIT_V(n) asm volatile("s_waitcnt vmcnt(" #n ")" ::: "memory")
#define PG8_WAIT_L(n) asm volatile("s_waitcnt lgkmcnt(" #n ")" ::: "memory")
#define PG8_BAR __builtin_amdgcn_s_barrier()
#define PG8_SCHED __builtin_amdgcn_sched_barrier(0)
    Unit cur, nxt; int ui = 0;
    if (!S.next(0, cur)) return;
    f32x4 acc[2][2][4][2];
#pragma unroll
    for (int a = 0; a < 2; ++a)
#pragma unroll
        for (int b = 0; b < 2; ++b)
#pragma unroll
            for (int m = 0; m < 4; ++m)
#pragma unroll
                for (int n = 0; n < 2; ++n) acc[a][b][m][n] = (f32x4){0.f, 0.f, 0.f, 0.f};
    bf16x8 At[4][2], B0[2][2], B1[2][2];
    const char* cA = (const char*)(cur.z ? g.A2 : g.A) + (size_t)cur.pm * tstep + (size_t)cur.k0 * kstep; const char* cB = (const char*)(cur.z ? g.Bt2 : g.Bt) + (size_t)cur.pn * tstep + (size_t)cur.k0 * kstep;
    S.a_ready(cur);
    if constexpr (SP2) {
        PG8_STAGE(PG8_SB(0, 0), cB, voffB); PG8_STAGE(PG8_SB(0, 1), cB + hstep, voffB); PG8_STAGE(PG8_SA(0, 0), cA, voffA); PG8_STAGE(PG8_SA(0, 1), cA + hstep, voffA);
        if (wr == 1) PG8_BAR;
        PG8_WAIT_V(2); PG8_BAR;
        PG8_STAGE(PG8_SB(1, 0), cB + kstep, voffB); PG8_STAGE(PG8_SA(1, 0), cA + kstep, voffA); PG8_STAGE(PG8_SB(1, 1), cB + hstep + kstep, voffB);
        PG8_WAIT_V(6); PG8_BAR;
    } else {
        PG8_STAGE(PG8_SB(0, 0), cB, voffB); PG8_STAGE(PG8_SA(0, 0), cA, voffA); PG8_STAGE(PG8_SB(0, 1), cB + hstep, voffB); PG8_STAGE(PG8_SA(0, 1), cA + hstep, voffA);
        if (wr == 1) PG8_BAR;
        PG8_WAIT_V(4); PG8_BAR;
        PG8_STAGE(PG8_SB(1, 0), cB + kstep, voffB); PG8_STAGE(PG8_SA(1, 0), cA + kstep, voffA); PG8_STAGE(PG8_SB(1, 1), cB + hstep + kstep, voffB);
        PG8_WAIT_V(6); PG8_BAR;
    }
    for (;;) {
        const bool has_next = S.next(ui + 1, nxt);
        const char* nA = has_next ? (const char*)(nxt.z ? g.A2 : g.A) + (size_t)nxt.pm * tstep + (size_t)nxt.k0 * kstep : cA; const char* nB = has_next ? (const char*)(nxt.z ? g.Bt2 : g.Bt) + (size_t)nxt.pn * tstep + (size_t)nxt.k0 * kstep : cB;
        const int nt = cur.nt;
        for (int t = 0; t < nt; t += 2) {
            const bool last = (t == nt - 2);
            const char* a1 = cA + (size_t)(t + 1) * kstep;
            const char* a2 = last ? nA : cA + (size_t)(t + 2) * kstep; const char* b2 = last ? nB : cB + (size_t)(t + 2) * kstep;
            const char* a3 = a2 + kstep; const char* b3 = b2 + kstep;
            if (last && has_next) S.a_ready(nxt);
            if constexpr (SP2) {
            PG8_LDB(B0, 0, 0); PG8_LDB(B1, 0, 1); PG8_SCHED; PG8_LDA(At, 0, 0); PG8_STAGE(PG8_SA(1, 1), a1 + hstep, voffA);
            PG8_WAIT_V(8); PG8_WAIT_L(0); PG8_BAR; PG8_MMA(0, 0, At, B0); PG8_MMA(0, 1, At, B1); PG8_BAR; PG8_SCHED;
            PG8_LDA(At, 0, 1); PG8_STAGE(PG8_SB(0, 0), b2, voffB); PG8_STAGE(PG8_SB(0, 1), b2 + hstep, voffB); PG8_STAGE(PG8_SA(0, 0), a2, voffA);
            PG8_WAIT_V(8); PG8_WAIT_L(0); PG8_BAR; PG8_MMA(1, 0, At, B0); PG8_MMA(1, 1, At, B1); PG8_BAR; PG8_SCHED;
            PG8_LDB(B0, 1, 0); PG8_LDB(B1, 1, 1); PG8_SCHED; PG8_LDA(At, 1, 0); PG8_STAGE(PG8_SA(0, 1), a2 + hstep, voffA);
            PG8_WAIT_V(8); PG8_WAIT_L(0); PG8_BAR; PG8_MMA(0, 0, At, B0); PG8_MMA(0, 1, At, B1); PG8_BAR; PG8_SCHED;
            PG8_LDA(At, 1, 1); PG8_STAGE(PG8_SB(1, 0), b3, voffB); PG8_STAGE(PG8_SB(1, 1), b3 + hstep, voffB); PG8_STAGE(PG8_SA(1, 0), a3, voffA);
            PG8_WAIT_V(8); PG8_WAIT_L(0); PG8_BAR; PG8_MMA(1, 0, At, B0); PG8_MMA(1, 1, At, B1); PG8_BAR; PG8_SCHED;
            } else {
            PG8_LDB(B0, 0, 0); PG8_SCHED; PG8_LDA(At, 0, 0); PG8_STAGE(PG8_SA(1, 1), a1 + hstep, voffA);
            PG8_WAIT_L(8); PG8_BAR; PG8_WAIT_L(0); PG8_MMA(0, 0, At, B0); PG8_BAR; PG8_SCHED;
            PG8_LDB(B1, 0, 1); PG8_STAGE(PG8_SB(0, 0), b2, voffB);
            PG8_BAR; PG8_WAIT_L(0); PG8_MMA(0, 1, At, B1); PG8_BAR;
            PG8_LDA(At, 0, 1); PG8_STAGE(PG8_SA(0, 0), a2, voffA);
            PG8_BAR; PG8_WAIT_L(0); PG8_MMA(1, 0, At, B0); PG8_BAR; PG8_SCHED;
            PG8_STAGE(PG8_SB(0, 1), b2 + hstep, voffB);
            PG8_WAIT_V(6); PG8_BAR; PG8_MMA(1, 1, At, B1); PG8_BAR;
            PG8_LDB(B0, 1, 0); PG8_SCHED; PG8_LDA(At, 1, 0); PG8_STAGE(PG8_SA(0, 1), a2 + hstep, voffA);
            PG8_WAIT_L(8); PG8_BAR; PG8_WAIT_L(0); PG8_MMA(0, 0, At, B0); PG8_BAR; PG8_SCHED;
            PG8_LDB(B1, 1, 1); PG8_STAGE(PG8_SB(1, 0), b3, voffB);
            PG8_BAR; PG8_WAIT_L(0); PG8_MMA(0, 1, At, B1); PG8_BAR;
            PG8_LDA(At, 1, 1); PG8_STAGE(PG8_SA(1, 0), a3, voffA);
            PG8_BAR; PG8_WAIT_L(0); PG8_MMA(1, 0, At, B0); PG8_BAR; PG8_SCHED;
            PG8_STAGE(PG8_SB(1, 1), b3 + hstep, voffB);
            PG8_WAIT_V(6); PG8_BAR; PG8_MMA(1, 1, At, B1); PG8_BAR;
            }
        }
        if constexpr (ALIGN_EPI) { if (wr == 0) PG8_BAR; }
        if constexpr (!Epi::AFTER_DRAIN) { E(acc, cur, wr, wc, fr, fq); S.done(cur); }
        if (!has_next) break;
#pragma unroll
        for (int a = 0; a < 2; ++a)
#pragma unroll
            for (int b = 0; b < 2; ++b)
#pragma unroll
                for (int m = 0; m < 4; ++m)
#pragma unroll
                    for (int n = 0; n < 2; ++n) acc[a][b][m][n] = (f32x4){0.f, 0.f, 0.f, 0.f};
        cur = nxt; cA = nA; cB = nB; ++ui;
        if constexpr (ALIGN_EPI) { if (wr == 1) PG8_BAR; }
    }
    PG8_WAIT_V(0);
    if constexpr (!ALIGN_EPI) { if (wr == 0) PG8_BAR; }
    PG8_BAR;
    if constexpr (Epi::AFTER_DRAIN) { E.fused(acc, cur, wr, wc, fr, fq, lds, wid, lane); S.done(cur); }
#undef PG8_SA
#undef PG8_SB
#undef PG8_STAGE
#undef PG8_LDA
#undef PG8_LDB
#undef PG8_MMA
#undef PG8_WAIT_V
#undef PG8_WAIT_L
#undef PG8_BAR
#undef PG8_SCHED
}
}
#define TR_LO 0
#define TR_HI 16


#define LAS __attribute__((address_space(3)))
typedef unsigned short bf16;
typedef unsigned v4u __attribute__((ext_vector_type(4)));
typedef unsigned v2u __attribute__((ext_vector_type(2)));
typedef float f32x4 __attribute__((ext_vector_type(4)));
typedef short bf16x8 __attribute__((ext_vector_type(8)));
using pg8::cvt_pk_bf16; using pg8::bf_lo; using pg8::bf_hi;

constexpr int DM = 1024, MP = 65536, MS = 1024, MT = MP + MS;
constexpr int TPR = 8192, TSM = 64;
constexpr int APROJ = 1792, NMIX = 3584, FH = 2816, NLORA = 1536, KLORA = 256;
constexpr float LN_EPS = 1e-5f, A_NORM_EPS = 64e-5f;
constexpr float DN_ALPHA = 1.681792830507429f;
constexpr int NWAVES = 8, NTHREADS = 512;
constexpr int LDS_BYTES = 132096;

constexpr size_t SZ_X = (size_t)MT * 1024 * 2;
constexpr size_t W_IN = 0, W_IN_SZ = (size_t)NMIX * 1024 * 2;
constexpr size_t W_LO = W_IN + 2 * W_IN_SZ, W_LO_SZ = (size_t)NLORA * KLORA * 2;
constexpr size_t W_OM = W_LO + 2 * W_LO_SZ, W_SQ_SZ = (size_t)1024 * 1024 * 2;
constexpr size_t W_QKV = W_OM + 2 * W_SQ_SZ, W_QKV_SZ = (size_t)3072 * 1024 * 2;
constexpr size_t W_O = W_QKV + 2 * W_QKV_SZ;
constexpr size_t W_FI = W_O + 2 * W_SQ_SZ, W_FI_SZ = (size_t)2 * FH * 1024 * 2;
constexpr size_t W_FO = W_FI + 4 * W_FI_SZ, W_FO_SZ = (size_t)1024 * FH * 2;
constexpr size_t OFF_XB = W_FO + 4 * W_FO_SZ;
constexpr size_t OFF_R1 = OFF_XB + SZ_X;
constexpr size_t OFF_G = OFF_R1 + SZ_X;
constexpr size_t OFF_Z = OFF_G + SZ_X / 2;
constexpr size_t OFF_BIG = OFF_Z + SZ_X;
constexpr size_t WS_END = OFF_BIG + (size_t)MT * NMIX * 2;
constexpr size_t WS_BAR = WS_END, WS_BAR_BYTES = 16384;
static_assert(OFF_XB % 256 == 0 && WS_BAR % 256 == 0 && WS_BAR + WS_BAR_BYTES <= (size_t)1073741824, "ws map");

constexpr size_t O_YP = 0, O_YS = 67108864, O_PWKV = 68157440, O_PSHIFT = 68681728, O_PGLA = 68710400, O_PK = 69234688, O_PV = 77623296,
                 O_SWKV = 86011904, O_SSHIFT = 87060480, O_SGLA = 87117824, O_SK = 88166400, O_SV = 90263552;

__device__ __forceinline__ int tid_opaque() { int t = threadIdx.x; asm volatile("" : "+v"(t)); return t; }
struct Args { const float* in[32]; float* out; unsigned char* ws; int ph_lo, ph_hi; };

__device__ __forceinline__ float wave_sum(float v) {
#pragma unroll
    for (int o = 1; o < 64; o <<= 1) v += __shfl_xor(v, o);
    return v;
}
__device__ __forceinline__ void unpack8(const v4u w, float* f) {
    f[0] = bf_lo(w.x); f[1] = bf_hi(w.x); f[2] = bf_lo(w.y); f[3] = bf_hi(w.y); f[4] = bf_lo(w.z); f[5] = bf_hi(w.z); f[6] = bf_lo(w.w); f[7] = bf_hi(w.w);
}
__device__ __forceinline__ v4u pack8(const float* f) {
    v4u w; w.x = cvt_pk_bf16(f[0], f[1]); w.y = cvt_pk_bf16(f[2], f[3]); w.z = cvt_pk_bf16(f[4], f[5]); w.w = cvt_pk_bf16(f[6], f[7]); return w;
}
__device__ __forceinline__ void load8f(const float* p, float* f) {
    const f32x4 a = *(const f32x4*)p, b = *(const f32x4*)(p + 4);
    f[0] = a.x; f[1] = a.y; f[2] = a.z; f[3] = a.w; f[4] = b.x; f[5] = b.y; f[6] = b.z; f[7] = b.w;
}
__device__ __forceinline__ float softplus_f(float x) { return fmaxf(x, 0.f) + __logf(1.0f + __expf(-fabsf(x))); }
__device__ __forceinline__ float sigmoid_f(float x) { return __builtin_amdgcn_rcpf(1.0f + __expf(-x)); }
#define LDS_WAIT() asm volatile("s_waitcnt lgkmcnt(0)" ::: "memory")

__device__ __forceinline__ int xcd_vcu() { const int G = gridDim.x, bx = blockIdx.x; return (G % 8 == 0) ? (bx % 8) * (G / 8) + bx / 8 : bx; }
__device__ __forceinline__ int src_col(int mode, int n) {
    if (mode == 0) return n;
    if (mode == 1) {
        if (n < 1792) return n;
        if (n < 2816) { const int h = (n - 1792) >> 8, r = (n - 1792) & 255;
            if (r < 64) return 1792 + h * 64 + r; if (r < 128) return 1792 + 256 + h * 64 + (r - 64); return 1792 + 512 + h * 128 + (r - 128); }
        if (n < 3328) return 1792 + 1040 + (n - 2816);
        if (n < 3344) return 1792 + 1024 + (n - 3328);
        return -1;
    }
    const int pn = n >> 8, jj = n & 255;
    return jj < 128 ? pn * 128 + jj : FH + pn * 128 + (jj - 128);
}
__device__ __forceinline__ void transpose_item(const float* W, int ldw, int mode, bf16* WT, int K, int N, int it, int lane) {
    const int nblk = N / 64;
    const int kb = it / nblk, nb = it - kb * nblk, k0 = 64 * kb, n = 64 * nb + lane;
    const int sc = src_col(mode, n); const float msk = sc >= 0 ? 1.f : 0.f; const int scc = sc >= 0 ? sc : 0;
    const float* wp = W + (size_t)k0 * ldw + scc; bf16* op = WT + (size_t)n * K + k0;
#pragma unroll 4
    for (int k8 = 0; k8 < 8; ++k8) {
        float f[8];
#pragma unroll
        for (int i = 0; i < 8; ++i) f[i] = wp[(size_t)(8 * k8 + i) * ldw] * msk;
        *(v4u*)(op + 8 * k8) = pack8(f);
    }
}
__device__ __forceinline__ void prologue_phase(const Args& a, LAS unsigned char* lds) {
    const int tid = tid_opaque(), lane = tid & 63, wave = tid >> 6;
    const int gw = blockIdx.x * NWAVES + wave, ngw = gridDim.x * NWAVES;
    LAS float* scr = (LAS float*)(lds + wave * 8704);
    unsigned char* ws = a.ws;
    for (int itg = gw; itg < 12800; itg += ngw) {
        int j, base;
        if (itg < 1792) { j = itg / 896; base = j * 896; }
        else if (itg < 2304) { j = 2 + (itg - 1792) / 256; base = 1792 + (j - 2) * 256; }
        else if (itg < 3840) { j = 4 + (itg - 2304) / 768; base = 2304 + (j - 4) * 768; }
        else if (itg < 4352) { j = 6 + (itg - 3840) / 256; base = 3840 + (j - 6) * 256; }
        else if (itg < 9984) { j = 8 + (itg - 4352) / 1408; base = 4352 + (j - 8) * 1408; }
        else { j = 12 + (itg - 9984) / 704; base = 9984 + (j - 12) * 704; }
        const float* W; int ldw, mode, K, N; bf16* WT;
        if (j < 2)       { W = a.in[7] + (size_t)j * 1024 * 3344; ldw = 3344; mode = 1; K = 1024; N = NMIX; WT = (bf16*)(ws + W_IN + j * W_IN_SZ); }
        else if (j < 4)  { const int e = j - 2;  W = a.in[22] + (size_t)e * 1024 * 1024; ldw = 1024; mode = 0; K = 1024; N = 1024; WT = (bf16*)(ws + W_OM + e * W_SQ_SZ); }
        else if (j < 6)  { const int e = j - 4;  W = a.in[23] + (size_t)e * 1024 * 3072; ldw = 3072; mode = 0; K = 1024; N = 3072; WT = (bf16*)(ws + W_QKV + e * W_QKV_SZ); }
        else if (j < 8)  { const int e = j - 6;  W = a.in[25] + (size_t)e * 1024 * 1024; ldw = 1024; mode = 0; K = 1024; N = 1024; WT = (bf16*)(ws + W_O + e * W_SQ_SZ); }
        else if (j < 12) { const int l = j - 8;  W = a.in[30] + (size_t)l * 1024 * 2 * FH; ldw = 2 * FH; mode = 2; K = 1024; N = 2 * FH; WT = (bf16*)(ws + W_FI + l * W_FI_SZ); }
        else             { const int l = j - 12; W = a.in[31] + (size_t)l * FH * 1024; ldw = 1024; mode = 0; K = FH; N = 1024; WT = (bf16*)(ws + W_FO + l * W_FO_SZ); }
        transpose_item(W, ldw, mode, WT, K, N, itg - base, lane);
    }
    const int gt = blockIdx.x * NTHREADS + tid, ngt = gridDim.x * NTHREADS;
#ifndef SKIP_LORA
    for (int idx = gt; idx < 2 * NLORA * 32; idx += ngt) {
        const int e = idx / (NLORA * 32), r = idx - e * (NLORA * 32), n = r >> 5, k0 = (r & 31) * 8;
        float f[8];
#pragma unroll
        for (int i = 0; i < 8; ++i) { const int k = k0 + i; float v = 0.f;
            if (n < 512) { if (k < 64) v = a.in[10][((size_t)e * 64 + k) * 512 + n]; }
            else if (n < 1024) { if (k >= 64 && k < 128) v = a.in[12][((size_t)e * 64 + (k - 64)) * 512 + (n - 512)]; }
            else { if (k >= 128) v = a.in[13][((size_t)e * 128 + (k - 128)) * 512 + (n - 1024)]; }
            f[i] = v; }
        *(v4u*)((bf16*)(ws + W_LO + e * W_LO_SZ) + (size_t)n * KLORA + k0) = pack8(f);
    }
#endif
    bf16* XB = (bf16*)(ws + OFF_XB);
    for (size_t idx = gt; idx < (size_t)MT * 128; idx += ngt) {
        const size_t e0 = idx * 8; const float* src = e0 < (size_t)MP * 1024 ? a.in[0] + e0 : a.in[1] + (e0 - (size_t)MP * 1024);
        float f[8]; load8f(src, f); *(v4u*)(XB + e0) = pack8(f);
    }
}

__device__ __forceinline__ void prep1_phase(const Args& a, int e) {
    const int tid = tid_opaque(), lane = tid & 63, wave = tid >> 6;
    const int gw = blockIdx.x * NWAVES + wave, ngw = gridDim.x * NWAVES;
    const bf16* PA = (const bf16*)(a.ws + OFF_BIG); bf16* L = (bf16*)(a.ws + OFF_Z);
    const float* mu = a.in[8] + (size_t)e * APROJ; const float* shift0 = a.in[3] + (size_t)e * 16 * APROJ;
    const int c = 1536 + 4 * lane;
    const f32x4 mu4 = *(const f32x4*)(mu + c);
    for (int m = gw; m < MT; m += ngw) {
        const v2u pw = *(const v2u*)(PA + (size_t)m * APROJ + c);
        float p[4] = {bf_lo(pw.x), bf_hi(pw.x), bf_lo(pw.y), bf_hi(pw.y)}, q[4];
        const int t = m < MP ? (m & (TPR - 1)) : ((m - MP) & (TSM - 1));
        if (t > 0) { const v2u qw = *(const v2u*)(PA + (size_t)(m - 1) * APROJ + c); q[0] = bf_lo(qw.x); q[1] = bf_hi(qw.x); q[2] = bf_lo(qw.y); q[3] = bf_hi(qw.y); }
        else if (m < MP) { q[0] = q[1] = q[2] = q[3] = 0.f; }
        else { const f32x4 s = *(const f32x4*)(shift0 + (size_t)((m - MP) >> 6) * APROJ + c); q[0] = s.x; q[1] = s.y; q[2] = s.z; q[3] = s.w; }
        float r[4];
#pragma unroll
        for (int i = 0; i < 4; ++i) { const float xs = p[i] + (q[i] - p[i]) * mu4[i]; r[i] = lane < 16 ? tanhf(xs) : (lane < 32 ? xs : sigmoid_f(xs)); }
        v2u o; o.x = cvt_pk_bf16(r[0], r[1]); o.y = cvt_pk_bf16(r[2], r[3]);
        *(v2u*)(L + (size_t)m * KLORA + 4 * lane) = o;
    }
}
__device__ __forceinline__ void prep2_phase(const Args& a, int e) {
    const int tid = tid_opaque(), lane = tid & 63, wave = tid >> 6;
    const int gw = blockIdx.x * NWAVES + wave, ngw = gridDim.x * NWAVES;
    const bf16* PA = (const bf16*)(a.ws + OFF_BIG); bf16* PB = (bf16*)(a.ws + OFF_BIG) + (size_t)MT * APROJ;
    const bf16* Lw = (const bf16*)(a.ws + OFF_R1); const bf16* La = Lw + (size_t)MT * 512;
    bf16* SA = (bf16*)a.out; bf16* SB = (bf16*)(a.ws + OFF_Z);
    const float* mu = a.in[8] + (size_t)e * APROJ; const float* shift0 = a.in[3] + (size_t)e * 16 * APROJ;
    const int c8 = 8 * lane, h = lane >> 3;
    float mur[8], muk[8], muv[8], w0[8], a0[8], kkw[8], kaw[8];
    load8f(mu + c8, mur); load8f(mu + 512 + c8, muk); load8f(mu + 1024 + c8, muv);
    load8f(a.in[9] + (size_t)e * 512 + c8, w0); load8f(a.in[11] + (size_t)e * 512 + c8, a0);
    load8f(a.in[14] + (size_t)e * 512 + c8, kkw); load8f(a.in[15] + (size_t)e * 512 + c8, kaw);
    const float* aup = a.in[19] + (size_t)e * 16 * 256; const f32x4 ab = *(const f32x4*)(a.in[20] + (size_t)e * 256 + 4 * lane);
    for (int m = gw; m < MT; m += ngw) {
        const bf16* pr = PA + (size_t)m * APROJ;
        float r[8], k[8], v[8], pq[8];
        unpack8(*(const v4u*)(pr + c8), r); unpack8(*(const v4u*)(pr + 512 + c8), k); unpack8(*(const v4u*)(pr + 1024 + c8), v);
        const int t = m < MP ? (m & (TPR - 1)) : ((m - MP) & (TSM - 1));
        if (t > 0) {
            unpack8(*(const v4u*)(pr - APROJ + c8), pq);
#pragma unroll
            for (int i = 0; i < 8; ++i) r[i] += (pq[i] - r[i]) * mur[i];
            unpack8(*(const v4u*)(pr - APROJ + 512 + c8), pq);
#pragma unroll
            for (int i = 0; i < 8; ++i) k[i] += (pq[i] - k[i]) * muk[i];
            unpack8(*(const v4u*)(pr - APROJ + 1024 + c8), pq);
#pragma unroll
            for (int i = 0; i < 8; ++i) v[i] += (pq[i] - v[i]) * muv[i];
        } else if (m < MP) {
#pragma unroll
            for (int i = 0; i < 8; ++i) { r[i] -= r[i] * mur[i]; k[i] -= k[i] * muk[i]; v[i] -= v[i] * muv[i]; }
        } else {
            const float* s0 = shift0 + (size_t)((m - MP) >> 6) * APROJ;
            load8f(s0 + c8, pq);
#pragma unroll
            for (int i = 0; i < 8; ++i) r[i] += (pq[i] - r[i]) * mur[i];
            load8f(s0 + 512 + c8, pq);
#pragma unroll
            for (int i = 0; i < 8; ++i) k[i] += (pq[i] - k[i]) * muk[i];
            load8f(s0 + 1024 + c8, pq);
#pragma unroll
            for (int i = 0; i < 8; ++i) v[i] += (pq[i] - v[i]) * muv[i];
        }
        float lw[8], la[8], u[8], av[8], kk[8], km[8], ka[8];
        unpack8(*(const v4u*)(Lw + (size_t)m * 512 + c8), lw); unpack8(*(const v4u*)(La + (size_t)m * 512 + c8), la);
        float ss = 0.f;
#pragma unroll
        for (int i = 0; i < 8; ++i) {
            const float w = -softplus_f(-(w0[i] + lw[i])) - 0.5f;
            u[i] = 1.0f - __expf(-__expf(w));
            av[i] = sigmoid_f(a0[i] + la[i]);
            kk[i] = k[i] * kkw[i]; ss += kk[i] * kk[i];
            km[i] = k[i] * (1.0f + (av[i] - 1.0f) * kaw[i]);
        }
        ss += __shfl_xor(ss, 1); ss += __shfl_xor(ss, 2); ss += __shfl_xor(ss, 4);
        const float rn = rsqrtf(ss + 1e-12f);
#pragma unroll
        for (int i = 0; i < 8; ++i) { kk[i] *= rn; ka[i] = kk[i] * av[i]; }
        bf16* sa = SA + ((size_t)m * 8 + h) * 256 + (lane & 7) * 8; bf16* sb = SB + ((size_t)m * 8 + h) * 128 + (lane & 7) * 8;
        *(v4u*)(sa) = pack8(r); *(v4u*)(sa + 64) = pack8(u); *(v4u*)(sa + 128) = pack8(km); *(v4u*)(sa + 192) = pack8(v);
        *(v4u*)(sb) = pack8(kk); *(v4u*)(sb + 64) = pack8(ka);
        bf16* pb = PB + (size_t)m * APROJ + 1536;
        float xa[16]; unpack8(*(const v4u*)(pb), xa); unpack8(*(const v4u*)(pb + 8), xa + 8);
        f32x4 acc = ab;
#pragma unroll
        for (int i = 0; i < 16; ++i) { const f32x4 wv = *(const f32x4*)(aup + i * 256 + 4 * lane); acc += xa[i] * wv; }
        float ug[4];
#pragma unroll
        for (int i = 0; i < 4; ++i) ug[i] = 1.0f - __expf(-softplus_f(-acc[i]) * (1.0f / 16.0f));
        v2u o; o.x = cvt_pk_bf16(ug[0], ug[1]); o.y = cvt_pk_bf16(ug[2], ug[3]);
        *(v2u*)(pb + 4 * lane) = o;
    }
}
struct PostRaw { v4u o, r, km, v, g, og, rg; };
__device__ __forceinline__ void post_phase(const Args& a, int e) {
    const int tid = tid_opaque(), lane = tid & 63, wave = tid >> 6;
    const int gw = blockIdx.x * NWAVES + wave, ngw = gridDim.x * NWAVES;
    bf16* Y = (bf16*)(a.ws + OFF_R1); const bf16* G = (const bf16*)(a.ws + OFF_G);
    const bf16* PB = (const bf16*)(a.ws + OFF_BIG) + (size_t)MT * APROJ; const bf16* SA = (const bf16*)a.out;
    const int c8 = 8 * lane, h = lane >> 3;
    float lnw[8], lnb[8], rk[8], nw[8];
    load8f(a.in[17] + (size_t)e * 512 + c8, lnw); load8f(a.in[18] + (size_t)e * 512 + c8, lnb); load8f(a.in[16] + (size_t)e * 512 + c8, rk);
    load8f(a.in[21] + (size_t)e * 128 + (lane & 15) * 8, nw);
    for (int mb = gw; mb < MT; mb += 2 * ngw) {
        PostRaw raw[2];
#pragma unroll
        for (int j = 0; j < 2; ++j) { const int m_ = mb + j * ngw; const size_t m = m_ < MT ? m_ : mb;
            const bf16* sa = SA + (m * 8 + h) * 256 + (lane & 7) * 8;
            raw[j].o = *(const v4u*)(Y + m * 1024 + c8); raw[j].r = *(const v4u*)(sa); raw[j].km = *(const v4u*)(sa + 128); raw[j].v = *(const v4u*)(sa + 192);
            raw[j].g = *(const v4u*)(G + m * 512 + c8); raw[j].og = *(const v4u*)(Y + m * 1024 + 512 + c8); raw[j].rg = *(const v4u*)(PB + m * APROJ + 1024 + c8); }
#pragma unroll
        for (int j = 0; j < 2; ++j) {
            const int m = mb + j * ngw;
            float o[8], r[8], km[8], v[8], g[8];
            unpack8(raw[j].o, o); unpack8(raw[j].r, r); unpack8(raw[j].km, km); unpack8(raw[j].v, v); unpack8(raw[j].g, g);
            float s = 0.f, bn = 0.f;
#pragma unroll
            for (int i = 0; i < 8; ++i) { s += o[i]; bn += r[i] * km[i] * rk[i]; }
            s += __shfl_xor(s, 1); s += __shfl_xor(s, 2); s += __shfl_xor(s, 4);
            bn += __shfl_xor(bn, 1); bn += __shfl_xor(bn, 2); bn += __shfl_xor(bn, 4);
            const float mean = s * (1.0f / 64.0f); float q = 0.f;
#pragma unroll
            for (int i = 0; i < 8; ++i) { o[i] -= mean; q += o[i] * o[i]; }
            q += __shfl_xor(q, 1); q += __shfl_xor(q, 2); q += __shfl_xor(q, 4);
            const float rstd = rsqrtf(q * (1.0f / 64.0f) + A_NORM_EPS);
#pragma unroll
            for (int i = 0; i < 8; ++i) o[i] = (o[i] * rstd * lnw[i] + lnb[i] + bn * v[i]) * g[i];
            float og[8], rg[8];
            unpack8(raw[j].og, og); unpack8(raw[j].rg, rg);
            float ms = 0.f;
#pragma unroll
            for (int i = 0; i < 8; ++i) ms += og[i] * og[i];
            ms += __shfl_xor(ms, 1); ms += __shfl_xor(ms, 2); ms += __shfl_xor(ms, 4); ms += __shfl_xor(ms, 8);
            const float rr = rsqrtf(ms * (1.0f / 128.0f) + LN_EPS);
#pragma unroll
            for (int i = 0; i < 8; ++i) og[i] = og[i] * rr * nw[i] * (rg[i] * sigmoid_f(rg[i]));
            if (m < MT) { *(v4u*)(Y + (size_t)m * 1024 + c8) = pack8(o); *(v4u*)(Y + (size_t)m * 1024 + 512 + c8) = pack8(og); }
        }
    }
}
__device__ __forceinline__ void ln_row_out(float* x0, float* x1, const float* w0, const float* w1, const float* b0, const float* b1, bf16* XB, float* fout, int m, int lane) {
    float s = 0.f;
#pragma unroll
    for (int i = 0; i < 8; ++i) s += x0[i] + x1[i];
    const float mean = wave_sum(s) * (1.0f / 1024.0f); float q = 0.f;
#pragma unroll
    for (int i = 0; i < 8; ++i) { x0[i] -= mean; x1[i] -= mean; q += x0[i] * x0[i] + x1[i] * x1[i]; }
    const float rstd = rsqrtf(wave_sum(q) * (1.0f / 1024.0f) + LN_EPS);
#pragma unroll
    for (int i = 0; i < 8; ++i) { x0[i] = x0[i] * rstd * w0[i] + b0[i]; x1[i] = x1[i] * rstd * w1[i] + b1[i]; }
    if (fout) {
        float* fo = fout + (size_t)m * 1024 + 8 * lane;
        *(f32x4*)(fo) = (f32x4){x0[0], x0[1], x0[2], x0[3]}; *(f32x4*)(fo + 4) = (f32x4){x0[4], x0[5], x0[6], x0[7]};
        *(f32x4*)(fo + 512) = (f32x4){x1[0], x1[1], x1[2], x1[3]}; *(f32x4*)(fo + 516) = (f32x4){x1[4], x1[5], x1[6], x1[7]};
    } else {
        *(v4u*)(XB + (size_t)m * 1024 + 8 * lane) = pack8(x0); *(v4u*)(XB + (size_t)m * 1024 + 512 + 8 * lane) = pack8(x1);
    }
}
__device__ __forceinline__ void ln_phase(const Args& a, const float* w, const float* b, float* fout, int ns) {
    const int tid = tid_opaque(), lane = tid & 63, wave = tid >> 6;
    const int gw = blockIdx.x * NWAVES + wave, ngw = gridDim.x * NWAVES;
    const bf16* Z = (const bf16*)(a.ws + OFF_Z); bf16* XB = (bf16*)(a.ws + OFF_XB);
    float w0[8], w1[8], b0[8], b1[8];
    load8f(w + 8 * lane, w0); load8f(w + 512 + 8 * lane, w1); load8f(b + 8 * lane, b0); load8f(b + 512 + 8 * lane, b1);
    for (int mb = gw; mb < MP; mb += 4 * ngw) {
        v4u r0[4], r1[4];
#pragma unroll
        for (int j = 0; j < 4; ++j) { const int m = mb + j * ngw; const int mc = m < MP ? m : mb;
            r0[j] = *(const v4u*)(Z + (size_t)mc * 1024 + 8 * lane); r1[j] = *(const v4u*)(Z + (size_t)mc * 1024 + 512 + 8 * lane); }
#pragma unroll
        for (int j = 0; j < 4; ++j) {
            const int m = mb + j * ngw;
            float x0[8], x1[8];
            unpack8(r0[j], x0); unpack8(r1[j], x1);
            if (m < MP) ln_row_out(x0, x1, w0, w1, b0, b1, XB, fout, m, lane);
        }
    }
#pragma unroll 1
    for (int m = MP + gw; m < MT; m += ngw) {
        float x0[8], x1[8];
        unpack8(*(const v4u*)(XB + (size_t)m * 1024 + 8 * lane), x0); unpack8(*(const v4u*)(XB + (size_t)m * 1024 + 512 + 8 * lane), x1);
#pragma unroll
        for (int i = 0; i < 8; ++i) { x0[i] *= DN_ALPHA; x1[i] *= DN_ALPHA; }
        const float* zs = (const float*)(a.ws + OFF_G) + (size_t)(m - MP) * 1024 + 8 * lane;
#pragma unroll 1
        for (int sl = 0; sl < ns; ++sl) { float t0[8], t1[8]; load8f(zs + (size_t)sl * 1024 * 1024, t0); load8f(zs + (size_t)sl * 1024 * 1024 + 512, t1);
#pragma unroll
            for (int i = 0; i < 8; ++i) { x0[i] += t0[i]; x1[i] += t1[i]; } }
        ln_row_out(x0, x1, w0, w1, b0, b1, XB, fout, m, lane);
    }
}

#define TR_DPP(x, ctrl) __builtin_bit_cast(float, __builtin_amdgcn_update_dpp(0, __builtin_bit_cast(int, x), ctrl, 0xf, 0xf, false))
__device__ __forceinline__ float transpose_reduce16(const float* p, int g) {
    const bool h1 = (g & 8) != 0, h2 = (g & 4) != 0, h3 = (g & 2) != 0, h4 = (g & 1) != 0;
    float q[8], r[4], t[2];
#pragma unroll
    for (int i = 0; i < 8; ++i) { const float keep = h1 ? p[i + 8] : p[i], send = h1 ? p[i] : p[i + 8]; q[i] = keep + TR_DPP(send, 0x140); }
#pragma unroll
    for (int i = 0; i < 4; ++i) { const float keep = h2 ? q[i + 4] : q[i], send = h2 ? q[i] : q[i + 4]; r[i] = keep + TR_DPP(send, 0x141); }
#pragma unroll
    for (int i = 0; i < 2; ++i) { const float keep = h3 ? r[i + 2] : r[i], send = h3 ? r[i] : r[i + 2]; t[i] = keep + TR_DPP(send, 0x4E); }
    const float keep = h4 ? t[1] : t[0], send = h4 ? t[0] : t[1];
    return keep + TR_DPP(send, 0xB1);
}
constexpr int TC = 16;
constexpr int SCW = 384, SCG = 320;
__device__ __forceinline__ void st8n(LAS float* d, const v4u w) {
    *(LAS f32x4*)(d) = (f32x4){bf_lo(w.x), bf_hi(w.x), bf_lo(w.y), bf_hi(w.y)};
    *(LAS f32x4*)(d + 4) = (f32x4){bf_lo(w.z), bf_hi(w.z), bf_lo(w.w), bf_hi(w.w)};
}
__device__ __forceinline__ void st8(LAS float* d, const v4u w, float sc) {
    *(LAS f32x4*)(d) = (f32x4){bf_lo(w.x) * sc, bf_hi(w.x) * sc, bf_lo(w.y) * sc, bf_hi(w.y) * sc};
    *(LAS f32x4*)(d + 4) = (f32x4){bf_lo(w.z) * sc, bf_hi(w.z) * sc, bf_lo(w.w) * sc, bf_hi(w.w) * sc};
}
typedef float f32x2 __attribute__((ext_vector_type(2)));
#define LO2(v4) (__builtin_shufflevector(v4, v4, 0, 1))
#define HI2(v4) (__builtin_shufflevector(v4, v4, 2, 3))
__device__ __forceinline__ f32x2 fma2(f32x2 a, f32x2 b, f32x2 c) { return __builtin_elementwise_fma(a, b, c); }
__device__ __forceinline__ float rowsum16(float x) {
    x += __builtin_bit_cast(float, __builtin_amdgcn_update_dpp(0, __builtin_bit_cast(int, x), 0x128, 0xf, 0xf, false));
    x += __builtin_bit_cast(float, __builtin_amdgcn_update_dpp(0, __builtin_bit_cast(int, x), 0x124, 0xf, 0xf, false));
    x += __builtin_bit_cast(float, __builtin_amdgcn_update_dpp(0, __builtin_bit_cast(int, x), 0x122, 0xf, 0xf, false));
    x += __builtin_bit_cast(float, __builtin_amdgcn_update_dpp(0, __builtin_bit_cast(int, x), 0x121, 0xf, 0xf, false));
    return x;
}
struct WkvIn { f32x4 r, u, km, kk, ka; float v; };
struct GlaIn { f32x4 q, k, u; float v; };
__device__ __forceinline__ void scan_phase(const Args& a, int e, LAS unsigned char* lds) {
    const int tid = tid_opaque(), lane = tid & 63, wave = tid >> 6;
    const bool isW = wave < 4; const int ltid = tid & 255, lw = wave & 3;
    const int g = lane & 15, rl = lw * 4 + (lane >> 4);
    const bf16* SA = (const bf16*)a.out; const bf16* SB = (const bf16*)(a.ws + OFF_Z);
    const bf16* PB = (const bf16*)(a.ws + OFF_BIG) + (size_t)MT * APROJ;
    bf16* O1 = (bf16*)(a.ws + OFF_R1);
    LAS float* bufW = (LAS float*)lds;
    LAS float* bufG = (LAS float*)(lds + 2 * TC * SCW * 4);
    int ps[3], pp[3];
#pragma unroll
    for (int j = 0; j < 3; ++j) { const int p = ltid + 256 * j; if (isW) { ps[j] = p / 48; pp[j] = p - ps[j] * 48; } else { ps[j] = p / 40; pp[j] = p - ps[j] * 40; } }
    const bool v2ok = isW || (ltid + 512 < 640);
#pragma unroll 1
    for (int it = xcd_vcu(); it < 768; it += gridDim.x) {
        const bool samp = it >= 256; const int wi = samp ? it - 256 : it;
        const int b = wi >> 5; const int T = samp ? TSM : TPR; const size_t row0 = samp ? (size_t)MP + b * TSM : (size_t)b * TPR;
        const int nb = samp ? 16 : 8;
        int h, sub;
        if (isW) { h = (wi >> 2) & 7; sub = wi & 3; } else { h = (wi >> 3) & 3; sub = wi & 7; }
        const int vrow = sub * 16 + rl;
        f32x2 P0 = {0.f, 0.f}, P1 = {0.f, 0.f};
        if (samp) {
            if (isW) { const f32x4 S = *(const f32x4*)(a.in[2] + ((((size_t)e * 16 + b) * 8 + h) * 64 + vrow) * 64 + 4 * g); P0 = LO2(S); P1 = HI2(S); }
            else { const float* s0 = a.in[4] + (((size_t)e * 16 + b) * 4 + h) * 8192 + vrow;
                P0 = (f32x2){s0[(4 * g + 0) * 128], s0[(4 * g + 1) * 128]}; P1 = (f32x2){s0[(4 * g + 2) * 128], s0[(4 * g + 3) * 128]}; }
        }
        const int nc = T / TC;
        bf16* obase = isW ? O1 + (row0 + g) * 1024 + h * 64 + vrow : O1 + (row0 + g) * 1024 + 512 + h * 128 + vrow;
        v4u pre[3];
        unsigned so[3];
#pragma unroll
        for (int j = 0; j < 3; ++j) { const unsigned row = (unsigned)row0 + ps[j];
            if (isW) so[j] = pp[j] < 32 ? (row * 8 + h) * 256 + pp[j] * 8 : (row * 8 + h) * 128 + (pp[j] - 32) * 8;
            else so[j] = pp[j] < 32 ? row * APROJ + h * 256 + pp[j] * 8 : row * APROJ + 1536 + h * 64 + (pp[j] - 32) * 8; }
#define SCAN_ISSUE(t0) do { _Pragma("unroll") for (int j = 0; j < 3; ++j) { const bf16* src = (isW ? (pp[j] < 32 ? SA : SB) : PB) + so[j]; \
            if (j < 2 || v2ok) pre[j] = *(const v4u*)src; so[j] += isW ? (pp[j] < 32 ? TC * 2048 : TC * 1024) : TC * APROJ; } } while (0)
#define SCAN_COMMIT(bi) do { _Pragma("unroll") for (int j = 0; j < 3; ++j) { if (j < 2 || v2ok) { \
            if (isW) st8n(bufW + ((bi) * TC + ps[j]) * SCW + pp[j] * 8, pre[j]); else st8n(bufG + ((bi) * TC + ps[j]) * SCG + pp[j] * 8, pre[j]); } } } while (0)
        __syncthreads();
        SCAN_ISSUE(0); SCAN_COMMIT(0);
        __syncthreads();
#pragma unroll 1
        for (int c = 0; c < nc; ++c) {
            const int bi = c & 1;
            if (c + 1 < nc) SCAN_ISSUE((c + 1) * TC);
            float oacc = 0.f; float op[16];
            if (isW) {
                const LAS float* bw = bufW + bi * TC * SCW + 4 * g; const LAS float* bv = bufW + bi * TC * SCW + 192 + vrow;
#define WKV_LOAD(d, s) do { const LAS float* p_ = bw + (s) * SCW; d.r = *(const LAS f32x4*)(p_); d.u = *(const LAS f32x4*)(p_ + 64); d.km = *(const LAS f32x4*)(p_ + 128); \
                    d.kk = *(const LAS f32x4*)(p_ + 256); d.ka = *(const LAS f32x4*)(p_ + 320); d.v = bv[(s) * SCW]; } while (0)
                WkvIn in[3];
                WKV_LOAD(in[0], 0); WKV_LOAD(in[1], 1);
#pragma unroll
                for (int s = 0; s < TC; ++s) {
                    if (s + 2 < TC) WKV_LOAD(in[(s + 2) % 3], s + 2);
                    __builtin_amdgcn_sched_barrier(0);
                    const WkvIn& x = in[s % 3];
                    const f32x2 vv = {x.v, x.v};
                    const f32x2 s2 = fma2(P1, HI2(x.kk), P0 * LO2(x.kk));
                    const f32x2 T0 = fma2(vv, LO2(x.km), fma2(-LO2(x.u), P0, P0)), T1 = fma2(vv, HI2(x.km), fma2(-HI2(x.u), P1, P1));
                    const float sa = rowsum16(s2.x + s2.y);
                    const f32x2 ns = {-sa, -sa};
                    P0 = fma2(ns, LO2(x.ka), T0); P1 = fma2(ns, HI2(x.ka), T1);
                    const f32x2 o2 = fma2(P1, HI2(x.r), P0 * LO2(x.r));
                    op[s] = o2.x + o2.y;
                }
                oacc = transpose_reduce16(op, g);
#undef WKV_LOAD
            } else {
                const LAS float* bg = bufG + bi * TC * SCG + 4 * g; const LAS float* bv = bufG + bi * TC * SCG + 128 + vrow;
#define GLA_LOAD(d, s) do { const LAS float* p_ = bg + (s) * SCG; d.q = *(const LAS f32x4*)(p_); d.k = *(const LAS f32x4*)(p_ + 64); d.u = *(const LAS f32x4*)(p_ + 256); d.v = bv[(s) * SCG]; } while (0)
                GlaIn in[3];
                GLA_LOAD(in[0], 0); GLA_LOAD(in[1], 1);
#pragma unroll
                for (int s = 0; s < TC; ++s) {
                    if (s + 2 < TC) GLA_LOAD(in[(s + 2) % 3], s + 2);
                    __builtin_amdgcn_sched_barrier(0);
                    const GlaIn& x = in[s % 3];
                    const f32x2 vv = {x.v, x.v};
                    P0 = fma2(vv, LO2(x.k), fma2(-LO2(x.u), P0, P0)); P1 = fma2(vv, HI2(x.k), fma2(-HI2(x.u), P1, P1));
                    const f32x2 o2 = fma2(P1, HI2(x.q), P0 * LO2(x.q));
                    op[s] = o2.x + o2.y;
                }
                oacc = transpose_reduce16(op, g);
#undef GLA_LOAD
            }
            obase[(size_t)c * TC * 1024] = (bf16)(cvt_pk_bf16(isW ? oacc : oacc * 0.125f, 0.f) & 0xffffu);
            if (c + 1 < nc) SCAN_COMMIT(bi ^ 1);
            __syncthreads();
        }
#undef SCAN_ISSUE
#undef SCAN_COMMIT
        if (isW) { float* so = a.out + (samp ? O_SWKV : O_PWKV) + ((((size_t)e * nb + b) * 8 + h) * 64 + vrow) * 64 + 4 * g; *(f32x4*)so = (f32x4){P0.x, P0.y, P1.x, P1.y}; }
        else { float* so = a.out + (samp ? O_SGLA : O_PGLA) + (((size_t)e * nb + b) * 4 + h) * 8192 + vrow;
            so[(4 * g + 0) * 128] = P0.x; so[(4 * g + 1) * 128] = P0.y; so[(4 * g + 2) * 128] = P1.x; so[(4 * g + 3) * 128] = P1.y; }
    }
    const bf16* PA = (const bf16*)(a.ws + OFF_BIG);
    for (int idx = blockIdx.x * NTHREADS + tid; idx < 24 * APROJ; idx += gridDim.x * NTHREADS) {
        const int bb = idx / APROJ, c = idx - bb * APROJ;
        if (bb < 8) a.out[O_PSHIFT + ((size_t)e * 8 + bb) * APROJ + c] = bf_lo((unsigned)PA[((size_t)bb * TPR + TPR - 1) * APROJ + c]);
        else a.out[O_SSHIFT + ((size_t)e * 16 + (bb - 8)) * APROJ + c] = bf_lo((unsigned)PA[((size_t)MP + (bb - 8) * TSM + TSM - 1) * APROJ + c]);
    }
}

constexpr int KEXT = 8192, LDV = MT + KEXT;
constexpr size_t BIG_K = (size_t)MT * 1024, BIG_VT = (size_t)(2 * MT + KEXT) * 1024;
__device__ __forceinline__ bf16x8 ld_frag(const bf16* p) { return __builtin_bit_cast(bf16x8, *(const v4u*)p); }
__device__ __forceinline__ void cache_convert(const Args& a, int o) {
    const int tid = tid_opaque();
    const int gt = blockIdx.x * NTHREADS + tid, ngt = gridDim.x * NTHREADS;
    bf16* Kb = (bf16*)(a.ws + OFF_BIG) + BIG_K; bf16* Vt = (bf16*)(a.ws + OFF_BIG) + BIG_VT;
    const float* ck = a.in[5] + (size_t)o * 16 * 16 * 512 * 64; const float* cv = a.in[6] + (size_t)o * 16 * 16 * 512 * 64;
    for (int idx = gt; idx < 16 * 16 * 512 * 8; idx += ngt) {
        const int d8 = idx & 7, key = (idx >> 3) & 511, h = (idx >> 12) & 15, b = idx >> 16;
        float f[8]; load8f(ck + (size_t)idx * 8, f);
        *(v4u*)(Kb + ((size_t)MT + b * 512 + key) * 1024 + h * 64 + d8 * 8) = pack8(f);
    }
    for (int idx = gt; idx < 16 * 16 * 64 * 64; idx += ngt) {
        const int d = idx & 63, k8 = (idx >> 6) & 63, h = (idx >> 12) & 15, b = idx >> 16;
        const float* src = cv + (((size_t)b * 16 + h) * 512 + k8 * 8) * 64 + d; float f[8];
#pragma unroll
        for (int j = 0; j < 8; ++j) f[j] = src[j * 64];
        *(v4u*)(Vt + (size_t)(h * 64 + d) * LDV + MT + b * 512 + k8 * 8) = pack8(f);
    }
}
__device__ __forceinline__ void attn_phase(const Args& a, int o, LAS unsigned char* lds) {
    const int tid = tid_opaque(), lane = tid & 63, wave = tid >> 6;
    const int gw = blockIdx.x * NWAVES + wave, ngw = gridDim.x * NWAVES;
    const bf16* Q = (const bf16*)(a.ws + OFF_BIG); const bf16* Kb = Q + BIG_K; const bf16* Vt = Q + BIG_VT;
    bf16* O = (bf16*)(a.ws + OFF_R1);
    LAS float* bias = (LAS float*)lds;
    constexpr int KVP = 72;
    LAS bf16* KT = (LAS bf16*)(lds + 16512);
    LAS bf16* VT = KT + 2 * 64 * KVP;
    for (int i = tid; i < 16 * 257; i += NTHREADS) bias[i] = a.in[24][(size_t)o * 16 * 257 + i] * 1.4426950408889634f;
    __syncthreads();
    const int i16 = lane & 15, g = lane >> 4;
    const int keyoff = 8 * (i16 >> 2) + (i16 & 3);
    {
        const int wu = __builtin_amdgcn_readfirstlane(wave);
        const int srow = tid >> 3, sseg = (tid & 7) * 8;
#pragma unroll 1
        for (int unit = xcd_vcu(); unit < 4096; unit += gridDim.x) {
            const int b = unit >> 9, h = (unit >> 5) & 15, c0 = (unit & 31) * 4;
            const int c = c0 + (wu >> 1), half = wu & 1;
            const size_t qrow0 = (size_t)b * TPR + c * 64 + half * 32;
            const int qpos0 = c * 64 + half * 32;
            const int kc_lo = c0 >= 8 ? c0 - 8 : 0, kc_hi = c0 + 3, my_lo = c >= 8 ? c - 8 : 0;
            const LAS float* bh = bias + h * 257 + 128;
            const float bfar = bh[128];
            bf16x8 qf[2][2];
#pragma unroll
            for (int qt = 0; qt < 2; ++qt)
#pragma unroll
                for (int kk = 0; kk < 2; ++kk) qf[qt][kk] = ld_frag(Q + (qrow0 + 16 * qt + i16) * 1024 + h * 64 + 32 * kk + 8 * g);
            f32x4 ot[4][2];
#pragma unroll
            for (int dt = 0; dt < 4; ++dt) { ot[dt][0] = (f32x4){0.f, 0.f, 0.f, 0.f}; ot[dt][1] = (f32x4){0.f, 0.f, 0.f, 0.f}; }
            float mrun[2] = {-1e30f, -1e30f}, lrun[2] = {0.f, 0.f};
            const bf16* kg_ = Kb + ((size_t)b * TPR + srow) * 1024 + h * 64 + sseg;
            const bf16* vg_ = Vt + (size_t)(h * 64 + srow) * LDV + (size_t)b * TPR + sseg;
            v4u kreg = *(const v4u*)(kg_ + (size_t)(64 * kc_lo) * 1024), vreg = *(const v4u*)(vg_ + 64 * kc_lo);
            *(LAS v4u*)(KT + srow * KVP + sseg) = kreg; *(LAS v4u*)(VT + srow * KVP + sseg) = vreg;
            __syncthreads();
#pragma unroll 1
            for (int kc = kc_lo; kc <= kc_hi; ++kc) {
                const int buf = (kc - kc_lo) & 1;
                if (kc < kc_hi) { kreg = *(const v4u*)(kg_ + (size_t)(64 * (kc + 1)) * 1024); vreg = *(const v4u*)(vg_ + 64 * (kc + 1)); }
                if (kc >= my_lo && kc <= c) {
                    const int kpos0 = 64 * kc;
                    const LAS bf16* kt = KT + buf * 64 * KVP + keyoff * KVP + 8 * g; const LAS bf16* vt = VT + buf * 64 * KVP + i16 * KVP + 8 * g;
                    f32x4 st[4][2];
#pragma unroll
                    for (int t4 = 0; t4 < 4; ++t4) {
                        const LAS bf16* p = kt + (32 * (t4 >> 1) + 4 * (t4 & 1)) * KVP;
                        const bf16x8 k0 = *(const LAS bf16x8*)p, k1 = *(const LAS bf16x8*)(p + 32);
#pragma unroll
                        for (int qt = 0; qt < 2; ++qt) {
                            f32x4 acc = {0.f, 0.f, 0.f, 0.f};
                            acc = __builtin_amdgcn_mfma_f32_16x16x32_bf16(k0, qf[qt][0], acc, 0, 0, 0);
                            acc = __builtin_amdgcn_mfma_f32_16x16x32_bf16(k1, qf[qt][1], acc, 0, 0, 0);
                            st[t4][qt] = acc;
                        }
                    }
                    const bool far = qpos0 - (kpos0 + 63) >= 128;
                    bf16x8 pf[2][2];
#pragma unroll
                    for (int qt = 0; qt < 2; ++qt) {
                        const int qpos = qpos0 + 16 * qt + i16;
                        float mx = -1e30f;
                        float boff = 0.f;
                        if (far) {
#pragma unroll
                            for (int t4 = 0; t4 < 4; ++t4)
#pragma unroll
                                for (int j = 0; j < 4; ++j) mx = fmaxf(mx, st[t4][qt][j]);
                            mx += bfar; boff = bfar;
                        } else {
#pragma unroll
                            for (int t4 = 0; t4 < 4; ++t4)
#pragma unroll
                                for (int j = 0; j < 4; ++j) {
                                    int rel = qpos - (kpos0 + 32 * (t4 >> 1) + 8 * g + 4 * (t4 & 1) + j); rel = rel > 128 ? 128 : (rel < -128 ? -128 : rel);
                                    const float sv = st[t4][qt][j] + bh[rel]; st[t4][qt][j] = sv; mx = fmaxf(mx, sv);
                                }
                        }
                        mx = fmaxf(mx, __shfl_xor(mx, 16)); mx = fmaxf(mx, __shfl_xor(mx, 32));
                        const float mnew = fmaxf(mrun[qt], mx), corr = __builtin_amdgcn_exp2f(mrun[qt] - mnew), msub = mnew - boff; mrun[qt] = mnew;
                        float psum = 0.f;
#pragma unroll
                        for (int sb = 0; sb < 2; ++sb) {
                            float p[8];
#pragma unroll
                            for (int T = 0; T < 2; ++T)
#pragma unroll
                                for (int j = 0; j < 4; ++j) { p[4 * T + j] = __builtin_amdgcn_exp2f(st[2 * sb + T][qt][j] - msub); psum += p[4 * T + j]; }
                            pf[sb][qt] = __builtin_bit_cast(bf16x8, pack8(p));
                        }
                        lrun[qt] = lrun[qt] * corr + psum;
#pragma unroll
                        for (int dt = 0; dt < 4; ++dt) ot[dt][qt] *= corr;
                    }
#pragma unroll
                    for (int sb = 0; sb < 2; ++sb)
#pragma unroll
                        for (int dt = 0; dt < 4; ++dt) {
                            const bf16x8 vf = *(const LAS bf16x8*)(vt + 16 * dt * KVP + 32 * sb);
#pragma unroll
                            for (int qt = 0; qt < 2; ++qt) ot[dt][qt] = __builtin_amdgcn_mfma_f32_16x16x32_bf16(vf, pf[sb][qt], ot[dt][qt], 0, 0, 0);
                        }
                }
                if (kc < kc_hi) { *(LAS v4u*)(KT + (buf ^ 1) * 64 * KVP + srow * KVP + sseg) = kreg; *(LAS v4u*)(VT + (buf ^ 1) * 64 * KVP + srow * KVP + sseg) = vreg; }
                __syncthreads();
            }
#pragma unroll
            for (int qt = 0; qt < 2; ++qt) {
                float l = lrun[qt]; l += __shfl_xor(l, 16); l += __shfl_xor(l, 32);
                const float inv = 1.0f / l;
                bf16* op = O + (qrow0 + 16 * qt + i16) * 1024 + h * 64 + 4 * g;
#pragma unroll
                for (int dt = 0; dt < 4; ++dt) { const f32x4 v = ot[dt][qt] * inv; v2u w; w.x = cvt_pk_bf16(v[0], v[1]); w.y = cvt_pk_bf16(v[2], v[3]); *(v2u*)(op + 16 * dt) = w; }
            }
        }
    }
#pragma unroll 1
    for (int it = 32768 + gw; it < 32768 + 512; it += ngw) {
        const bool samp = it >= 32768;
        int b, c, h, half;
        if (!samp) { b = it >> 12; c = (it >> 5) & 127; h = (it >> 1) & 15; half = it & 1; }
        else { const int r = it - 32768; b = r >> 5; c = 8; h = (r >> 1) & 15; half = r & 1; }
        const size_t qrow0 = samp ? (size_t)MP + b * 64 + half * 32 : (size_t)b * TPR + c * 64 + half * 32;
        const int qpos0 = c * 64 + half * 32;
        const int kstart = c >= 8 ? c * 64 - 512 : 0, nkb = (c * 64 + 64 - kstart) >> 6;
        const size_t kbase = samp ? (size_t)MT + b * 512 : (size_t)b * TPR + kstart;
        const size_t knew = (size_t)MP + b * 64;
        const LAS float* bh = bias + h * 257 + 128;
        const float bfar = bh[128];
        bf16x8 qf[2][2];
#pragma unroll
        for (int qt = 0; qt < 2; ++qt)
#pragma unroll
            for (int kk = 0; kk < 2; ++kk) qf[qt][kk] = ld_frag(Q + (qrow0 + 16 * qt + i16) * 1024 + h * 64 + 32 * kk + 8 * g);
        f32x4 ot[4][2];
#pragma unroll
        for (int dt = 0; dt < 4; ++dt) { ot[dt][0] = (f32x4){0.f, 0.f, 0.f, 0.f}; ot[dt][1] = (f32x4){0.f, 0.f, 0.f, 0.f}; }
        float mrun[2] = {-1e30f, -1e30f}, lrun[2] = {0.f, 0.f};
        bf16x8 kc[4][2], kn[4][2];
        {   const bf16* kp = Kb + (kbase + keyoff) * 1024 + h * 64 + 8 * g;
#pragma unroll
            for (int t4 = 0; t4 < 4; ++t4) { const bf16* p = kp + (size_t)(32 * (t4 >> 1) + 4 * (t4 & 1)) * 1024; kc[t4][0] = ld_frag(p); kc[t4][1] = ld_frag(p + 32); } }
#pragma unroll 1
        for (int kb = 0; kb < nkb; ++kb) {
            const int kpos0 = kstart + 64 * kb;
            const size_t krow0 = (samp && kb == 8) ? knew : kbase + 64 * kb;
            bf16x8 vf[2][4];
            {   const bf16* vp = Vt + (size_t)(h * 64 + i16) * LDV + krow0 + 8 * g;
#pragma unroll
                for (int sb = 0; sb < 2; ++sb)
#pragma unroll
                    for (int dt = 0; dt < 4; ++dt) vf[sb][dt] = ld_frag(vp + (size_t)(16 * dt) * LDV + 32 * sb); }
            if (kb + 1 < nkb) {
                const size_t krow1 = (samp && kb + 1 == 8) ? knew : kbase + 64 * (kb + 1);
                const bf16* kp = Kb + (krow1 + keyoff) * 1024 + h * 64 + 8 * g;
#pragma unroll
                for (int t4 = 0; t4 < 4; ++t4) { const bf16* p = kp + (size_t)(32 * (t4 >> 1) + 4 * (t4 & 1)) * 1024; kn[t4][0] = ld_frag(p); kn[t4][1] = ld_frag(p + 32); }
            }
            f32x4 st[4][2];
#pragma unroll
            for (int t4 = 0; t4 < 4; ++t4)
#pragma unroll
                for (int qt = 0; qt < 2; ++qt) {
                    f32x4 acc = {0.f, 0.f, 0.f, 0.f};
                    acc = __builtin_amdgcn_mfma_f32_16x16x32_bf16(kc[t4][0], qf[qt][0], acc, 0, 0, 0);
                    acc = __builtin_amdgcn_mfma_f32_16x16x32_bf16(kc[t4][1], qf[qt][1], acc, 0, 0, 0);
                    st[t4][qt] = acc;
                }
            const bool far = qpos0 - (kpos0 + 63) >= 128;
            bf16x8 pf[2][2];
#pragma unroll
            for (int qt = 0; qt < 2; ++qt) {
                const int qpos = qpos0 + 16 * qt + i16;
                float mx = -1e30f;
                float boff = 0.f;
                if (far) {
#pragma unroll
                    for (int t4 = 0; t4 < 4; ++t4)
#pragma unroll
                        for (int j = 0; j < 4; ++j) mx = fmaxf(mx, st[t4][qt][j]);
                    mx += bfar; boff = bfar;
                } else {
#pragma unroll
                    for (int t4 = 0; t4 < 4; ++t4)
#pragma unroll
                        for (int j = 0; j < 4; ++j) {
                            int rel = qpos - (kpos0 + 32 * (t4 >> 1) + 8 * g + 4 * (t4 & 1) + j); rel = rel > 128 ? 128 : (rel < -128 ? -128 : rel);
                            const float s = st[t4][qt][j] + bh[rel]; st[t4][qt][j] = s; mx = fmaxf(mx, s);
                        }
                }
                mx = fmaxf(mx, __shfl_xor(mx, 16)); mx = fmaxf(mx, __shfl_xor(mx, 32));
                const float mnew = fmaxf(mrun[qt], mx), corr = __builtin_amdgcn_exp2f(mrun[qt] - mnew), msub = mnew - boff; mrun[qt] = mnew;
                float psum = 0.f;
#pragma unroll
                for (int sb = 0; sb < 2; ++sb) {
                    float p[8];
#pragma unroll
                    for (int T = 0; T < 2; ++T)
#pragma unroll
                        for (int j = 0; j < 4; ++j) { p[4 * T + j] = __builtin_amdgcn_exp2f(st[2 * sb + T][qt][j] - msub); psum += p[4 * T + j]; }
                    pf[sb][qt] = __builtin_bit_cast(bf16x8, pack8(p));
                }
                lrun[qt] = lrun[qt] * corr + psum;
#pragma unroll
                for (int dt = 0; dt < 4; ++dt) ot[dt][qt] *= corr;
            }
#pragma unroll
            for (int sb = 0; sb < 2; ++sb)
#pragma unroll
                for (int dt = 0; dt < 4; ++dt)
#pragma unroll
                    for (int qt = 0; qt < 2; ++qt) ot[dt][qt] = __builtin_amdgcn_mfma_f32_16x16x32_bf16(vf[sb][dt], pf[sb][qt], ot[dt][qt], 0, 0, 0);
#pragma unroll
            for (int t4 = 0; t4 < 4; ++t4) { kc[t4][0] = kn[t4][0]; kc[t4][1] = kn[t4][1]; }
        }
#pragma unroll
        for (int qt = 0; qt < 2; ++qt) {
            float l = lrun[qt]; l += __shfl_xor(l, 16); l += __shfl_xor(l, 32);
            const float inv = 1.0f / l;
            bf16* op = O + (qrow0 + 16 * qt + i16) * 1024 + h * 64 + 4 * g;
#pragma unroll
            for (int dt = 0; dt < 4; ++dt) { const f32x4 v = ot[dt][qt] * inv; v2u w; w.x = cvt_pk_bf16(v[0], v[1]); w.y = cvt_pk_bf16(v[2], v[3]); *(v2u*)(op + 16 * dt) = w; }
        }
    }
    const int gt = blockIdx.x * NTHREADS + tid, ngt = gridDim.x * NTHREADS;
    for (int idx = gt; idx < 8 * 16 * 512 * 8; idx += ngt) {
        const int d8 = idx & 7, r = (idx >> 3) & 511, h = (idx >> 12) & 15, b = idx >> 16;
        float f[8]; unpack8(*(const v4u*)(Kb + ((size_t)b * TPR + 7680 + r) * 1024 + h * 64 + d8 * 8), f);
        float* dst = a.out + O_PK + ((((size_t)o * 8 + b) * 16 + h) * 512 + r) * 64 + d8 * 8;
        *(f32x4*)dst = (f32x4){f[0], f[1], f[2], f[3]}; *(f32x4*)(dst + 4) = (f32x4){f[4], f[5], f[6], f[7]};
    }
    for (int idx = gt; idx < 8 * 16 * 64 * 64; idx += ngt) {
        const int r8 = idx & 63, d = (idx >> 6) & 63, h = (idx >> 12) & 15, b = idx >> 16;
        float f[8]; unpack8(*(const v4u*)(Vt + (size_t)(h * 64 + d) * LDV + (size_t)b * TPR + 7680 + r8 * 8), f);
        float* dst = a.out + O_PV + ((((size_t)o * 8 + b) * 16 + h) * 512 + r8 * 8) * 64 + d;
#pragma unroll
        for (int j = 0; j < 8; ++j) dst[j * 64] = f[j];
    }
    for (int idx = gt; idx < 16 * 16 * 64 * 8; idx += ngt) {
        const int d8 = idx & 7, t = (idx >> 3) & 63, h = (idx >> 9) & 15, b = idx >> 13;
        float f[8]; unpack8(*(const v4u*)(Kb + ((size_t)MP + b * 64 + t) * 1024 + h * 64 + d8 * 8), f);
        float* dst = a.out + O_SK + ((((size_t)o * 16 + b) * 16 + h) * 64 + t) * 64 + d8 * 8;
        *(f32x4*)dst = (f32x4){f[0], f[1], f[2], f[3]}; *(f32x4*)(dst + 4) = (f32x4){f[4], f[5], f[6], f[7]};
    }
    for (int idx = gt; idx < 16 * 16 * 64 * 8; idx += ngt) {
        const int t8 = idx & 7, d = (idx >> 3) & 63, h = (idx >> 9) & 15, b = idx >> 13;
        float f[8]; unpack8(*(const v4u*)(Vt + (size_t)(h * 64 + d) * LDV + (size_t)MP + b * 64 + t8 * 8), f);
        float* dst = a.out + O_SV + ((((size_t)o * 16 + b) * 16 + h) * 64 + t8 * 8) * 64 + d;
#pragma unroll
        for (int j = 0; j < 8; ++j) dst[j * 64] = f[j];
    }
}

#define XB_TMO      128
#define XB_XCNT(j)  (256  + 64 * (j))
#define XB_XSUB(j)  (1280 + 64 * (j))
#define XB_XGEN(j)  (2304 + 64 * (j))
#define XB_TOP      3328
#define XB_TOPGEN   3392
#define XCD_BAR_WORDS 3456
#define XB_SPIN_CAP (1u << 18)

__device__ __forceinline__ unsigned xb_ld(unsigned* p)              { return __hip_atomic_load(p, __ATOMIC_RELAXED, __HIP_MEMORY_SCOPE_AGENT); }
__device__ __forceinline__ unsigned xb_add(unsigned* p, unsigned v) { return __hip_atomic_fetch_add(p, v, __ATOMIC_RELAXED, __HIP_MEMORY_SCOPE_AGENT); }
__device__ __forceinline__ unsigned xb_xcc_id() { return (unsigned)__builtin_amdgcn_s_getreg((3 << 11) | 20) & 0xFu; }
#define XB_SPIN(cond, bar) do { unsigned _sp = 0; while (cond) { __builtin_amdgcn_s_sleep(1); \
    if ((++_sp & 255u) == 0u) { if (xb_ld(&(bar)[XB_TMO])) break; if (_sp > XB_SPIN_CAP) { atomicAdd(&(bar)[XB_TMO], 1u); break; } } } } while (0)

struct XcdBarrier {
    unsigned* bar; unsigned x;
    volatile LAS unsigned* st;
};

__device__ __forceinline__ XcdBarrier xcd_barrier_post(unsigned* bar, volatile LAS unsigned* st) {
    XcdBarrier b; b.bar = bar; b.x = xb_xcc_id(); b.st = st;
    if (threadIdx.x == 0) (void)xb_add(&bar[XB_XCNT(b.x)], 1u);
    return b;
}
__device__ __forceinline__ void xcd_barrier_complete(unsigned* bar, unsigned x, unsigned& nloc, unsigned& nx) {
    const unsigned G = gridDim.x * gridDim.y * gridDim.z;
    unsigned sum, cnt, mine, sp = 0u;
    for (;;) {
        sum = 0u; cnt = 0u; mine = 0u;
#pragma unroll
        for (unsigned j = 0; j < 16; ++j) { const unsigned c = xb_ld(&bar[XB_XCNT(j)]); sum += c; cnt += (c > 0u) ? 1u : 0u; mine = (j == x) ? c : mine; }
        if (sum == G) break;
        __builtin_amdgcn_s_sleep(1);
        if ((++sp & 255u) == 0u) { if (xb_ld(&bar[XB_TMO])) break; if (sp > XB_SPIN_CAP) { atomicAdd(&bar[XB_TMO], 1u); break; } }
    }
    nloc = mine > 0u ? mine : 1u; nx = cnt > 0u ? cnt : 1u;
}

__device__ __forceinline__ void xcd_barrier(const XcdBarrier& b) {
    asm volatile("s_waitcnt vmcnt(0)" ::: "memory");
    __syncthreads();
    if (threadIdx.x == 0) {
        unsigned* bar = b.bar;
        __builtin_amdgcn_s_waitcnt(0);
        unsigned nloc = b.st[0], nx = b.st[1];
        if (nloc == 0u) { xcd_barrier_complete(bar, b.x, nloc, nx); b.st[0] = nloc; b.st[1] = nx; }
        const unsigned old = xb_add(&bar[XB_XSUB(b.x)], 1u);
        const unsigned gen = old / nloc;
        if (old + 1u == (gen + 1u) * nloc) {
            __builtin_amdgcn_fence(__ATOMIC_RELEASE, "agent");
            asm volatile("s_waitcnt vmcnt(0)" ::: "memory");
            const unsigned og = xb_add(&bar[XB_TOP], 1u);
            const unsigned tg = og / nx;
            if (og + 1u == (tg + 1u) * nx) xb_add(&bar[XB_TOPGEN], 1u);
            else XB_SPIN(xb_ld(&bar[XB_TOPGEN]) == tg, bar);
            __builtin_amdgcn_fence(__ATOMIC_ACQUIRE, "agent");
            xb_add(&bar[XB_XGEN(b.x)], 1u);
            asm volatile("s_waitcnt vmcnt(0)" ::: "memory");
        } else {
            XB_SPIN(xb_ld(&bar[XB_XGEN(b.x)]) == gen, bar);
            __builtin_amdgcn_fence(__ATOMIC_ACQUIRE, "agent");
            asm volatile("s_waitcnt vmcnt(0)" ::: "memory");
        }
    }
    __syncthreads();
}

#ifndef REP_GEMM
#define REP_GEMM 1
#endif
#ifndef REP_SCAN
#define REP_SCAN 1
#endif
#ifndef REP_ATTN
#define REP_ATTN 1
#endif
#ifndef REP_LN
#define REP_LN 1
#endif
#ifndef EXTRA_SYNC
#define EXTRA_SYNC 2
#endif
#ifndef PH_STOP
#define PH_STOP N_PHASES
#endif
#ifndef PHMASK
#define PHMASK 0xffff
#endif
#define PHM(i) (((PHMASK) >> (i)) & 1)
constexpr int NS_K1 = 4, NS_K2 = 11;
constexpr int PH_PER_PAIR = 19, N_PHASES = 1 + 2 * PH_PER_PAIR;
__global__ void __launch_bounds__(NTHREADS, 2) trunk_fwd(Args a) {
    __shared__ __attribute__((aligned(16))) unsigned char lds_raw[LDS_BYTES];
    LAS unsigned char* lds = (LAS unsigned char*)lds_raw;
    cg::grid_group grid = cg::this_grid();
    volatile LAS unsigned* bar_st = (volatile LAS unsigned*)(lds + 131072);
    if (threadIdx.x < 2) bar_st[threadIdx.x] = 0u;
    __syncthreads();
    XcdBarrier xbar = xcd_barrier_post((unsigned*)(a.ws + WS_BAR), bar_st);
    unsigned char* ws = a.ws;
    bf16* XB = (bf16*)(ws + OFF_XB); bf16* R1 = (bf16*)(ws + OFF_R1); bf16* Z = (bf16*)(ws + OFF_Z); bf16* BIG = (bf16*)(ws + OFF_BIG);
    const int G = gridDim.x, cb = blockIdx.x;
#pragma unroll 1
    for (int ph = a.ph_lo; ph < a.ph_hi; ++ph) {
        bool nosync = false;
        if (ph == 0) { if (PHM(0)) prologue_phase(a, lds); }
        else {
            const int e = (ph - 1) / PH_PER_PAIR, q = (ph - 1) - e * PH_PER_PAIR;
            const int layer = 2 * e + (q >= 11 ? 1 : 0);
            int kind = -1; pg8::Gemm g{nullptr, nullptr, MT, 0, 0, nullptr, nullptr};
            pg8::EpiBf16 eb{nullptr, 0, 0, 0, 1.f, nullptr, 0}; int m2 = 0, n2 = 0;
            switch (q) {
            case 0:  kind = 0; g = pg8::Gemm{XB, (const bf16*)(ws + W_IN + e * W_IN_SZ), MT, NMIX, 1024, nullptr, nullptr}; eb = pg8::EpiBf16{BIG, APROJ, APROJ, (size_t)MT * APROJ, 1.f, nullptr, 0}; break;
            case 2:  kind = 0; g = pg8::Gemm{Z, (const bf16*)(ws + W_LO + e * W_LO_SZ), MT, NLORA, KLORA, nullptr, nullptr}; eb = pg8::EpiBf16{R1, 512, 512, (size_t)MT * 512, 1.f, nullptr, 0}; break;
            case 11: kind = 0; g = pg8::Gemm{XB, (const bf16*)(ws + W_QKV + e * W_QKV_SZ), MT, 2048, 1024, (const bf16*)(ws + W_QKV + e * W_QKV_SZ) + (size_t)2048 * 1024, XB};
                     eb = pg8::EpiBf16{BIG, 1024, 1024, (size_t)MT * 1024, 0.125f * 1.4426950408889634f, BIG + BIG_VT, LDV}; m2 = 1024; n2 = MT; break;
            case 12: nosync = true; break;
            case 8: case 16: kind = 1; g = pg8::Gemm{XB, (const bf16*)(ws + W_FI + layer * W_FI_SZ), MT, 2 * FH, 1024, nullptr, nullptr}; break;
            case 6:  kind = 2; g = pg8::Gemm{R1, (const bf16*)(ws + W_OM + e * W_SQ_SZ), MT, 1024, 1024, nullptr, nullptr}; break;
            case 14: kind = 2; g = pg8::Gemm{R1, (const bf16*)(ws + W_O + e * W_SQ_SZ), MT, 1024, 1024, nullptr, nullptr}; break;
            case 9: case 17: kind = 2; g = pg8::Gemm{BIG, (const bf16*)(ws + W_FO + layer * W_FO_SZ), MT, 1024, FH, nullptr, nullptr}; break;
            default: break;
            }
            const int nrep = kind >= 0 ? REP_GEMM : (q == 4 ? REP_SCAN : (q == 13 ? REP_ATTN : ((q == 7 || q == 15 || q == 10 || q == 18) ? REP_LN : 1)));
            if (q == 11) cache_convert(a, e);
#pragma unroll 1
            for (int rep = 0; rep < nrep; ++rep) {
            if (kind == 0 && PHM(1)) { pg8::StaticOrder S; S.init(g.M, g.N, G, cb, g.K, q == 2 ? 1 : 0); if (m2) S.second(m2, n2); pg8::gemm_phase<pg8::EpiBf16, pg8::StaticOrder, true, true>(lds, g, S, eb); }
            else if (kind == 1 && PHM(2)) { pg8::StaticOrder S; S.init(g.M, g.N, G, cb, g.K); pg8::EpiSwiglu es{BIG, FH}; pg8::gemm_phase<pg8::EpiSwiglu, pg8::StaticOrder, true, true>(lds, g, S, es); }
            else if (kind == 2 && PHM(3)) { pg8::SplitOrder S; S.init(G, cb, g.K, g.K == 1024 ? NS_K1 : NS_K2); pg8::EpiResid er{XB, Z, 1024, DN_ALPHA, (float*)(ws + OFF_G)}; pg8::gemm_phase<pg8::EpiResid, pg8::SplitOrder, true, true>(lds, g, S, er); }
            else if (q == 1 && PHM(4)) prep1_phase(a, e);
            else if (q == 3 && PHM(5)) prep2_phase(a, e);
            else if (q == 4 && PHM(6)) scan_phase(a, e, lds);
            else if (q == 5 && PHM(7)) post_phase(a, e);
            else if (q == 13 && PHM(8)) attn_phase(a, e, lds);
            else if ((q == 7 || q == 15) && PHM(9)) ln_phase(a, a.in[26] + (size_t)layer * 1024, a.in[27] + (size_t)layer * 1024, nullptr, NS_K1);
            else if ((q == 10 || q == 18) && PHM(9)) ln_phase(a, a.in[28] + (size_t)layer * 1024, a.in[29] + (size_t)layer * 1024, (layer == 3) ? a.out : nullptr, NS_K2);
        }
        }
        if (ph + 1 < a.ph_hi && !nosync) { if (ph == 0) grid.sync(); else xcd_barrier(xbar); }
        else __syncthreads();
    }
}

extern "C" void kernel_launch(void* const* d_in, const int* in_sizes, int n_in, void* d_out, int out_size, void* d_ws, size_t ws_size, hipStream_t stream) {
    static int grid = 0; static int badsz = 0;
    if (grid == 0) {
        if (n_in != 32 || ws_size < WS_BAR + WS_BAR_BYTES || out_size != 92360704) { fprintf(stderr, "kernel_launch: unexpected shapes (n_in %d, ws %zu, out %d)\n", n_in, ws_size, out_size); grid = -1; return; }
        static const long long exp_sz[32] = {67108864LL, 1048576, 1048576, 57344, 1048576, 16777216, 16777216, 6848512, 3584, 1024, 65536, 1024, 65536, 131072, 1024, 1024, 1024, 1024, 1024, 8192, 512, 256, 2097152, 6291456, 8224, 2097152, 4096, 4096, 4096, 4096, 23068672, 11534336};
        for (int i = 0; i < 32; ++i) if ((long long)in_sizes[i] != exp_sz[i]) { fprintf(stderr, "kernel_launch: input %d has %d elements, expected %lld\n", i, in_sizes[i], exp_sz[i]); badsz = 1; }
        int dev = 0, cus = 0, per_cu = 0;
        hipGetDevice(&dev); hipDeviceGetAttribute(&cus, hipDeviceAttributeMultiprocessorCount, dev);
        if (hipOccupancyMaxActiveBlocksPerMultiprocessor(&per_cu, (const void*)trunk_fwd, NTHREADS, 0) != hipSuccess || per_cu < 1) { fprintf(stderr, "kernel_launch: occupancy query says %d\n", per_cu); per_cu = 1; }
        (void)hipGetLastError();
        grid = cus * per_cu;
    }
    if (grid < 0) return;
    Args a{};
    for (int i = 0; i < 32; ++i) a.in[i] = (const float*)d_in[i];
    a.out = (float*)d_out; a.ws = (unsigned char*)d_ws;
#if defined(MK_PER_PHASE)
    for (int p = 0; p < N_PHASES; ++p) { a.ph_lo = p; a.ph_hi = p + 1; hipLaunchKernelGGL(trunk_fwd, dim3(grid), dim3(NTHREADS), 0, stream, a); }
#else
    a.ph_lo = 0; a.ph_hi = badsz ? 0 : PH_STOP;
    if (hipMemsetAsync((char*)d_ws + WS_BAR, 0, WS_BAR_BYTES, stream) != hipSuccess) { fprintf(stderr, "kernel_launch: memset of the barrier words failed\n"); return; }
    void* args[] = {&a};
    hipError_t err = hipLaunchCooperativeKernel((const void*)trunk_fwd, dim3(grid), dim3(NTHREADS), args, 0, stream);
    if (err != hipSuccess) fprintf(stderr, "kernel_launch: cooperative launch failed: %s (grid %d)\n", hipGetErrorString(err), grid);
#endif
}
```

```cpp
#include <hip/hip_runtime.h>
#include <hip/hip_cooperative_groups.h>
#include <cstdio>
#include <cstdint>
namespace cg = cooperative_groups;
namespace pg8 {
#define PG8_LAS __attribute__((address_space(3)))
typedef unsigned short bf16_t;
typedef short bf16x8 __attribute__((ext_vector_type(8)));
typedef float f32x4 __attribute__((ext_vector_type(4)));
typedef unsigned u32x4 __attribute__((ext_vector_type(4)));
constexpr int BM = 256, BK = 64, HALF = 128, HTB = HALF * BK * 2  , STAGE_BYTES = 8 * HTB, NXCD = 8, WGM = 8;

__host__ __device__ __forceinline__ int lds_byte(int r, int c) { const int st = (r >> 4) * 2 + (c >> 5), rr = r & 15, cc = c & 31, ob = rr * 64 + cc * 2; return st * 1024 + (ob ^ (((ob >> 9) & 1) << 5)); }
__host__ __device__ __forceinline__ void stage_rc(int b, int& R, int& C) { const int st = b / 1024, sb = b % 1024, swz = sb ^ (((sb >> 9) & 1) << 5); R = (st >> 1) * 16 + swz / 64; C = (st & 1) * 32 + (swz % 64) / 2; }
__host__ __device__ __forceinline__ int perm32(int rho) { const int n = rho >> 4, i = rho & 15; return 8 * (i >> 2) + 4 * n + (i & 3); }

struct Unit { int pm, pn, k0, nt, sl, z; };
struct Gemm { const bf16_t* A; const bf16_t* Bt; int M, N, K; const bf16_t* A2; const bf16_t* Bt2; };

struct StaticOrder {
    int nM, nN, nwg, G, c, ntk, lora, nM2, nN2, nwg2;
    __host__ __device__ void init(int M, int N, int G_, int c_, int K_, int lora_ = 0) { nM = M / BM; nN = N / BM; nwg = nM * nN; G = G_; c = c_; ntk = K_ / BK; lora = lora_; nM2 = 0; nN2 = 0; nwg2 = 0; }
    __host__ __device__ void second(int M2, int N2) { nM2 = M2 / BM; nN2 = N2 / BM; nwg2 = nM2 * nN2; }
    __host__ __device__ bool next(int i, Unit& u) const {
        long L = (long)i * G + c; int nM_ = nM, nN_ = nN, nwg_ = nwg, z_ = 0;
        if (L >= nwg) { L -= nwg; if (L >= nwg2) return false; nM_ = nM2; nN_ = nN2; nwg_ = nwg2; z_ = 1; }
        int wgid = (int)L; { const int q = nwg_ / NXCD, r = nwg_ % NXCD, xcd = wgid % NXCD, off = wgid / NXCD; wgid = (xcd < r ? xcd * (q + 1) : r * (q + 1) + (xcd - r) * q) + off; }
        const int nig = WGM * nN_, gid = wgid / nig, fm = gid * WGM, gsz = (nM_ - fm) < WGM ? (nM_ - fm) : WGM;
        u.pm = fm + ((wgid % nig) % gsz); u.pn = (wgid % nig) / gsz; u.k0 = 0; u.nt = ntk; u.sl = -1; u.z = z_; if (lora) { u.k0 = u.pn < 4 ? 0 : 2; u.nt = 2; } return true;
    }
    __device__ __forceinline__ void a_ready(const Unit&) const {}
    __device__ __forceinline__ void done(const Unit&) const {}
};

struct SplitOrder {
    StaticOrder so; int NS, nts, G, c;
    __host__ __device__ void init(int G_, int c_, int K_, int NS_) { so.init(65536, 1024, G_, c_, K_); NS = NS_; nts = (K_ / BK) / NS_; G = G_; c = c_; }
    __host__ __device__ bool next(int i, Unit& u) const {
        if (so.next(i, u)) return true;
        const long L = (long)i * G + c - 1024; if (L < 0 || L >= 16 * NS) return false;
        const int tile = (int)L / NS, sl = (int)L - tile * NS;
        u.pm = 256 + (tile >> 2); u.pn = tile & 3; u.k0 = sl * nts; u.nt = nts; u.sl = sl; u.z = 0; return true;
    }
    __device__ __forceinline__ void a_ready(const Unit&) const {}
    __device__ __forceinline__ void done(const Unit&) const {}
};

__device__ __forceinline__ unsigned cvt_pk_bf16(float lo, float hi) { unsigned r; asm volatile("v_cvt_pk_bf16_f32 %0, %1, %2" : "=v"(r) : "v"(lo), "v"(hi)); return r; }
__device__ __forceinline__ float bf_lo(unsigned w) { return __uint_as_float(w << 16); }
__device__ __forceinline__ float bf_hi(unsigned w) { return __uint_as_float(w & 0xffff0000u); }
struct EpiBf16 {
    static constexpr bool PERM = true, AFTER_DRAIN = false;
    bf16_t* O; int ldc; int split_cols; size_t split_stride; float scale0; bf16_t* O2; int ldc2;
    __device__ __forceinline__ void operator()(const f32x4 (&acc)[2][2][4][2], const Unit& u, int wr, int wc, int fr, int fq) const {
        const int row0 = u.pm * BM + wr * 64 + fr; int colt = u.pn * BM; bf16_t* base = u.z ? O2 : O; const int ldc = u.z ? ldc2 : this->ldc;
        float sc = 1.f; if (split_cols && !u.z) { const int t = colt / split_cols; base += (size_t)t * split_stride; colt -= t * split_cols; if (t == 0) sc = scale0; }
        const int col0 = colt + wc * 32 + 8 * fq;
#pragma unroll
        for (int ai = 0; ai < 2; ++ai)
#pragma unroll
            for (int m = 0; m < 4; ++m) { bf16_t* rowp = base + (size_t)(row0 + ai * HALF + m * 16) * ldc + col0;
#pragma unroll
                for (int bj = 0; bj < 2; ++bj) { const f32x4 v0 = acc[ai][bj][m][0] * sc, v1 = acc[ai][bj][m][1] * sc;
                    u32x4 w; w.x = cvt_pk_bf16(v0[0], v0[1]); w.y = cvt_pk_bf16(v0[2], v0[3]); w.z = cvt_pk_bf16(v1[0], v1[1]); w.w = cvt_pk_bf16(v1[2], v1[3]);
                    *(u32x4*)(rowp + bj * HALF) = w; } }
    }
};
__device__ __forceinline__ float silu_f(float x) { return x * __builtin_amdgcn_rcpf(1.0f + __expf(-x)); }
struct EpiSwiglu {
    static constexpr bool PERM = true, AFTER_DRAIN = false;
    bf16_t* O; int ldc;
    __device__ __forceinline__ void operator()(const f32x4 (&acc)[2][2][4][2], const Unit& u, int wr, int wc, int fr, int fq) const {
        const int row0 = u.pm * BM + wr * 64 + fr; const int col0 = u.pn * HALF + wc * 32 + 8 * fq;
#pragma unroll
        for (int ai = 0; ai < 2; ++ai)
#pragma unroll
            for (int m = 0; m < 4; ++m) { bf16_t* rowp = O + (size_t)(row0 + ai * HALF + m * 16) * ldc + col0;
                const f32x4 g0 = acc[ai][0][m][0], g1 = acc[ai][0][m][1], u0 = acc[ai][1][m][0], u1 = acc[ai][1][m][1];
                u32x4 w;
                w.x = cvt_pk_bf16(silu_f(g0[0]) * u0[0], silu_f(g0[1]) * u0[1]); w.y = cvt_pk_bf16(silu_f(g0[2]) * u0[2], silu_f(g0[3]) * u0[3]);
                w.z = cvt_pk_bf16(silu_f(g1[0]) * u1[0], silu_f(g1[1]) * u1[1]); w.w = cvt_pk_bf16(silu_f(g1[2]) * u1[2], silu_f(g1[3]) * u1[3]);
                *(u32x4*)rowp = w; }
    }
};
struct EpiResid {
    static constexpr bool PERM = true, AFTER_DRAIN = false;
    const bf16_t* X; bf16_t* Z; int ldc; float alpha; float* ZS;
    __device__ __forceinline__ void operator()(const f32x4 (&acc)[2][2][4][2], const Unit& u, int wr, int wc, int fr, int fq) const {
        const int row0 = u.pm * BM + wr * 64 + fr; const int col0 = u.pn * BM + wc * 32 + 8 * fq;
        if (u.sl >= 0) {
            float* zs = ZS + ((size_t)u.sl * 1024 + (row0 - 65536)) * 1024 + col0;
#pragma unroll
            for (int ai = 0; ai < 2; ++ai)
#pragma unroll
                for (int m = 0; m < 4; ++m)
#pragma unroll
                    for (int bj = 0; bj < 2; ++bj) { float* q = zs + (size_t)(ai * HALF + m * 16) * 1024 + bj * HALF; *(f32x4*)q = acc[ai][bj][m][0]; *(f32x4*)(q + 4) = acc[ai][bj][m][1]; }
            return;
        }
#pragma unroll
        for (int ai = 0; ai < 2; ++ai)
#pragma unroll
            for (int m = 0; m < 4; ++m) { const size_t off = (size_t)(row0 + ai * HALF + m * 16) * ldc + col0;
#pragma unroll
                for (int bj = 0; bj < 2; ++bj) { const u32x4 x = *(const u32x4*)(X + off + bj * HALF);
                    const f32x4 v0 = acc[ai][bj][m][0], v1 = acc[ai][bj][m][1];
                    u32x4 w;
                    w.x = cvt_pk_bf16(alpha * bf_lo(x.x) + v0[0], alpha * bf_hi(x.x) + v0[1]); w.y = cvt_pk_bf16(alpha * bf_lo(x.y) + v0[2], alpha * bf_hi(x.y) + v0[3]);
                    w.z = cvt_pk_bf16(alpha * bf_lo(x.z) + v1[0], alpha * bf_hi(x.z) + v1[1]); w.w = cvt_pk_bf16(alpha * bf_lo(x.w) + v1[2], alpha * bf_hi(x.w) + v1[3]);
                    *(u32x4*)(Z + off + bj * HALF) = w; } }
    }
};
template <class Epi, class Sched, bool ALIGN_EPI = false, bool SP2 = false>
__device__ __forceinline__ void gemm_phase(PG8_LAS unsigned char* lds, const Gemm g, const Sched& S, const Epi& E) {
    int tid = threadIdx.x; asm volatile("" : "+v"(tid)); const int wid = __builtin_amdgcn_readfirstlane(tid >> 6), lane = tid & 63, wr = wid >> 2, wc = wid & 3, fr = lane & 15, fq = lane >> 4;
    const int K = g.K;
    unsigned voffA[2], voffB[2];
#pragma unroll
    for (int i = 0; i < 2; ++i) { int R, C; stage_rc(tid * 16 + i * 8192, R, C); const int Rb = Epi::PERM ? ((R & ~31) + perm32(R & 31)) : R;
        voffA[i] = (unsigned)(R * K + C) * 2u; voffB[i] = (unsigned)(Rb * K + C) * 2u; }
    const size_t kstep = (size_t)(BK * 2);
    const size_t hstep = (size_t)HALF * K * 2;
    const size_t tstep = 2 * hstep;
    const unsigned ldsw = (unsigned)wid * 1024u;
    const int aoff = lds_byte(wr * 64 + fr, fq * 8), boff = lds_byte(wc * 32 + fr, fq * 8);
#define PG8_SA(b, h) (((b) * 2 + (h)) * HTB)
#define PG8_SB(b, h) ((4 + (b) * 2 + (h)) * HTB)
#define PG8_STAGE(bufoff, gbase, voff) do { _Pragma("unroll") for (int _i = 0; _i < 2; ++_i) \
        __builtin_amdgcn_global_load_lds((const unsigned*)((const char*)(gbase) + (voff)[_i]), (PG8_LAS unsigned*)(lds + (bufoff) + ldsw + _i * 8192), 16, 0, 0); } while (0)
#define PG8_LDA(dst, b, h) do { _Pragma("unroll") for (int m = 0; m < 4; ++m) _Pragma("unroll") for (int k = 0; k < 2; ++k) dst[m][k] = *(const PG8_LAS bf16x8*)(lds + PG8_SA(b, h) + aoff + m * 2048 + k * 1024); } while (0)
#define PG8_LDB(dst, b, h) do { _Pragma("unroll") for (int n = 0; n < 2; ++n) _Pragma("unroll") for (int k = 0; k < 2; ++k) dst[n][k] = *(const PG8_LAS bf16x8*)(lds + PG8_SB(b, h) + boff + n * 2048 + k * 1024); } while (0)
#define PG8_MMA(ai, bj, At, Bt) do { __builtin_amdgcn_s_setprio(1); _Pragma("unroll") for (int m = 0; m < 4; ++m) _Pragma("unroll") for (int n = 0; n < 2; ++n) _Pragma("unroll") for (int k = 0; k < 2; ++k) \
        acc[ai][bj][m][n] = __builtin_amdgcn_mfma_f32_16x16x32_bf16(Bt[n][k], At[m][k], acc[ai][bj][m][n], 0, 0, 0); __builtin_amdgcn_s_setprio(0); } while (0)
#define PG8_WAIT_V(n) asm volatile("s_waitcnt vmcnt(" #n ")" ::: "memory")
#define PG8_WAIT_L(n) asm volatile("s_waitcnt lgkmcnt(" #n ")" ::: "memory")
#define PG8_BAR __builtin_amdgcn_s_barrier()
#define PG8_SCHED __builtin_amdgcn_sched_barrier(0)
    Unit cur, nxt; int ui = 0;
    if (!S.next(0, cur)) return;
    f32x4 acc[2][2][4][2];
#pragma unroll
    for (int a = 0; a < 2; ++a)
#pragma unroll
        for (int b = 0; b < 2; ++b)
#pragma unroll
            for (int m = 0; m < 4; ++m)
#pragma unroll
                for (int n = 0; n < 2; ++n) acc[a][b][m][n] = (f32x4){0.f, 0.f, 0.f, 0.f};
    bf16x8 At[4][2], B0[2][2], B1[2][2];
    const char* cA = (const char*)(cur.z ? g.A2 : g.A) + (size_t)cur.pm * tstep + (size_t)cur.k0 * kstep; const char* cB = (const char*)(cur.z ? g.Bt2 : g.Bt) + (size_t)cur.pn * tstep + (size_t)cur.k0 * kstep;
    S.a_ready(cur);
    if constexpr (SP2) {
        PG8_STAGE(PG8_SB(0, 0), cB, voffB); PG8_STAGE(PG8_SB(0, 1), cB + hstep, voffB); PG8_STAGE(PG8_SA(0, 0), cA, voffA); PG8_STAGE(PG8_SA(0, 1), cA + hstep, voffA);
        if (wr == 1) PG8_BAR;
        PG8_WAIT_V(2); PG8_BAR;
        PG8_STAGE(PG8_SB(1, 0), cB + kstep, voffB); PG8_STAGE(PG8_SA(1, 0), cA + kstep, voffA); PG8_STAGE(PG8_SB(1, 1), cB + hstep + kstep, voffB);
        PG8_WAIT_V(6); PG8_BAR;
    } else {
        PG8_STAGE(PG8_SB(0, 0), cB, voffB); PG8_STAGE(PG8_SA(0, 0), cA, voffA); PG8_STAGE(PG8_SB(0, 1), cB + hstep, voffB); PG8_STAGE(PG8_SA(0, 1), cA + hstep, voffA);
        if (wr == 1) PG8_BAR;
        PG8_WAIT_V(4); PG8_BAR;
        PG8_STAGE(PG8_SB(1, 0), cB + kstep, voffB); PG8_STAGE(PG8_SA(1, 0), cA + kstep, voffA); PG8_STAGE(PG8_SB(1, 1), cB + hstep + kstep, voffB);
        PG8_WAIT_V(6); PG8_BAR;
    }
    for (;;) {
        const bool has_next = S.next(ui + 1, nxt);
        const char* nA = has_next ? (const char*)(nxt.z ? g.A2 : g.A) + (size_t)nxt.pm * tstep + (size_t)nxt.k0 * kstep : cA; const char* nB = has_next ? (const char*)(nxt.z ? g.Bt2 : g.Bt) + (size_t)nxt.pn * tstep + (size_t)nxt.k0 * kstep : cB;
        const int nt = cur.nt;
        for (int t = 0; t < nt; t += 2) {
            const bool last = (t == nt - 2);
            const char* a1 = cA + (size_t)(t + 1) * kstep;
            const char* a2 = last ? nA : cA + (size_t)(t + 2) * kstep; const char* b2 = last ? nB : cB + (size_t)(t + 2) * kstep;
            const char* a3 = a2 + kstep; const char* b3 = b2 + kstep;
            if (last && has_next) S.a_ready(nxt);
            if constexpr (SP2) {
            PG8_LDB(B0, 0, 0); PG8_LDB(B1, 0, 1); PG8_SCHED; PG8_LDA(At, 0, 0); PG8_STAGE(PG8_SA(1, 1), a1 + hstep, voffA);
            PG8_WAIT_V(8); PG8_WAIT_L(0); PG8_BAR; PG8_MMA(0, 0, At, B0); PG8_MMA(0, 1, At, B1); PG8_BAR; PG8_SCHED;
            PG8_LDA(At, 0, 1); PG8_STAGE(PG8_SB(0, 0), b2, voffB); PG8_STAGE(PG8_SB(0, 1), b2 + hstep, voffB); PG8_STAGE(PG8_SA(0, 0), a2, voffA);
            PG8_WAIT_V(8); PG8_WAIT_L(0); PG8_BAR; PG8_MMA(1, 0, At, B0); PG8_MMA(1, 1, At, B1); PG8_BAR; PG8_SCHED;
            PG8_LDB(B0, 1, 0); PG8_LDB(B1, 1, 1); PG8_SCHED; PG8_LDA(At, 1, 0); PG8_STAGE(PG8_SA(0, 1), a2 + hstep, voffA);
            PG8_WAIT_V(8); PG8_WAIT_L(0); PG8_BAR; PG8_MMA(0, 0, At, B0); PG8_MMA(0, 1, At, B1); PG8_BAR; PG8_SCHED;
            PG8_LDA(At, 1, 1); PG8_STAGE(PG8_SB(1, 0), b3, voffB); PG8_STAGE(PG8_SB(1, 1), b3 + hstep, voffB); PG8_STAGE(PG8_SA(1, 0), a3, voffA);
            PG8_WAIT_V(8); PG8_WAIT_L(0); PG8_BAR; PG8_MMA(1, 0, At, B0); PG8_MMA(1, 1, At, B1); PG8_BAR; PG8_SCHED;
            } else {
            PG8_LDB(B0, 0, 0); PG8_SCHED; PG8_LDA(At, 0, 0); PG8_STAGE(PG8_SA(1, 1), a1 + hstep, voffA);
            PG8_WAIT_L(8); PG8_BAR; PG8_WAIT_L(0); PG8_MMA(0, 0, At, B0); PG8_BAR; PG8_SCHED;
            PG8_LDB(B1, 0, 1); PG8_STAGE(PG8_SB(0, 0), b2, voffB);
            PG8_BAR; PG8_WAIT_L(0); PG8_MMA(0, 1, At, B1); PG8_BAR;
            PG8_LDA(At, 0, 1); PG8_STAGE(PG8_SA(0, 0), a2, voffA);
            PG8_BAR; PG8_WAIT_L(0); PG8_MMA(1, 0, At, B0); PG8_BAR; PG8_SCHED;
            PG8_STAGE(PG8_SB(0, 1), b2 + hstep, voffB);
            PG8_WAIT_V(6); PG8_BAR; PG8_MMA(1, 1, At, B1); PG8_BAR;
            PG8_LDB(B0, 1, 0); PG8_SCHED; PG8_LDA(At, 1, 0); PG8_STAGE(PG8_SA(0, 1), a2 + hstep, voffA);
            PG8_WAIT_L(8); PG8_BAR; PG8_WAIT_L(0); PG8_MMA(0, 0, At, B0); PG8_BAR; PG8_SCHED;
            PG8_LDB(B1, 1, 1); PG8_STAGE(PG8_SB(1, 0), b3, voffB);
            PG8_BAR; PG8_WAIT_L(0); PG8_MMA(0, 1, At, B1); PG8_BAR;
            PG8_LDA(At, 1, 1); PG8_STAGE(PG8_SA(1, 0), a3, voffA);
            PG8_BAR; PG8_WAIT_L(0); PG8_MMA(1, 0, At, B0); PG8_BAR; PG8_SCHED;
            PG8_STAGE(PG8_SB(1, 1), b3 + hstep, voffB);
            PG8_WAIT_V(6); PG8_BAR; PG8_MMA(1, 1, At, B1); PG8_BAR;
            }
        }
        if constexpr (ALIGN_EPI) { if (wr == 0) PG8_BAR; }
        if constexpr (!Epi::AFTER_DRAIN) { E(acc, cur, wr, wc, fr, fq); S.done(cur); }
        if (!has_next) break;
#pragma unroll
        for (int a = 0; a < 2; ++a)
#pragma unroll
            for (int b = 0; b < 2; ++b)
#pragma unroll
                for (int m = 0; m < 4; ++m)
#pragma unroll
                    for (int n = 0; n < 2; ++n) acc[a][b][m][n] = (f32x4){0.f, 0.f, 0.f, 0.f};
        cur = nxt; cA = nA; cB = nB; ++ui;
        if constexpr (ALIGN_EPI) { if (wr == 1) PG8_BAR; }
    }
    PG8_WAIT_V(0);
    if constexpr (!ALIGN_EPI) { if (wr == 0) PG8_BAR; }
    PG8_BAR;
    if constexpr (Epi::AFTER_DRAIN) { E.fused(acc, cur, wr, wc, fr, fq, lds, wid, lane); S.done(cur); }
#undef PG8_SA
#undef PG8_SB
#undef PG8_STAGE
#undef PG8_LDA
#undef PG8_LDB
#undef PG8_MMA
#undef PG8_WAIT_V
#undef PG8_WAIT_L
#undef PG8_BAR
#undef PG8_SCHED
}
}
#define TR_LO 0
#define TR_HI 16


#define LAS __attribute__((address_space(3)))
typedef unsigned short bf16;
typedef unsigned v4u __attribute__((ext_vector_type(4)));
typedef unsigned v2u __attribute__((ext_vector_type(2)));
typedef float f32x4 __attribute__((ext_vector_type(4)));
typedef short bf16x8 __attribute__((ext_vector_type(8)));
using pg8::cvt_pk_bf16; using pg8::bf_lo; using pg8::bf_hi;

constexpr int DM = 1024, MP = 65536, MS = 1024, MT = MP + MS;
constexpr int TPR = 8192, TSM = 64;
constexpr int APROJ = 1792, NMIX = 3584, FH = 2816, NLORA = 1536, KLORA = 256;
constexpr float LN_EPS = 1e-5f, A_NORM_EPS = 64e-5f;
constexpr float DN_ALPHA = 1.681792830507429f;
constexpr int NWAVES = 8, NTHREADS = 512;
constexpr int LDS_BYTES = 132096;

constexpr size_t SZ_X = (size_t)MT * 1024 * 2;
constexpr size_t W_IN = 0, W_IN_SZ = (size_t)NMIX * 1024 * 2;
constexpr size_t W_LO = W_IN + 2 * W_IN_SZ, W_LO_SZ = (size_t)NLORA * KLORA * 2;
constexpr size_t W_OM = W_LO + 2 * W_LO_SZ, W_SQ_SZ = (size_t)1024 * 1024 * 2;
constexpr size_t W_QKV = W_OM + 2 * W_SQ_SZ, W_QKV_SZ = (size_t)3072 * 1024 * 2;
constexpr size_t W_O = W_QKV + 2 * W_QKV_SZ;
constexpr size_t W_FI = W_O + 2 * W_SQ_SZ, W_FI_SZ = (size_t)2 * FH * 1024 * 2;
constexpr size_t W_FO = W_FI + 4 * W_FI_SZ, W_FO_SZ = (size_t)1024 * FH * 2;
constexpr size_t OFF_XB = W_FO + 4 * W_FO_SZ;
constexpr size_t OFF_R1 = OFF_XB + SZ_X;
constexpr size_t OFF_G = OFF_R1 + SZ_X;
constexpr size_t OFF_Z = OFF_G + SZ_X / 2;
constexpr size_t OFF_BIG = OFF_Z + SZ_X;
constexpr size_t WS_END = OFF_BIG + (size_t)MT * NMIX * 2;
constexpr size_t WS_BAR = WS_END, WS_BAR_BYTES = 16384;
static_assert(OFF_XB % 256 == 0 && WS_BAR % 256 == 0 && WS_BAR + WS_BAR_BYTES <= (size_t)1073741824, "ws map");

constexpr size_t O_YP = 0, O_YS = 67108864, O_PWKV = 68157440, O_PSHIFT = 68681728, O_PGLA = 68710400, O_PK = 69234688, O_PV = 77623296,
                 O_SWKV = 86011904, O_SSHIFT = 87060480, O_SGLA = 87117824, O_SK = 88166400, O_SV = 90263552;

__device__ __forceinline__ int tid_opaque() { int t = threadIdx.x; asm volatile("" : "+v"(t)); return t; }
struct Args { const float* in[32]; float* out; unsigned char* ws; int ph_lo, ph_hi; };

__device__ __forceinline__ float wave_sum(float v) {
#pragma unroll
    for (int o = 1; o < 64; o <<= 1) v += __shfl_xor(v, o);
    return v;
}
__device__ __forceinline__ void unpack8(const v4u w, float* f) {
    f[0] = bf_lo(w.x); f[1] = bf_hi(w.x); f[2] = bf_lo(w.y); f[3] = bf_hi(w.y); f[4] = bf_lo(w.z); f[5] = bf_hi(w.z); f[6] = bf_lo(w.w); f[7] = bf_hi(w.w);
}
__device__ __forceinline__ v4u pack8(const float* f) {
    v4u w; w.x = cvt_pk_bf16(f[0], f[1]); w.y = cvt_pk_bf16(f[2], f[3]); w.z = cvt_pk_bf16(f[4], f[5]); w.w = cvt_pk_bf16(f[6], f[7]); return w;
}
__device__ __forceinline__ void load8f(const float* p, float* f) {
    const f32x4 a = *(const f32x4*)p, b = *(const f32x4*)(p + 4);
    f[0] = a.x; f[1] = a.y; f[2] = a.z; f[3] = a.w; f[4] = b.x; f[5] = b.y; f[6] = b.z; f[7] = b.w;
}
__device__ __forceinline__ float softplus_f(float x) { return fmaxf(x, 0.f) + __logf(1.0f + __expf(-fabsf(x))); }
__device__ __forceinline__ float sigmoid_f(float x) { return __builtin_amdgcn_rcpf(1.0f + __expf(-x)); }
#define LDS_WAIT() asm volatile("s_waitcnt lgkmcnt(0)" ::: "memory")

__device__ __forceinline__ int xcd_vcu() { const int G = gridDim.x, bx = blockIdx.x; return (G % 8 == 0) ? (bx % 8) * (G / 8) + bx / 8 : bx; }
__device__ __forceinline__ int src_col(int mode, int n) {
    if (mode == 0) return n;
    if (mode == 1) {
        if (n < 1792) return n;
        if (n < 2816) { const int h = (n - 1792) >> 8, r = (n - 1792) & 255;
            if (r < 64) return 1792 + h * 64 + r; if (r < 128) return 1792 + 256 + h * 64 + (r - 64); return 1792 + 512 + h * 128 + (r - 128); }
        if (n < 3328) return 1792 + 1040 + (n - 2816);
        if (n < 3344) return 1792 + 1024 + (n - 3328);
        return -1;
    }
    const int pn = n >> 8, jj = n & 255;
    return jj < 128 ? pn * 128 + jj : FH + pn * 128 + (jj - 128);
}
__device__ __forceinline__ void transpose_item(const float* W, int ldw, int mode, bf16* WT, int K, int N, int it, int lane) {
    const int nblk = N / 64;
    const int kb = it / nblk, nb = it - kb * nblk, k0 = 64 * kb, n = 64 * nb + lane;
    const int sc = src_col(mode, n); const float msk = sc >= 0 ? 1.f : 0.f; const int scc = sc >= 0 ? sc : 0;
    const float* wp = W + (size_t)k0 * ldw + scc; bf16* op = WT + (size_t)n * K + k0;
#pragma unroll 4
    for (int k8 = 0; k8 < 8; ++k8) {
        float f[8];
#pragma unroll
        for (int i = 0; i < 8; ++i) f[i] = wp[(size_t)(8 * k8 + i) * ldw] * msk;
        *(v4u*)(op + 8 * k8) = pack8(f);
    }
}
__device__ __forceinline__ void prologue_phase(const Args& a, LAS unsigned char* lds) {
    const int tid = tid_opaque(), lane = tid & 63, wave = tid >> 6;
    const int gw = blockIdx.x * NWAVES + wave, ngw = gridDim.x * NWAVES;
    LAS float* scr = (LAS float*)(lds + wave * 8704);
    unsigned char* ws = a.ws;
    for (int itg = gw; itg < 12800; itg += ngw) {
        int j, base;
        if (itg < 1792) { j = itg / 896; base = j * 896; }
        else if (itg < 2304) { j = 2 + (itg - 1792) / 256; base = 1792 + (j - 2) * 256; }
        else if (itg < 3840) { j = 4 + (itg - 2304) / 768; base = 2304 + (j - 4) * 768; }
        else if (itg < 4352) { j = 6 + (itg - 3840) / 256; base = 3840 + (j - 6) * 256; }
        else if (itg < 9984) { j = 8 + (itg - 4352) / 1408; base = 4352 + (j - 8) * 1408; }
        else { j = 12 + (itg - 9984) / 704; base = 9984 + (j - 12) * 704; }
        const float* W; int ldw, mode, K, N; bf16* WT;
        if (j < 2)       { W = a.in[7] + (size_t)j * 1024 * 3344; ldw = 3344; mode = 1; K = 1024; N = NMIX; WT = (bf16*)(ws + W_IN + j * W_IN_SZ); }
        else if (j < 4)  { const int e = j - 2;  W = a.in[22] + (size_t)e * 1024 * 1024; ldw = 1024; mode = 0; K = 1024; N = 1024; WT = (bf16*)(ws + W_OM + e * W_SQ_SZ); }
        else if (j < 6)  { const int e = j - 4;  W = a.in[23] + (size_t)e * 1024 * 3072; ldw = 3072; mode = 0; K = 1024; N = 3072; WT = (bf16*)(ws + W_QKV + e * W_QKV_SZ); }
        else if (j < 8)  { const int e = j - 6;  W = a.in[25] + (size_t)e * 1024 * 1024; ldw = 1024; mode = 0; K = 1024; N = 1024; WT = (bf16*)(ws + W_O + e * W_SQ_SZ); }
        else if (j < 12) { const int l = j - 8;  W = a.in[30] + (size_t)l * 1024 * 2 * FH; ldw = 2 * FH; mode = 2; K = 1024; N = 2 * FH; WT = (bf16*)(ws + W_FI + l * W_FI_SZ); }
        else             { const int l = j - 12; W = a.in[31] + (size_t)l * FH * 1024; ldw = 1024; mode = 0; K = FH; N = 1024; WT = (bf16*)(ws + W_FO + l * W_FO_SZ); }
        transpose_item(W, ldw, mode, WT, K, N, itg - base, lane);
    }
    const int gt = blockIdx.x * NTHREADS + tid, ngt = gridDim.x * NTHREADS;
#ifndef SKIP_LORA
    for (int idx = gt; idx < 2 * NLORA * 32; idx += ngt) {
        const int e = idx / (NLORA * 32), r = idx - e * (NLORA * 32), n = r >> 5, k0 = (r & 31) * 8;
        float f[8];
#pragma unroll
        for (int i = 0; i < 8; ++i) { const int k = k0 + i; float v = 0.f;
            if (n < 512) { if (k < 64) v = a.in[10][((size_t)e * 64 + k) * 512 + n]; }
            else if (n < 1024) { if (k >= 64 && k < 128) v = a.in[12][((size_t)e * 64 + (k - 64)) * 512 + (n - 512)]; }
            else { if (k >= 128) v = a.in[13][((size_t)e * 128 + (k - 128)) * 512 + (n - 1024)]; }
            f[i] = v; }
        *(v4u*)((bf16*)(ws + W_LO + e * W_LO_SZ) + (size_t)n * KLORA + k0) = pack8(f);
    }
#endif
    bf16* XB = (bf16*)(ws + OFF_XB);
    for (size_t idx = gt; idx < (size_t)MT * 128; idx += ngt) {
        const size_t e0 = idx * 8; const float* src = e0 < (size_t)MP * 1024 ? a.in[0] + e0 : a.in[1] + (e0 - (size_t)MP * 1024);
        float f[8]; load8f(src, f); *(v4u*)(XB + e0) = pack8(f);
    }
}

__device__ __forceinline__ void prep1_phase(const Args& a, int e) {
    const int tid = tid_opaque(), lane = tid & 63, wave = tid >> 6;
    const int gw = blockIdx.x * NWAVES + wave, ngw = gridDim.x * NWAVES;
    const bf16* PA = (const bf16*)(a.ws + OFF_BIG); bf16* L = (bf16*)(a.ws + OFF_Z);
    const float* mu = a.in[8] + (size_t)e * APROJ; const float* shift0 = a.in[3] + (size_t)e * 16 * APROJ;
    const int c = 1536 + 4 * lane;
    const f32x4 mu4 = *(const f32x4*)(mu + c);
    for (int m = gw; m < MT; m += ngw) {
        const v2u pw = *(const v2u*)(PA + (size_t)m * APROJ + c);
        float p[4] = {bf_lo(pw.x), bf_hi(pw.x), bf_lo(pw.y), bf_hi(pw.y)}, q[4];
        const int t = m < MP ? (m & (TPR - 1)) : ((m - MP) & (TSM - 1));
        if (t > 0) { const v2u qw = *(const v2u*)(PA + (size_t)(m - 1) * APROJ + c); q[0] = bf_lo(qw.x); q[1] = bf_hi(qw.x); q[2] = bf_lo(qw.y); q[3] = bf_hi(qw.y); }
        else if (m < MP) { q[0] = q[1] = q[2] = q[3] = 0.f; }
        else { const f32x4 s = *(const f32x4*)(shift0 + (size_t)((m - MP) >> 6) * APROJ + c); q[0] = s.x; q[1] = s.y; q[2] = s.z; q[3] = s.w; }
        float r[4];
#pragma unroll
        for (int i = 0; i < 4; ++i) { const float xs = p[i] + (q[i] - p[i]) * mu4[i]; r[i] = lane < 16 ? tanhf(xs) : (lane < 32 ? xs : sigmoid_f(xs)); }
        v2u o; o.x = cvt_pk_bf16(r[0], r[1]); o.y = cvt_pk_bf16(r[2], r[3]);
        *(v2u*)(L + (size_t)m * KLORA + 4 * lane) = o;
    }
}
__device__ __forceinline__ void prep2_phase(const Args& a, int e) {
    const int tid = tid_opaque(), lane = tid & 63, wave = tid >> 6;
    const int gw = blockIdx.x * NWAVES + wave, ngw = gridDim.x * NWAVES;
    const bf16* PA = (const bf16*)(a.ws + OFF_BIG); bf16* PB = (bf16*)(a.ws + OFF_BIG) + (size_t)MT * APROJ;
    const bf16* Lw = (const bf16*)(a.ws + OFF_R1); const bf16* La = Lw + (size_t)MT * 512;
    bf16* SA = (bf16*)a.out; bf16* SB = (bf16*)(a.ws + OFF_Z);
    const float* mu = a.in[8] + (size_t)e * APROJ; const float* shift0 = a.in[3] + (size_t)e * 16 * APROJ;
    const int c8 = 8 * lane, h = lane >> 3;
    float mur[8], muk[8], muv[8], w0[8], a0[8], kkw[8], kaw[8];
    load8f(mu + c8, mur); load8f(mu + 512 + c8, muk); load8f(mu + 1024 + c8, muv);
    load8f(a.in[9] + (size_t)e * 512 + c8, w0); load8f(a.in[11] + (size_t)e * 512 + c8, a0);
    load8f(a.in[14] + (size_t)e * 512 + c8, kkw); load8f(a.in[15] + (size_t)e * 512 + c8, kaw);
    const float* aup = a.in[19] + (size_t)e * 16 * 256; const f32x4 ab = *(const f32x4*)(a.in[20] + (size_t)e * 256 + 4 * lane);
    for (int m = gw; m < MT; m += ngw) {
        const bf16* pr = PA + (size_t)m * APROJ;
        float r[8], k[8], v[8], pq[8];
        unpack8(*(const v4u*)(pr + c8), r); unpack8(*(const v4u*)(pr + 512 + c8), k); unpack8(*(const v4u*)(pr + 1024 + c8), v);
        const int t = m < MP ? (m & (TPR - 1)) : ((m - MP) & (TSM - 1));
        if (t > 0) {
            unpack8(*(const v4u*)(pr - APROJ + c8), pq);
#pragma unroll
            for (int i = 0; i < 8; ++i) r[i] += (pq[i] - r[i]) * mur[i];
            unpack8(*(const v4u*)(pr - APROJ + 512 + c8), pq);
#pragma unroll
            for (int i = 0; i < 8; ++i) k[i] += (pq[i] - k[i]) * muk[i];
            unpack8(*(const v4u*)(pr - APROJ + 1024 + c8), pq);
#pragma unroll
            for (int i = 0; i < 8; ++i) v[i] += (pq[i] - v[i]) * muv[i];
        } else if (m < MP) {
#pragma unroll
            for (int i = 0; i < 8; ++i) { r[i] -= r[i] * mur[i]; k[i] -= k[i] * muk[i]; v[i] -= v[i] * muv[i]; }
        } else {
            const float* s0 = shift0 + (size_t)((m - MP) >> 6) * APROJ;
            load8f(s0 + c8, pq);
#pragma unroll
            for (int i = 0; i < 8; ++i) r[i] += (pq[i] - r[i]) * mur[i];
            load8f(s0 + 512 + c8, pq);
#pragma unroll
            for (int i = 0; i < 8; ++i) k[i] += (pq[i] - k[i]) * muk[i];
            load8f(s0 + 1024 + c8, pq);
#pragma unroll
            for (int i = 0; i < 8; ++i) v[i] += (pq[i] - v[i]) * muv[i];
        }
        float lw[8], la[8], u[8], av[8], kk[8], km[8], ka[8];
        unpack8(*(const v4u*)(Lw + (size_t)m * 512 + c8), lw); unpack8(*(const v4u*)(La + (size_t)m * 512 + c8), la);
        float ss = 0.f;
#pragma unroll
        for (int i = 0; i < 8; ++i) {
            const float w = -softplus_f(-(w0[i] + lw[i])) - 0.5f;
            u[i] = 1.0f - __expf(-__expf(w));
            av[i] = sigmoid_f(a0[i] + la[i]);
            kk[i] = k[i] * kkw[i]; ss += kk[i] * kk[i];
            km[i] = k[i] * (1.0f + (av[i] - 1.0f) * kaw[i]);
        }
        ss += __shfl_xor(ss, 1); ss += __shfl_xor(ss, 2); ss += __shfl_xor(ss, 4);
        const float rn = rsqrtf(ss + 1e-12f);
#pragma unroll
        for (int i = 0; i < 8; ++i) { kk[i] *= rn; ka[i] = kk[i] * av[i]; }
        bf16* sa = SA + ((size_t)m * 8 + h) * 256 + (lane & 7) * 8; bf16* sb = SB + ((size_t)m * 8 + h) * 128 + (lane & 7) * 8;
        *(v4u*)(sa) = pack8(r); *(v4u*)(sa + 64) = pack8(u); *(v4u*)(sa + 128) = pack8(km); *(v4u*)(sa + 192) = pack8(v);
        *(v4u*)(sb) = pack8(kk); *(v4u*)(sb + 64) = pack8(ka);
        bf16* pb = PB + (size_t)m * APROJ + 1536;
        float xa[16]; unpack8(*(const v4u*)(pb), xa); unpack8(*(const v4u*)(pb + 8), xa + 8);
        f32x4 acc = ab;
#pragma unroll
        for (int i = 0; i < 16; ++i) { const f32x4 wv = *(const f32x4*)(aup + i * 256 + 4 * lane); acc += xa[i] * wv; }
        float ug[4];
#pragma unroll
        for (int i = 0; i < 4; ++i) ug[i] = 1.0f - __expf(-softplus_f(-acc[i]) * (1.0f / 16.0f));
        v2u o; o.x = cvt_pk_bf16(ug[0], ug[1]); o.y = cvt_pk_bf16(ug[2], ug[3]);
        *(v2u*)(pb + 4 * lane) = o;
    }
}
struct PostRaw { v4u o, r, km, v, g, og, rg; };
__device__ __forceinline__ void post_phase(const Args& a, int e) {
    const int tid = tid_opaque(), lane = tid & 63, wave = tid >> 6;
    const int gw = blockIdx.x * NWAVES + wave, ngw = gridDim.x * NWAVES;
    bf16* Y = (bf16*)(a.ws + OFF_R1); const bf16* G = (const bf16*)(a.ws + OFF_G);
    const bf16* PB = (const bf16*)(a.ws + OFF_BIG) + (size_t)MT * APROJ; const bf16* SA = (const bf16*)a.out;
    const int c8 = 8 * lane, h = lane >> 3;
    float lnw[8], lnb[8], rk[8], nw[8];
    load8f(a.in[17] + (size_t)e * 512 + c8, lnw); load8f(a.in[18] + (size_t)e * 512 + c8, lnb); load8f(a.in[16] + (size_t)e * 512 + c8, rk);
    load8f(a.in[21] + (size_t)e * 128 + (lane & 15) * 8, nw);
    for (int mb = gw; mb < MT; mb += 2 * ngw) {
        PostRaw raw[2];
#pragma unroll
        for (int j = 0; j < 2; ++j) { const int m_ = mb + j * ngw; const size_t m = m_ < MT ? m_ : mb;
            const bf16* sa = SA + (m * 8 + h) * 256 + (lane & 7) * 8;
            raw[j].o = *(const v4u*)(Y + m * 1024 + c8); raw[j].r = *(const v4u*)(sa); raw[j].km = *(const v4u*)(sa + 128); raw[j].v = *(const v4u*)(sa + 192);
            raw[j].g = *(const v4u*)(G + m * 512 + c8); raw[j].og = *(const v4u*)(Y + m * 1024 + 512 + c8); raw[j].rg = *(const v4u*)(PB + m * APROJ + 1024 + c8); }
#pragma unroll
        for (int j = 0; j < 2; ++j) {
            const int m = mb + j * ngw;
            float o[8], r[8], km[8], v[8], g[8];
            unpack8(raw[j].o, o); unpack8(raw[j].r, r); unpack8(raw[j].km, km); unpack8(raw[j].v, v); unpack8(raw[j].g, g);
            float s = 0.f, bn = 0.f;
#pragma unroll
            for (int i = 0; i < 8; ++i) { s += o[i]; bn += r[i] * km[i] * rk[i]; }
            s += __shfl_xor(s, 1); s += __shfl_xor(s, 2); s += __shfl_xor(s, 4);
            bn += __shfl_xor(bn, 1); bn += __shfl_xor(bn, 2); bn += __shfl_xor(bn, 4);
            const float mean = s * (1.0f / 64.0f); float q = 0.f;
#pragma unroll
            for (int i = 0; i < 8; ++i) { o[i] -= mean; q += o[i] * o[i]; }
            q += __shfl_xor(q, 1); q += __shfl_xor(q, 2); q += __shfl_xor(q, 4);
            const float rstd = rsqrtf(q * (1.0f / 64.0f) + A_NORM_EPS);
#pragma unroll
            for (int i = 0; i < 8; ++i) o[i] = (o[i] * rstd * lnw[i] + lnb[i] + bn * v[i]) * g[i];
            float og[8], rg[8];
            unpack8(raw[j].og, og); unpack8(raw[j].rg, rg);
            float ms = 0.f;
#pragma unroll
            for (int i = 0; i < 8; ++i) ms += og[i] * og[i];
            ms += __shfl_xor(ms, 1); ms += __shfl_xor(ms, 2); ms += __shfl_xor(ms, 4); ms += __shfl_xor(ms, 8);
            const float rr = rsqrtf(ms * (1.0f / 128.0f) + LN_EPS);
#pragma unroll
            for (int i = 0; i < 8; ++i) og[i] = og[i] * rr * nw[i] * (rg[i] * sigmoid_f(rg[i]));
            if (m < MT) { *(v4u*)(Y + (size_t)m * 1024 + c8) = pack8(o); *(v4u*)(Y + (size_t)m * 1024 + 512 + c8) = pack8(og); }
        }
    }
}
__device__ __forceinline__ void ln_row_out(float* x0, float* x1, const float* w0, const float* w1, const float* b0, const float* b1, bf16* XB, float* fout, int m, int lane) {
    float s = 0.f;
#pragma unroll
    for (int i = 0; i < 8; ++i) s += x0[i] + x1[i];
    const float mean = wave_sum(s) * (1.0f / 1024.0f); float q = 0.f;
#pragma unroll
    for (int i = 0; i < 8; ++i) { x0[i] -= mean; x1[i] -= mean; q += x0[i] * x0[i] + x1[i] * x1[i]; }
    const float rstd = rsqrtf(wave_sum(q) * (1.0f / 1024.0f) + LN_EPS);
#pragma unroll
    for (int i = 0; i < 8; ++i) { x0[i] = x0[i] * rstd * w0[i] + b0[i]; x1[i] = x1[i] * rstd * w1[i] + b1[i]; }
    if (fout) {
        float* fo = fout + (size_t)m * 1024 + 8 * lane;
        *(f32x4*)(fo) = (f32x4){x0[0], x0[1], x0[2], x0[3]}; *(f32x4*)(fo + 4) = (f32x4){x0[4], x0[5], x0[6], x0[7]};
        *(f32x4*)(fo + 512) = (f32x4){x1[0], x1[1], x1[2], x1[3]}; *(f32x4*)(fo + 516) = (f32x4){x1[4], x1[5], x1[6], x1[7]};
    } else {
        *(v4u*)(XB + (size_t)m * 1024 + 8 * lane) = pack8(x0); *(v4u*)(XB + (size_t)m * 1024 + 512 + 8 * lane) = pack8(x1);
    }
}
__device__ __forceinline__ void ln_phase(const Args& a, const float* w, const float* b, float* fout, int ns) {
    const int tid = tid_opaque(), lane = tid & 63, wave = tid >> 6;
    const int gw = blockIdx.x * NWAVES + wave, ngw = gridDim.x * NWAVES;
    const bf16* Z = (const bf16*)(a.ws + OFF_Z); bf16* XB = (bf16*)(a.ws + OFF_XB);
    float w0[8], w1[8], b0[8], b1[8];
    load8f(w + 8 * lane, w0); load8f(w + 512 + 8 * lane, w1); load8f(b + 8 * lane, b0); load8f(b + 512 + 8 * lane, b1);
    for (int mb = gw; mb < MP; mb += 4 * ngw) {
        v4u r0[4], r1[4];
#pragma unroll
        for (int j = 0; j < 4; ++j) { const int m = mb + j * ngw; const int mc = m < MP ? m : mb;
            r0[j] = *(const v4u*)(Z + (size_t)mc * 1024 + 8 * lane); r1[j] = *(const v4u*)(Z + (size_t)mc * 1024 + 512 + 8 * lane); }
#pragma unroll
        for (int j = 0; j < 4; ++j) {
            const int m = mb + j * ngw;
            float x0[8], x1[8];
            unpack8(r0[j], x0); unpack8(r1[j], x1);
            if (m < MP) ln_row_out(x0, x1, w0, w1, b0, b1, XB, fout, m, lane);
        }
    }
#pragma unroll 1
    for (int m = MP + gw; m < MT; m += ngw) {
        float x0[8], x1[8];
        unpack8(*(const v4u*)(XB + (size_t)m * 1024 + 8 * lane), x0); unpack8(*(const v4u*)(XB + (size_t)m * 1024 + 512 + 8 * lane), x1);
#pragma unroll
        for (int i = 0; i < 8; ++i) { x0[i] *= DN_ALPHA; x1[i] *= DN_ALPHA; }
        const float* zs = (const float*)(a.ws + OFF_G) + (size_t)(m - MP) * 1024 + 8 * lane;
#pragma unroll 1
        for (int sl = 0; sl < ns; ++sl) { float t0[8], t1[8]; load8f(zs + (size_t)sl * 1024 * 1024, t0); load8f(zs + (size_t)sl * 1024 * 1024 + 512, t1);
#pragma unroll
            for (int i = 0; i < 8; ++i) { x0[i] += t0[i]; x1[i] += t1[i]; } }
        ln_row_out(x0, x1, w0, w1, b0, b1, XB, fout, m, lane);
    }
}

#define TR_DPP(x, ctrl) __builtin_bit_cast(float, __builtin_amdgcn_update_dpp(0, __builtin_bit_cast(int, x), ctrl, 0xf, 0xf, false))
__device__ __forceinline__ float transpose_reduce16(const float* p, int g) {
    const bool h1 = (g & 8) != 0, h2 = (g & 4) != 0, h3 = (g & 2) != 0, h4 = (g & 1) != 0;
    float q[8], r[4], t[2];
#pragma unroll
    for (int i = 0; i < 8; ++i) { const float keep = h1 ? p[i + 8] : p[i], send = h1 ? p[i] : p[i + 8]; q[i] = keep + TR_DPP(send, 0x140); }
#pragma unroll
    for (int i = 0; i < 4; ++i) { const float keep = h2 ? q[i + 4] : q[i], send = h2 ? q[i] : q[i + 4]; r[i] = keep + TR_DPP(send, 0x141); }
#pragma unroll
    for (int i = 0; i < 2; ++i) { const float keep = h3 ? r[i + 2] : r[i], send = h3 ? r[i] : r[i + 2]; t[i] = keep + TR_DPP(send, 0x4E); }
    const float keep = h4 ? t[1] : t[0], send = h4 ? t[0] : t[1];
    return keep + TR_DPP(send, 0xB1);
}
constexpr int TC = 16;
constexpr int SCW = 384, SCG = 320;
__device__ __forceinline__ void st8n(LAS float* d, const v4u w) {
    *(LAS f32x4*)(d) = (f32x4){bf_lo(w.x), bf_hi(w.x), bf_lo(w.y), bf_hi(w.y)};
    *(LAS f32x4*)(d + 4) = (f32x4){bf_lo(w.z), bf_hi(w.z), bf_lo(w.w), bf_hi(w.w)};
}
__device__ __forceinline__ void st8(LAS float* d, const v4u w, float sc) {
    *(LAS f32x4*)(d) = (f32x4){bf_lo(w.x) * sc, bf_hi(w.x) * sc, bf_lo(w.y) * sc, bf_hi(w.y) * sc};
    *(LAS f32x4*)(d + 4) = (f32x4){bf_lo(w.z) * sc, bf_hi(w.z) * sc, bf_lo(w.w) * sc, bf_hi(w.w) * sc};
}
typedef float f32x2 __attribute__((ext_vector_type(2)));
#define LO2(v4) (__builtin_shufflevector(v4, v4, 0, 1))
#define HI2(v4) (__builtin_shufflevector(v4, v4, 2, 3))
__device__ __forceinline__ f32x2 fma2(f32x2 a, f32x2 b, f32x2 c) { return __builtin_elementwise_fma(a, b, c); }
__device__ __forceinline__ float rowsum16(float x) {
    x += __builtin_bit_cast(float, __builtin_amdgcn_update_dpp(0, __builtin_bit_cast(int, x), 0x128, 0xf, 0xf, false));
    x += __builtin_bit_cast(float, __builtin_amdgcn_update_dpp(0, __builtin_bit_cast(int, x), 0x124, 0xf, 0xf, false));
    x += __builtin_bit_cast(float, __builtin_amdgcn_update_dpp(0, __builtin_bit_cast(int, x), 0x122, 0xf, 0xf, false));
    x += __builtin_bit_cast(float, __builtin_amdgcn_update_dpp(0, __builtin_bit_cast(int, x), 0x121, 0xf, 0xf, false));
    return x;
}
struct WkvIn { f32x4 r, u, km, kk, ka; float v; };
struct GlaIn { f32x4 q, k, u; float v; };
__device__ __forceinline__ void scan_phase(const Args& a, int e, LAS unsigned char* lds) {
    const int tid = tid_opaque(), lane = tid & 63, wave = tid >> 6;
    const bool isW = wave < 4; const int ltid = tid & 255, lw = wave & 3;
    const int g = lane & 15, rl = lw * 4 + (lane >> 4);
    const bf16* SA = (const bf16*)a.out; const bf16* SB = (const bf16*)(a.ws + OFF_Z);
    const bf16* PB = (const bf16*)(a.ws + OFF_BIG) + (size_t)MT * APROJ;
    bf16* O1 = (bf16*)(a.ws + OFF_R1);
    LAS float* bufW = (LAS float*)lds;
    LAS float* bufG = (LAS float*)(lds + 2 * TC * SCW * 4);
    int ps[3], pp[3];
#pragma unroll
    for (int j = 0; j < 3; ++j) { const int p = ltid + 256 * j; if (isW) { ps[j] = p / 48; pp[j] = p - ps[j] * 48; } else { ps[j] = p / 40; pp[j] = p - ps[j] * 40; } }
    const bool v2ok = isW || (ltid + 512 < 640);
#pragma unroll 1
    for (int it = xcd_vcu(); it < 768; it += gridDim.x) {
        const bool samp = it >= 256; const int wi = samp ? it - 256 : it;
        const int b = wi >> 5; const int T = samp ? TSM : TPR; const size_t row0 = samp ? (size_t)MP + b * TSM : (size_t)b * TPR;
        const int nb = samp ? 16 : 8;
        int h, sub;
        if (isW) { h = (wi >> 2) & 7; sub = wi & 3; } else { h = (wi >> 3) & 3; sub = wi & 7; }
        const int vrow = sub * 16 + rl;
        f32x2 P0 = {0.f, 0.f}, P1 = {0.f, 0.f};
        if (samp) {
            if (isW) { const f32x4 S = *(const f32x4*)(a.in[2] + ((((size_t)e * 16 + b) * 8 + h) * 64 + vrow) * 64 + 4 * g); P0 = LO2(S); P1 = HI2(S); }
            else { const float* s0 = a.in[4] + (((size_t)e * 16 + b) * 4 + h) * 8192 + vrow;
                P0 = (f32x2){s0[(4 * g + 0) * 128], s0[(4 * g + 1) * 128]}; P1 = (f32x2){s0[(4 * g + 2) * 128], s0[(4 * g + 3) * 128]}; }
        }
        const int nc = T / TC;
        bf16* obase = isW ? O1 + (row0 + g) * 1024 + h * 64 + vrow : O1 + (row0 + g) * 1024 + 512 + h * 128 + vrow;
        v4u pre[3];
        unsigned so[3];
#pragma unroll
        for (int j = 0; j < 3; ++j) { const unsigned row = (unsigned)row0 + ps[j];
            if (isW) so[j] = pp[j] < 32 ? (row * 8 + h) * 256 + pp[j] * 8 : (row * 8 + h) * 128 + (pp[j] - 32) * 8;
            else so[j] = pp[j] < 32 ? row * APROJ + h * 256 + pp[j] * 8 : row * APROJ + 1536 + h * 64 + (pp[j] - 32) * 8; }
#define SCAN_ISSUE(t0) do { _Pragma("unroll") for (int j = 0; j < 3; ++j) { const bf16* src = (isW ? (pp[j] < 32 ? SA : SB) : PB) + so[j]; \
            if (j < 2 || v2ok) pre[j] = *(const v4u*)src; so[j] += isW ? (pp[j] < 32 ? TC * 2048 : TC * 1024) : TC * APROJ; } } while (0)
#define SCAN_COMMIT(bi) do { _Pragma("unroll") for (int j = 0; j < 3; ++j) { if (j < 2 || v2ok) { \
            if (isW) st8n(bufW + ((bi) * TC + ps[j]) * SCW + pp[j] * 8, pre[j]); else st8n(bufG + ((bi) * TC + ps[j]) * SCG + pp[j] * 8, pre[j]); } } } while (0)
        __syncthreads();
        SCAN_ISSUE(0); SCAN_COMMIT(0);
        __syncthreads();
#pragma unroll 1
        for (int c = 0; c < nc; ++c) {
            const int bi = c & 1;
            if (c + 1 < nc) SCAN_ISSUE((c + 1) * TC);
            float oacc = 0.f; float op[16];
            if (isW) {
                const LAS float* bw = bufW + bi * TC * SCW + 4 * g; const LAS float* bv = bufW + bi * TC * SCW + 192 + vrow;
#define WKV_LOAD(d, s) do { const LAS float* p_ = bw + (s) * SCW; d.r = *(const LAS f32x4*)(p_); d.u = *(const LAS f32x4*)(p_ + 64); d.km = *(const LAS f32x4*)(p_ + 128); \
                    d.kk = *(const LAS f32x4*)(p_ + 256); d.ka = *(const LAS f32x4*)(p_ + 320); d.v = bv[(s) * SCW]; } while (0)
                WkvIn in[3];
                WKV_LOAD(in[0], 0); WKV_LOAD(in[1], 1);
#pragma unroll
                for (int s = 0; s < TC; ++s) {
                    if (s + 2 < TC) WKV_LOAD(in[(s + 2) % 3], s + 2);
                    __builtin_amdgcn_sched_barrier(0);
                    const WkvIn& x = in[s % 3];
                    const f32x2 vv = {x.v, x.v};
                    const f32x2 s2 = fma2(P1, HI2(x.kk), P0 * LO2(x.kk));
                    const f32x2 T0 = fma2(vv, LO2(x.km), fma2(-LO2(x.u), P0, P0)), T1 = fma2(vv, HI2(x.km), fma2(-HI2(x.u), P1, P1));
                    const float sa = rowsum16(s2.x + s2.y);
                    const f32x2 ns = {-sa, -sa};
                    P0 = fma2(ns, LO2(x.ka), T0); P1 = fma2(ns, HI2(x.ka), T1);
                    const f32x2 o2 = fma2(P1, HI2(x.r), P0 * LO2(x.r));
                    op[s] = o2.x + o2.y;
                }
                oacc = transpose_reduce16(op, g);
#undef WKV_LOAD
            } else {
                const LAS float* bg = bufG + bi * TC * SCG + 4 * g; const LAS float* bv = bufG + bi * TC * SCG + 128 + vrow;
#define GLA_LOAD(d, s) do { const LAS float* p_ = bg + (s) * SCG; d.q = *(const LAS f32x4*)(p_); d.k = *(const LAS f32x4*)(p_ + 64); d.u = *(const LAS f32x4*)(p_ + 256); d.v = bv[(s) * SCG]; } while (0)
                GlaIn in[3];
                GLA_LOAD(in[0], 0); GLA_LOAD(in[1], 1);
#pragma unroll
                for (int s = 0; s < TC; ++s) {
                    if (s + 2 < TC) GLA_LOAD(in[(s + 2) % 3], s + 2);
                    __builtin_amdgcn_sched_barrier(0);
                    const GlaIn& x = in[s % 3];
                    const f32x2 vv = {x.v, x.v};
                    P0 = fma2(vv, LO2(x.k), fma2(-LO2(x.u), P0, P0)); P1 = fma2(vv, HI2(x.k), fma2(-HI2(x.u), P1, P1));
                    const f32x2 o2 = fma2(P1, HI2(x.q), P0 * LO2(x.q));
                    op[s] = o2.x + o2.y;
                }
                oacc = transpose_reduce16(op, g);
#undef GLA_LOAD
            }
            obase[(size_t)c * TC * 1024] = (bf16)(cvt_pk_bf16(isW ? oacc : oacc * 0.125f, 0.f) & 0xffffu);
            if (c + 1 < nc) SCAN_COMMIT(bi ^ 1);
            __syncthreads();
        }
#undef SCAN_ISSUE
#undef SCAN_COMMIT
        if (isW) { float* so = a.out + (samp ? O_SWKV : O_PWKV) + ((((size_t)e * nb + b) * 8 + h) * 64 + vrow) * 64 + 4 * g; *(f32x4*)so = (f32x4){P0.x, P0.y, P1.x, P1.y}; }
        else { float* so = a.out + (samp ? O_SGLA : O_PGLA) + (((size_t)e * nb + b) * 4 + h) * 8192 + vrow;
            so[(4 * g + 0) * 128] = P0.x; so[(4 * g + 1) * 128] = P0.y; so[(4 * g + 2) * 128] = P1.x; so[(4 * g + 3) * 128] = P1.y; }
    }
    const bf16* PA = (const bf16*)(a.ws + OFF_BIG);
    for (int idx = blockIdx.x * NTHREADS + tid; idx < 24 * APROJ; idx += gridDim.x * NTHREADS) {
        const int bb = idx / APROJ, c = idx - bb * APROJ;
        if (bb < 8) a.out[O_PSHIFT + ((size_t)e * 8 + bb) * APROJ + c] = bf_lo((unsigned)PA[((size_t)bb * TPR + TPR - 1) * APROJ + c]);
        else a.out[O_SSHIFT + ((size_t)e * 16 + (bb - 8)) * APROJ + c] = bf_lo((unsigned)PA[((size_t)MP + (bb - 8) * TSM + TSM - 1) * APROJ + c]);
    }
}

constexpr int KEXT = 8192, LDV = MT + KEXT;
constexpr size_t BIG_K = (size_t)MT * 1024, BIG_VT = (size_t)(2 * MT + KEXT) * 1024;
__device__ __forceinline__ bf16x8 ld_frag(const bf16* p) { return __builtin_bit_cast(bf16x8, *(const v4u*)p); }
__device__ __forceinline__ void cache_convert(const Args& a, int o) {
    const int tid = tid_opaque();
    const int gt = blockIdx.x * NTHREADS + tid, ngt = gridDim.x * NTHREADS;
    bf16* Kb = (bf16*)(a.ws + OFF_BIG) + BIG_K; bf16* Vt = (bf16*)(a.ws + OFF_BIG) + BIG_VT;
    const float* ck = a.in[5] + (size_t)o * 16 * 16 * 512 * 64; const float* cv = a.in[6] + (size_t)o * 16 * 16 * 512 * 64;
    for (int idx = gt; idx < 16 * 16 * 512 * 8; idx += ngt) {
        const int d8 = idx & 7, key = (idx >> 3) & 511, h = (idx >> 12) & 15, b = idx >> 16;
        float f[8]; load8f(ck + (size_t)idx * 8, f);
        *(v4u*)(Kb + ((size_t)MT + b * 512 + key) * 1024 + h * 64 + d8 * 8) = pack8(f);
    }
    for (int idx = gt; idx < 16 * 16 * 64 * 64; idx += ngt) {
        const int d = idx & 63, k8 = (idx >> 6) & 63, h = (idx >> 12) & 15, b = idx >> 16;
        const float* src = cv + (((size_t)b * 16 + h) * 512 + k8 * 8) * 64 + d; float f[8];
#pragma unroll
        for (int j = 0; j < 8; ++j) f[j] = src[j * 64];
        *(v4u*)(Vt + (size_t)(h * 64 + d) * LDV + MT + b * 512 + k8 * 8) = pack8(f);
    }
}
__device__ __forceinline__ void attn_phase(const Args& a, int o, LAS unsigned char* lds) {
    const int tid = tid_opaque(), lane = tid & 63, wave = tid >> 6;
    const int gw = blockIdx.x * NWAVES + wave, ngw = gridDim.x * NWAVES;
    const bf16* Q = (const bf16*)(a.ws + OFF_BIG); const bf16* Kb = Q + BIG_K; const bf16* Vt = Q + BIG_VT;
    bf16* O = (bf16*)(a.ws + OFF_R1);
    LAS float* bias = (LAS float*)lds;
    constexpr int KVP = 72;
    LAS bf16* KT = (LAS bf16*)(lds + 16512);
    LAS bf16* VT = KT + 2 * 64 * KVP;
    for (int i = tid; i < 16 * 257; i += NTHREADS) bias[i] = a.in[24][(size_t)o * 16 * 257 + i] * 1.4426950408889634f;
    __syncthreads();
    const int i16 = lane & 15, g = lane >> 4;
    const int keyoff = 8 * (i16 >> 2) + (i16 & 3);
    {
        const int wu = __builtin_amdgcn_readfirstlane(wave);
        const int srow = tid >> 3, sseg = (tid & 7) * 8;
#pragma unroll 1
        for (int unit = xcd_vcu(); unit < 4096; unit += gridDim.x) {
            const int b = unit >> 9, h = (unit >> 5) & 15, c0 = (unit & 31) * 4;
            const int c = c0 + (wu >> 1), half = wu & 1;
            const size_t qrow0 = (size_t)b * TPR + c * 64 + half * 32;
            const int qpos0 = c * 64 + half * 32;
            const int kc_lo = c0 >= 8 ? c0 - 8 : 0, kc_hi = c0 + 3, my_lo = c >= 8 ? c - 8 : 0;
            const LAS float* bh = bias + h * 257 + 128;
            const float bfar = bh[128];
            bf16x8 qf[2][2];
#pragma unroll
            for (int qt = 0; qt < 2; ++qt)
#pragma unroll
                for (int kk = 0; kk < 2; ++kk) qf[qt][kk] = ld_frag(Q + (qrow0 + 16 * qt + i16) * 1024 + h * 64 + 32 * kk + 8 * g);
            f32x4 ot[4][2];
#pragma unroll
            for (int dt = 0; dt < 4; ++dt) { ot[dt][0] = (f32x4){0.f, 0.f, 0.f, 0.f}; ot[dt][1] = (f32x4){0.f, 0.f, 0.f, 0.f}; }
            float mrun[2] = {-1e30f, -1e30f}, lrun[2] = {0.f, 0.f};
            const bf16* kg_ = Kb + ((size_t)b * TPR + srow) * 1024 + h * 64 + sseg;
            const bf16* vg_ = Vt + (size_t)(h * 64 + srow) * LDV + (size_t)b * TPR + sseg;
            v4u kreg = *(const v4u*)(kg_ + (size_t)(64 * kc_lo) * 1024), vreg = *(const v4u*)(vg_ + 64 * kc_lo);
            *(LAS v4u*)(KT + srow * KVP + sseg) = kreg; *(LAS v4u*)(VT + srow * KVP + sseg) = vreg;
            kreg = *(const v4u*)(kg_ + (size_t)(64 * (kc_lo + 1)) * 1024); vreg = *(const v4u*)(vg_ + 64 * (kc_lo + 1));
            v4u kreg2 = kreg, vreg2 = vreg;
            __syncthreads();
#pragma unroll 1
            for (int kc = kc_lo; kc <= kc_hi; ++kc) {
                const int buf = (kc - kc_lo) & 1;
                if (kc + 2 <= kc_hi) { kreg2 = *(const v4u*)(kg_ + (size_t)(64 * (kc + 2)) * 1024); vreg2 = *(const v4u*)(vg_ + 64 * (kc + 2)); }
                if (kc >= my_lo && kc <= c) {
                    const int kpos0 = 64 * kc;
                    const LAS bf16* kt = KT + buf * 64 * KVP + keyoff * KVP + 8 * g; const LAS bf16* vt = VT + buf * 64 * KVP + i16 * KVP + 8 * g;
                    f32x4 st[4][2];
#pragma unroll
                    for (int t4 = 0; t4 < 4; ++t4) {
                        const LAS bf16* p = kt + (32 * (t4 >> 1) + 4 * (t4 & 1)) * KVP;
                        const bf16x8 k0 = *(const LAS bf16x8*)p, k1 = *(const LAS bf16x8*)(p + 32);
#pragma unroll
                        for (int qt = 0; qt < 2; ++qt) {
                            f32x4 acc = {0.f, 0.f, 0.f, 0.f};
                            acc = __builtin_amdgcn_mfma_f32_16x16x32_bf16(k0, qf[qt][0], acc, 0, 0, 0);
                            acc = __builtin_amdgcn_mfma_f32_16x16x32_bf16(k1, qf[qt][1], acc, 0, 0, 0);
                            st[t4][qt] = acc;
                        }
                    }
                    const bool far = qpos0 - (kpos0 + 63) >= 128;
                    bf16x8 pf[2][2];
#pragma unroll
                    for (int qt = 0; qt < 2; ++qt) {
                        const int qpos = qpos0 + 16 * qt + i16;
                        float mx = -1e30f;
                        float boff = 0.f;
                        if (far) {
#pragma unroll
                            for (int t4 = 0; t4 < 4; ++t4)
#pragma unroll
                                for (int j = 0; j < 4; ++j) mx = fmaxf(mx, st[t4][qt][j]);
                            mx += bfar; boff = bfar;
                        } else {
#pragma unroll
                            for (int t4 = 0; t4 < 4; ++t4)
#pragma unroll
                                for (int j = 0; j < 4; ++j) {
                                    int rel = qpos - (kpos0 + 32 * (t4 >> 1) + 8 * g + 4 * (t4 & 1) + j); rel = rel > 128 ? 128 : (rel < -128 ? -128 : rel);
                                    const float sv = st[t4][qt][j] + bh[rel]; st[t4][qt][j] = sv; mx = fmaxf(mx, sv);
                                }
                        }
                        mx = fmaxf(mx, __shfl_xor(mx, 16)); mx = fmaxf(mx, __shfl_xor(mx, 32));
                        const float mnew = fmaxf(mrun[qt], mx), corr = __builtin_amdgcn_exp2f(mrun[qt] - mnew), msub = mnew - boff; mrun[qt] = mnew;
                        float psum = 0.f;
#pragma unroll
                        for (int sb = 0; sb < 2; ++sb) {
                            float p[8];
#pragma unroll
                            for (int T = 0; T < 2; ++T)
#pragma unroll
                                for (int j = 0; j < 4; ++j) { p[4 * T + j] = __builtin_amdgcn_exp2f(st[2 * sb + T][qt][j] - msub); psum += p[4 * T + j]; }
                            pf[sb][qt] = __builtin_bit_cast(bf16x8, pack8(p));
                        }
                        lrun[qt] = lrun[qt] * corr + psum;
#pragma unroll
                        for (int dt = 0; dt < 4; ++dt) ot[dt][qt] *= corr;
                    }
#pragma unroll
                    for (int sb = 0; sb < 2; ++sb)
#pragma unroll
                        for (int dt = 0; dt < 4; ++dt) {
                            const bf16x8 vf = *(const LAS bf16x8*)(vt + 16 * dt * KVP + 32 * sb);
#pragma unroll
                            for (int qt = 0; qt < 2; ++qt) ot[dt][qt] = __builtin_amdgcn_mfma_f32_16x16x32_bf16(vf, pf[sb][qt], ot[dt][qt], 0, 0, 0);
                        }
                }
                if (kc < kc_hi) { *(LAS v4u*)(KT + (buf ^ 1) * 64 * KVP + srow * KVP + sseg) = kreg; *(LAS v4u*)(VT + (buf ^ 1) * 64 * KVP + srow * KVP + sseg) = vreg; }
                kreg = kreg2; vreg = vreg2;
                __syncthreads();
            }
#pragma unroll
            for (int qt = 0; qt < 2; ++qt) {
                float l = lrun[qt]; l += __shfl_xor(l, 16); l += __shfl_xor(l, 32);
                const float inv = 1.0f / l;
                bf16* op = O + (qrow0 + 16 * qt + i16) * 1024 + h * 64 + 4 * g;
#pragma unroll
                for (int dt = 0; dt < 4; ++dt) { const f32x4 v = ot[dt][qt] * inv; v2u w; w.x = cvt_pk_bf16(v[0], v[1]); w.y = cvt_pk_bf16(v[2], v[3]); *(v2u*)(op + 16 * dt) = w; }
            }
        }
    }
#pragma unroll 1
    for (int it = 32768 + gw; it < 32768 + 512; it += ngw) {
        const bool samp = it >= 32768;
        int b, c, h, half;
        if (!samp) { b = it >> 12; c = (it >> 5) & 127; h = (it >> 1) & 15; half = it & 1; }
        else { const int r = it - 32768; b = r >> 5; c = 8; h = (r >> 1) & 15; half = r & 1; }
        const size_t qrow0 = samp ? (size_t)MP + b * 64 + half * 32 : (size_t)b * TPR + c * 64 + half * 32;
        const int qpos0 = c * 64 + half * 32;
        const int kstart = c >= 8 ? c * 64 - 512 : 0, nkb = (c * 64 + 64 - kstart) >> 6;
        const size_t kbase = samp ? (size_t)MT + b * 512 : (size_t)b * TPR + kstart;
        const size_t knew = (size_t)MP + b * 64;
        const LAS float* bh = bias + h * 257 + 128;
        const float bfar = bh[128];
        bf16x8 qf[2][2];
#pragma unroll
        for (int qt = 0; qt < 2; ++qt)
#pragma unroll
            for (int kk = 0; kk < 2; ++kk) qf[qt][kk] = ld_frag(Q + (qrow0 + 16 * qt + i16) * 1024 + h * 64 + 32 * kk + 8 * g);
        f32x4 ot[4][2];
#pragma unroll
        for (int dt = 0; dt < 4; ++dt) { ot[dt][0] = (f32x4){0.f, 0.f, 0.f, 0.f}; ot[dt][1] = (f32x4){0.f, 0.f, 0.f, 0.f}; }
        float mrun[2] = {-1e30f, -1e30f}, lrun[2] = {0.f, 0.f};
        bf16x8 kc[4][2], kn[4][2];
        {   const bf16* kp = Kb + (kbase + keyoff) * 1024 + h * 64 + 8 * g;
#pragma unroll
            for (int t4 = 0; t4 < 4; ++t4) { const bf16* p = kp + (size_t)(32 * (t4 >> 1) + 4 * (t4 & 1)) * 1024; kc[t4][0] = ld_frag(p); kc[t4][1] = ld_frag(p + 32); } }
#pragma unroll 1
        for (int kb = 0; kb < nkb; ++kb) {
            const int kpos0 = kstart + 64 * kb;
            const size_t krow0 = (samp && kb == 8) ? knew : kbase + 64 * kb;
            bf16x8 vf[2][4];
            {   const bf16* vp = Vt + (size_t)(h * 64 + i16) * LDV + krow0 + 8 * g;
#pragma unroll
                for (int sb = 0; sb < 2; ++sb)
#pragma unroll
                    for (int dt = 0; dt < 4; ++dt) vf[sb][dt] = ld_frag(vp + (size_t)(16 * dt) * LDV + 32 * sb); }
            if (kb + 1 < nkb) {
                const size_t krow1 = (samp && kb + 1 == 8) ? knew : kbase + 64 * (kb + 1);
                const bf16* kp = Kb + (krow1 + keyoff) * 1024 + h * 64 + 8 * g;
#pragma unroll
                for (int t4 = 0; t4 < 4; ++t4) { const bf16* p = kp + (size_t)(32 * (t4 >> 1) + 4 * (t4 & 1)) * 1024; kn[t4][0] = ld_frag(p); kn[t4][1] = ld_frag(p + 32); }
            }
            f32x4 st[4][2];
#pragma unroll
            for (int t4 = 0; t4 < 4; ++t4)
#pragma unroll
                for (int qt = 0; qt < 2; ++qt) {
                    f32x4 acc = {0.f, 0.f, 0.f, 0.f};
                    acc = __builtin_amdgcn_mfma_f32_16x16x32_bf16(kc[t4][0], qf[qt][0], acc, 0, 0, 0);
                    acc = __builtin_amdgcn_mfma_f32_16x16x32_bf16(kc[t4][1], qf[qt][1], acc, 0, 0, 0);
                    st[t4][qt] = acc;
                }
            const bool far = qpos0 - (kpos0 + 63) >= 128;
            bf16x8 pf[2][2];
#pragma unroll
            for (int qt = 0; qt < 2; ++qt) {
                const int qpos = qpos0 + 16 * qt + i16;
                float mx = -1e30f;
                float boff = 0.f;
                if (far) {
#pragma unroll
                    for (int t4 = 0; t4 < 4; ++t4)
#pragma unroll
                        for (int j = 0; j < 4; ++j) mx = fmaxf(mx, st[t4][qt][j]);
                    mx += bfar; boff = bfar;
                } else {
#pragma unroll
                    for (int t4 = 0; t4 < 4; ++t4)
#pragma unroll
                        for (int j = 0; j < 4; ++j) {
                            int rel = qpos - (kpos0 + 32 * (t4 >> 1) + 8 * g + 4 * (t4 & 1) + j); rel = rel > 128 ? 128 : (rel < -128 ? -128 : rel);
                            const float s = st[t4][qt][j] + bh[rel]; st[t4][qt][j] = s; mx = fmaxf(mx, s);
                        }
                }
                mx = fmaxf(mx, __shfl_xor(mx, 16)); mx = fmaxf(mx, __shfl_xor(mx, 32));
                const float mnew = fmaxf(mrun[qt], mx), corr = __builtin_amdgcn_exp2f(mrun[qt] - mnew), msub = mnew - boff; mrun[qt] = mnew;
                float psum = 0.f;
#pragma unroll
                for (int sb = 0; sb < 2; ++sb) {
                    float p[8];
#pragma unroll
                    for (int T = 0; T < 2; ++T)
#pragma unroll
                        for (int j = 0; j < 4; ++j) { p[4 * T + j] = __builtin_amdgcn_exp2f(st[2 * sb + T][qt][j] - msub); psum += p[4 * T + j]; }
                    pf[sb][qt] = __builtin_bit_cast(bf16x8, pack8(p));
                }
                lrun[qt] = lrun[qt] * corr + psum;
#pragma unroll
                for (int dt = 0; dt < 4; ++dt) ot[dt][qt] *= corr;
            }
#pragma unroll
            for (int sb = 0; sb < 2; ++sb)
#pragma unroll
                for (int dt = 0; dt < 4; ++dt)
#pragma unroll
                    for (int qt = 0; qt < 2; ++qt) ot[dt][qt] = __builtin_amdgcn_mfma_f32_16x16x32_bf16(vf[sb][dt], pf[sb][qt], ot[dt][qt], 0, 0, 0);
#pragma unroll
            for (int t4 = 0; t4 < 4; ++t4) { kc[t4][0] = kn[t4][0]; kc[t4][1] = kn[t4][1]; }
        }
#pragma unroll
        for (int qt = 0; qt < 2; ++qt) {
            float l = lrun[qt]; l += __shfl_xor(l, 16); l += __shfl_xor(l, 32);
            const float inv = 1.0f / l;
            bf16* op = O + (qrow0 + 16 * qt + i16) * 1024 + h * 64 + 4 * g;
#pragma unroll
            for (int dt = 0; dt < 4; ++dt) { const f32x4 v = ot[dt][qt] * inv; v2u w; w.x = cvt_pk_bf16(v[0], v[1]); w.y = cvt_pk_bf16(v[2], v[3]); *(v2u*)(op + 16 * dt) = w; }
        }
    }
    const int gt = blockIdx.x * NTHREADS + tid, ngt = gridDim.x * NTHREADS;
    for (int idx = gt; idx < 8 * 16 * 512 * 8; idx += ngt) {
        const int d8 = idx & 7, r = (idx >> 3) & 511, h = (idx >> 12) & 15, b = idx >> 16;
        float f[8]; unpack8(*(const v4u*)(Kb + ((size_t)b * TPR + 7680 + r) * 1024 + h * 64 + d8 * 8), f);
        float* dst = a.out + O_PK + ((((size_t)o * 8 + b) * 16 + h) * 512 + r) * 64 + d8 * 8;
        *(f32x4*)dst = (f32x4){f[0], f[1], f[2], f[3]}; *(f32x4*)(dst + 4) = (f32x4){f[4], f[5], f[6], f[7]};
    }
    for (int idx = gt; idx < 8 * 16 * 64 * 64; idx += ngt) {
        const int r8 = idx & 63, d = (idx >> 6) & 63, h = (idx >> 12) & 15, b = idx >> 16;
        float f[8]; unpack8(*(const v4u*)(Vt + (size_t)(h * 64 + d) * LDV + (size_t)b * TPR + 7680 + r8 * 8), f);
        float* dst = a.out + O_PV + ((((size_t)o * 8 + b) * 16 + h) * 512 + r8 * 8) * 64 + d;
#pragma unroll
        for (int j = 0; j < 8; ++j) dst[j * 64] = f[j];
    }
    for (int idx = gt; idx < 16 * 16 * 64 * 8; idx += ngt) {
        const int d8 = idx & 7, t = (idx >> 3) & 63, h = (idx >> 9) & 15, b = idx >> 13;
        float f[8]; unpack8(*(const v4u*)(Kb + ((size_t)MP + b * 64 + t) * 1024 + h * 64 + d8 * 8), f);
        float* dst = a.out + O_SK + ((((size_t)o * 16 + b) * 16 + h) * 64 + t) * 64 + d8 * 8;
        *(f32x4*)dst = (f32x4){f[0], f[1], f[2], f[3]}; *(f32x4*)(dst + 4) = (f32x4){f[4], f[5], f[6], f[7]};
    }
    for (int idx = gt; idx < 16 * 16 * 64 * 8; idx += ngt) {
        const int t8 = idx & 7, d = (idx >> 3) & 63, h = (idx >> 9) & 15, b = idx >> 13;
        float f[8]; unpack8(*(const v4u*)(Vt + (size_t)(h * 64 + d) * LDV + (size_t)MP + b * 64 + t8 * 8), f);
        float* dst = a.out + O_SV + ((((size_t)o * 16 + b) * 16 + h) * 64 + t8 * 8) * 64 + d;
#pragma unroll
        for (int j = 0; j < 8; ++j) dst[j * 64] = f[j];
    }
}

#define XB_TMO      128
#define XB_XCNT(j)  (256  + 64 * (j))
#define XB_XSUB(j)  (1280 + 64 * (j))
#define XB_XGEN(j)  (2304 + 64 * (j))
#define XB_TOP      3328
#define XB_TOPGEN   3392
#define XCD_BAR_WORDS 3456
#define XB_SPIN_CAP (1u << 18)

__device__ __forceinline__ unsigned xb_ld(unsigned* p)              { return __hip_atomic_load(p, __ATOMIC_RELAXED, __HIP_MEMORY_SCOPE_AGENT); }
__device__ __forceinline__ unsigned xb_add(unsigned* p, unsigned v) { return __hip_atomic_fetch_add(p, v, __ATOMIC_RELAXED, __HIP_MEMORY_SCOPE_AGENT); }
__device__ __forceinline__ unsigned xb_xcc_id() { return (unsigned)__builtin_amdgcn_s_getreg((3 << 11) | 20) & 0xFu; }
#define XB_SPIN(cond, bar) do { unsigned _sp = 0; while (cond) { __builtin_amdgcn_s_sleep(1); \
    if ((++_sp & 255u) == 0u) { if (xb_ld(&(bar)[XB_TMO])) break; if (_sp > XB_SPIN_CAP) { atomicAdd(&(bar)[XB_TMO], 1u); break; } } } } while (0)

struct XcdBarrier {
    unsigned* bar; unsigned x;
    volatile LAS unsigned* st;
};

__device__ __forceinline__ XcdBarrier xcd_barrier_post(unsigned* bar, volatile LAS unsigned* st) {
    XcdBarrier b; b.bar = bar; b.x = xb_xcc_id(); b.st = st;
    if (threadIdx.x == 0) (void)xb_add(&bar[XB_XCNT(b.x)], 1u);
    return b;
}
__device__ __forceinline__ void xcd_barrier_complete(unsigned* bar, unsigned x, unsigned& nloc, unsigned& nx) {
    const unsigned G = gridDim.x * gridDim.y * gridDim.z;
    unsigned sum, cnt, mine, sp = 0u;
    for (;;) {
        sum = 0u; cnt = 0u; mine = 0u;
#pragma unroll
        for (unsigned j = 0; j < 16; ++j) { const unsigned c = xb_ld(&bar[XB_XCNT(j)]); sum += c; cnt += (c > 0u) ? 1u : 0u; mine = (j == x) ? c : mine; }
        if (sum == G) break;
        __builtin_amdgcn_s_sleep(1);
        if ((++sp & 255u) == 0u) { if (xb_ld(&bar[XB_TMO])) break; if (sp > XB_SPIN_CAP) { atomicAdd(&bar[XB_TMO], 1u); break; } }
    }
    nloc = mine > 0u ? mine : 1u; nx = cnt > 0u ? cnt : 1u;
}

__device__ __forceinline__ void xcd_barrier(const XcdBarrier& b) {
    asm volatile("s_waitcnt vmcnt(0)" ::: "memory");
    __syncthreads();
    if (threadIdx.x == 0) {
        unsigned* bar = b.bar;
        __builtin_amdgcn_s_waitcnt(0);
        unsigned nloc = b.st[0], nx = b.st[1];
        if (nloc == 0u) { xcd_barrier_complete(bar, b.x, nloc, nx); b.st[0] = nloc; b.st[1] = nx; }
        const unsigned old = xb_add(&bar[XB_XSUB(b.x)], 1u);
        const unsigned gen = old / nloc;
        if (old + 1u == (gen + 1u) * nloc) {
            __builtin_amdgcn_fence(__ATOMIC_RELEASE, "agent");
            asm volatile("s_waitcnt vmcnt(0)" ::: "memory");
            const unsigned og = xb_add(&bar[XB_TOP], 1u);
            const unsigned tg = og / nx;
            if (og + 1u == (tg + 1u) * nx) xb_add(&bar[XB_TOPGEN], 1u);
            else XB_SPIN(xb_ld(&bar[XB_TOPGEN]) == tg, bar);
            __builtin_amdgcn_fence(__ATOMIC_ACQUIRE, "agent");
            xb_add(&bar[XB_XGEN(b.x)], 1u);
            asm volatile("s_waitcnt vmcnt(0)" ::: "memory");
        } else {
            XB_SPIN(xb_ld(&bar[XB_XGEN(b.x)]) == gen, bar);
            __builtin_amdgcn_fence(__ATOMIC_ACQUIRE, "agent");
            asm volatile("s_waitcnt vmcnt(0)" ::: "memory");
        }
    }
    __syncthreads();
}

#ifndef REP_GEMM
#define REP_GEMM 1
#endif
#ifndef REP_SCAN
#define REP_SCAN 1
#endif
#ifndef REP_ATTN
#define REP_ATTN 1
#endif
#ifndef REP_LN
#define REP_LN 1
#endif
#ifndef EXTRA_SYNC
#define EXTRA_SYNC 2
#endif
#ifndef PH_STOP
#define PH_STOP N_PHASES
#endif
#ifndef PHMASK
#define PHMASK 0xffff
#endif
#define PHM(i) (((PHMASK) >> (i)) & 1)
constexpr int NS_K1 = 4, NS_K2 = 11;
constexpr int PH_PER_PAIR = 19, N_PHASES = 1 + 2 * PH_PER_PAIR;
__global__ void __launch_bounds__(NTHREADS, 2) trunk_fwd(Args a) {
    __shared__ __attribute__((aligned(16))) unsigned char lds_raw[LDS_BYTES];
    LAS unsigned char* lds = (LAS unsigned char*)lds_raw;
    cg::grid_group grid = cg::this_grid();
    volatile LAS unsigned* bar_st = (volatile LAS unsigned*)(lds + 131072);
    if (threadIdx.x < 2) bar_st[threadIdx.x] = 0u;
    __syncthreads();
    XcdBarrier xbar = xcd_barrier_post((unsigned*)(a.ws + WS_BAR), bar_st);
    unsigned char* ws = a.ws;
    bf16* XB = (bf16*)(ws + OFF_XB); bf16* R1 = (bf16*)(ws + OFF_R1); bf16* Z = (bf16*)(ws + OFF_Z); bf16* BIG = (bf16*)(ws + OFF_BIG);
    const int G = gridDim.x, cb = blockIdx.x;
#pragma unroll 1
    for (int ph = a.ph_lo; ph < a.ph_hi; ++ph) {
        bool nosync = false;
        if (ph == 0) { if (PHM(0)) prologue_phase(a, lds); }
        else {
            const int e = (ph - 1) / PH_PER_PAIR, q = (ph - 1) - e * PH_PER_PAIR;
            const int layer = 2 * e + (q >= 11 ? 1 : 0);
            int kind = -1; pg8::Gemm g{nullptr, nullptr, MT, 0, 0, nullptr, nullptr};
            pg8::EpiBf16 eb{nullptr, 0, 0, 0, 1.f, nullptr, 0}; int m2 = 0, n2 = 0;
            switch (q) {
            case 0:  kind = 0; g = pg8::Gemm{XB, (const bf16*)(ws + W_IN + e * W_IN_SZ), MT, NMIX, 1024, nullptr, nullptr}; eb = pg8::EpiBf16{BIG, APROJ, APROJ, (size_t)MT * APROJ, 1.f, nullptr, 0}; break;
            case 2:  kind = 0; g = pg8::Gemm{Z, (const bf16*)(ws + W_LO + e * W_LO_SZ), MT, NLORA, KLORA, nullptr, nullptr}; eb = pg8::EpiBf16{R1, 512, 512, (size_t)MT * 512, 1.f, nullptr, 0}; break;
            case 11: kind = 0; g = pg8::Gemm{XB, (const bf16*)(ws + W_QKV + e * W_QKV_SZ), MT, 2048, 1024, (const bf16*)(ws + W_QKV + e * W_QKV_SZ) + (size_t)2048 * 1024, XB};
                     eb = pg8::EpiBf16{BIG, 1024, 1024, (size_t)MT * 1024, 0.125f * 1.4426950408889634f, BIG + BIG_VT, LDV}; m2 = 1024; n2 = MT; break;
            case 12: nosync = true; break;
            case 8: case 16: kind = 1; g = pg8::Gemm{XB, (const bf16*)(ws + W_FI + layer * W_FI_SZ), MT, 2 * FH, 1024, nullptr, nullptr}; break;
            case 6:  kind = 2; g = pg8::Gemm{R1, (const bf16*)(ws + W_OM + e * W_SQ_SZ), MT, 1024, 1024, nullptr, nullptr}; break;
            case 14: kind = 2; g = pg8::Gemm{R1, (const bf16*)(ws + W_O + e * W_SQ_SZ), MT, 1024, 1024, nullptr, nullptr}; break;
            case 9: case 17: kind = 2; g = pg8::Gemm{BIG, (const bf16*)(ws + W_FO + layer * W_FO_SZ), MT, 1024, FH, nullptr, nullptr}; break;
            default: break;
            }
            const int nrep = kind >= 0 ? REP_GEMM : (q == 4 ? REP_SCAN : (q == 13 ? REP_ATTN : ((q == 7 || q == 15 || q == 10 || q == 18) ? REP_LN : 1)));
            if (q == 11) cache_convert(a, e);
#pragma unroll 1
            for (int rep = 0; rep < nrep; ++rep) {
            if (kind == 0 && PHM(1)) { pg8::StaticOrder S; S.init(g.M, g.N, G, cb, g.K, q == 2 ? 1 : 0); if (m2) S.second(m2, n2); pg8::gemm_phase<pg8::EpiBf16, pg8::StaticOrder, true, true>(lds, g, S, eb); }
            else if (kind == 1 && PHM(2)) { pg8::StaticOrder S; S.init(g.M, g.N, G, cb, g.K); pg8::EpiSwiglu es{BIG, FH}; pg8::gemm_phase<pg8::EpiSwiglu, pg8::StaticOrder, true, true>(lds, g, S, es); }
            else if (kind == 2 && PHM(3)) { pg8::SplitOrder S; S.init(G, cb, g.K, g.K == 1024 ? NS_K1 : NS_K2); pg8::EpiResid er{XB, Z, 1024, DN_ALPHA, (float*)(ws + OFF_G)}; pg8::gemm_phase<pg8::EpiResid, pg8::SplitOrder, true, true>(lds, g, S, er); }
            else if (q == 1 && PHM(4)) prep1_phase(a, e);
            else if (q == 3 && PHM(5)) prep2_phase(a, e);
            else if (q == 4 && PHM(6)) scan_phase(a, e, lds);
            else if (q == 5 && PHM(7)) post_phase(a, e);
            else if (q == 13 && PHM(8)) attn_phase(a, e, lds);
            else if ((q == 7 || q == 15) && PHM(9)) ln_phase(a, a.in[26] + (size_t)layer * 1024, a.in[27] + (size_t)layer * 1024, nullptr, NS_K1);
            else if ((q == 10 || q == 18) && PHM(9)) ln_phase(a, a.in[28] + (size_t)layer * 1024, a.in[29] + (size_t)layer * 1024, (layer == 3) ? a.out : nullptr, NS_K2);
        }
        }
        if (ph + 1 < a.ph_hi && !nosync) { if (ph == 0) grid.sync(); else xcd_barrier(xbar); }
        else __syncthreads();
    }
}

extern "C" void kernel_launch(void* const* d_in, const int* in_sizes, int n_in, void* d_out, int out_size, void* d_ws, size_t ws_size, hipStream_t stream) {
    static int grid = 0; static int badsz = 0;
    if (grid == 0) {
        if (n_in != 32 || ws_size < WS_BAR + WS_BAR_BYTES || out_size != 92360704) { fprintf(stderr, "kernel_launch: unexpected shapes (n_in %d, ws %zu, out %d)\n", n_in, ws_size, out_size); grid = -1; return; }
        static const long long exp_sz[32] = {67108864LL, 1048576, 1048576, 57344, 1048576, 16777216, 16777216, 6848512, 3584, 1024, 65536, 1024, 65536, 131072, 1024, 1024, 1024, 1024, 1024, 8192, 512, 256, 2097152, 6291456, 8224, 2097152, 4096, 4096, 4096, 4096, 23068672, 11534336};
        for (int i = 0; i < 32; ++i) if ((long long)in_sizes[i] != exp_sz[i]) { fprintf(stderr, "kernel_launch: input %d has %d elements, expected %lld\n", i, in_sizes[i], exp_sz[i]); badsz = 1; }
        int dev = 0, cus = 0, per_cu = 0;
        hipGetDevice(&dev); hipDeviceGetAttribute(&cus, hipDeviceAttributeMultiprocessorCount, dev);
        if (hipOccupancyMaxActiveBlocksPerMultiprocessor(&per_cu, (const void*)trunk_fwd, NTHREADS, 0) != hipSuccess || per_cu < 1) { fprintf(stderr, "kernel_launch: occupancy query says %d\n", per_cu); per_cu = 1; }
        (void)hipGetLastError();
        grid = cus * per_cu;
    }
    if (grid < 0) return;
    Args a{};
    for (int i = 0; i < 32; ++i) a.in[i] = (const float*)d_in[i];
    a.out = (float*)d_out; a.ws = (unsigned char*)d_ws;
#if defined(MK_PER_PHASE)
    for (int p = 0; p < N_PHASES; ++p) { a.ph_lo = p; a.ph_hi = p + 1; hipLaunchKernelGGL(trunk_fwd, dim3(grid), dim3(NTHREADS), 0, stream, a); }
#else
    a.ph_lo = 0; a.ph_hi = badsz ? 0 : PH_STOP;
    if (hipMemsetAsync((char*)d_ws + WS_BAR, 0, WS_BAR_BYTES, stream) != hipSuccess) { fprintf(stderr, "kernel_launch: memset of the barrier words failed\n"); return; }
    void* args[] = {&a};
    hipError_t err = hipLaunchCooperativeKernel((const void*)trunk_fwd, dim3(grid), dim3(NTHREADS), args, 0, stream);
    if (err != hipSuccess) fprintf(stderr, "kernel_launch: cooperative launch failed: %s (grid %d)\n", hipGetErrorString(err), grid);
#endif
}
```

```cpp
#include <hip/hip_runtime.h>
#include <hip/hip_cooperative_groups.h>
#include <cstdio>
#include <cstdint>
namespace cg = cooperative_groups;
namespace pg8 {
#define PG8_LAS __attribute__((address_space(3)))
typedef unsigned short bf16_t;
typedef short bf16x8 __attribute__((ext_vector_type(8)));
typedef float f32x4 __attribute__((ext_vector_type(4)));
typedef unsigned u32x4 __attribute__((ext_vector_type(4)));
constexpr int BM = 256, BK = 64, HALF = 128, HTB = HALF * BK * 2  , STAGE_BYTES = 8 * HTB, NXCD = 8, WGM = 8;

__host__ __device__ __forceinline__ int lds_byte(int r, int c) { const int st = (r >> 4) * 2 + (c >> 5), rr = r & 15, cc = c & 31, ob = rr * 64 + cc * 2; return st * 1024 + (ob ^ (((ob >> 9) & 1) << 5)); }
__host__ __device__ __forceinline__ void stage_rc(int b, int& R, int& C) { const int st = b / 1024, sb = b % 1024, swz = sb ^ (((sb >> 9) & 1) << 5); R = (st >> 1) * 16 + swz / 64; C = (st & 1) * 32 + (swz % 64) / 2; }
__host__ __device__ __forceinline__ int perm32(int rho) { const int n = rho >> 4, i = rho & 15; return 8 * (i >> 2) + 4 * n + (i & 3); }

struct Unit { int pm, pn, k0, nt, sl, z; };
struct Gemm { const bf16_t* A; const bf16_t* Bt; int M, N, K; const bf16_t* A2; const bf16_t* Bt2; };

struct StaticOrder {
    int nM, nN, nwg, G, c, ntk, lora, nM2, nN2, nwg2;
    __host__ __device__ void init(int M, int N, int G_, int c_, int K_, int lora_ = 0) { nM = M / BM; nN = N / BM; nwg = nM * nN; G = G_; c = c_; ntk = K_ / BK; lora = lora_; nM2 = 0; nN2 = 0; nwg2 = 0; }
    __host__ __device__ void second(int M2, int N2) { nM2 = M2 / BM; nN2 = N2 / BM; nwg2 = nM2 * nN2; }
    __host__ __device__ bool next(int i, Unit& u) const {
        long L = (long)i * G + c; int nM_ = nM, nN_ = nN, nwg_ = nwg, z_ = 0;
        if (L >= nwg) { L -= nwg; if (L >= nwg2) return false; nM_ = nM2; nN_ = nN2; nwg_ = nwg2; z_ = 1; }
        int wgid = (int)L; { const int q = nwg_ / NXCD, r = nwg_ % NXCD, xcd = wgid % NXCD, off = wgid / NXCD; wgid = (xcd < r ? xcd * (q + 1) : r * (q + 1) + (xcd - r) * q) + off; }
        const int nig = WGM * nN_, gid = wgid / nig, fm = gid * WGM, gsz = (nM_ - fm) < WGM ? (nM_ - fm) : WGM;
        u.pm = fm + ((wgid % nig) % gsz); u.pn = (wgid % nig) / gsz; u.k0 = 0; u.nt = ntk; u.sl = -1; u.z = z_; if (lora) { u.k0 = u.pn < 4 ? 0 : 2; u.nt = 2; } return true;
    }
    __device__ __forceinline__ void a_ready(const Unit&) const {}
    __device__ __forceinline__ void done(const Unit&) const {}
};

struct SplitOrder {
    StaticOrder so; int NS, nts, G, c;
    __host__ __device__ void init(int G_, int c_, int K_, int NS_) { so.init(65536, 1024, G_, c_, K_); NS = NS_; nts = (K_ / BK) / NS_; G = G_; c = c_; }
    __host__ __device__ bool next(int i, Unit& u) const {
        if (so.next(i, u)) return true;
        const long L = (long)i * G + c - 1024; if (L < 0 || L >= 16 * NS) return false;
        const int tile = (int)L / NS, sl = (int)L - tile * NS;
        u.pm = 256 + (tile >> 2); u.pn = tile & 3; u.k0 = sl * nts; u.nt = nts; u.sl = sl; u.z = 0; return true;
    }
    __device__ __forceinline__ void a_ready(const Unit&) const {}
    __device__ __forceinline__ void done(const Unit&) const {}
};

__device__ __forceinline__ unsigned cvt_pk_bf16(float lo, float hi) { unsigned r; asm volatile("v_cvt_pk_bf16_f32 %0, %1, %2" : "=v"(r) : "v"(lo), "v"(hi)); return r; }
__device__ __forceinline__ float bf_lo(unsigned w) { return __uint_as_float(w << 16); }
__device__ __forceinline__ float bf_hi(unsigned w) { return __uint_as_float(w & 0xffff0000u); }
struct EpiBf16 {
    static constexpr bool PERM = true, AFTER_DRAIN = false;
    bf16_t* O; int ldc; int split_cols; size_t split_stride; float scale0; bf16_t* O2; int ldc2;
    __device__ __forceinline__ void operator()(const f32x4 (&acc)[2][2][4][2], const Unit& u, int wr, int wc, int fr, int fq) const {
        const int row0 = u.pm * BM + wr * 64 + fr; int colt = u.pn * BM; bf16_t* base = u.z ? O2 : O; const int ldc = u.z ? ldc2 : this->ldc;
        float sc = 1.f; if (split_cols && !u.z) { const int t = colt / split_cols; base += (size_t)t * split_stride; colt -= t * split_cols; if (t == 0) sc = scale0; }
        const int col0 = colt + wc * 32 + 8 * fq;
#pragma unroll
        for (int ai = 0; ai < 2; ++ai)
#pragma unroll
            for (int m = 0; m < 4; ++m) { bf16_t* rowp = base + (size_t)(row0 + ai * HALF + m * 16) * ldc + col0;
#pragma unroll
                for (int bj = 0; bj < 2; ++bj) { const f32x4 v0 = acc[ai][bj][m][0] * sc, v1 = acc[ai][bj][m][1] * sc;
                    u32x4 w; w.x = cvt_pk_bf16(v0[0], v0[1]); w.y = cvt_pk_bf16(v0[2], v0[3]); w.z = cvt_pk_bf16(v1[0], v1[1]); w.w = cvt_pk_bf16(v1[2], v1[3]);
                    *(u32x4*)(rowp + bj * HALF) = w; } }
    }
};
__device__ __forceinline__ float silu_f(float x) { return x * __builtin_amdgcn_rcpf(1.0f + __expf(-x)); }
struct EpiSwiglu {
    static constexpr bool PERM = true, AFTER_DRAIN = false;
    bf16_t* O; int ldc;
    __device__ __forceinline__ void operator()(const f32x4 (&acc)[2][2][4][2], const Unit& u, int wr, int wc, int fr, int fq) const {
        const int row0 = u.pm * BM + wr * 64 + fr; const int col0 = u.pn * HALF + wc * 32 + 8 * fq;
#pragma unroll
        for (int ai = 0; ai < 2; ++ai)
#pragma unroll
            for (int m = 0; m < 4; ++m) { bf16_t* rowp = O + (size_t)(row0 + ai * HALF + m * 16) * ldc + col0;
                const f32x4 g0 = acc[ai][0][m][0], g1 = acc[ai][0][m][1], u0 = acc[ai][1][m][0], u1 = acc[ai][1][m][1];
                u32x4 w;
                w.x = cvt_pk_bf16(silu_f(g0[0]) * u0[0], silu_f(g0[1]) * u0[1]); w.y = cvt_pk_bf16(silu_f(g0[2]) * u0[2], silu_f(g0[3]) * u0[3]);
                w.z = cvt_pk_bf16(silu_f(g1[0]) * u1[0], silu_f(g1[1]) * u1[1]); w.w = cvt_pk_bf16(silu_f(g1[2]) * u1[2], silu_f(g1[3]) * u1[3]);
                *(u32x4*)rowp = w; }
    }
};
struct EpiResid {
    static constexpr bool PERM = true, AFTER_DRAIN = false;
    const bf16_t* X; bf16_t* Z; int ldc; float alpha; float* ZS;
    __device__ __forceinline__ void operator()(const f32x4 (&acc)[2][2][4][2], const Unit& u, int wr, int wc, int fr, int fq) const {
        const int row0 = u.pm * BM + wr * 64 + fr; const int col0 = u.pn * BM + wc * 32 + 8 * fq;
        if (u.sl >= 0) {
            float* zs = ZS + ((size_t)u.sl * 1024 + (row0 - 65536)) * 1024 + col0;
#pragma unroll
            for (int ai = 0; ai < 2; ++ai)
#pragma unroll
                for (int m = 0; m < 4; ++m)
#pragma unroll
                    for (int bj = 0; bj < 2; ++bj) { float* q = zs + (size_t)(ai * HALF + m * 16) * 1024 + bj * HALF; *(f32x4*)q = acc[ai][bj][m][0]; *(f32x4*)(q + 4) = acc[ai][bj][m][1]; }
            return;
        }
#pragma unroll
        for (int ai = 0; ai < 2; ++ai)
#pragma unroll
            for (int m = 0; m < 4; ++m) { const size_t off = (size_t)(row0 + ai * HALF + m * 16) * ldc + col0;
#pragma unroll
                for (int bj = 0; bj < 2; ++bj) { const u32x4 x = *(const u32x4*)(X + off + bj * HALF);
                    const f32x4 v0 = acc[ai][bj][m][0], v1 = acc[ai][bj][m][1];
                    u32x4 w;
                    w.x = cvt_pk_bf16(alpha * bf_lo(x.x) + v0[0], alpha * bf_hi(x.x) + v0[1]); w.y = cvt_pk_bf16(alpha * bf_lo(x.y) + v0[2], alpha * bf_hi(x.y) + v0[3]);
                    w.z = cvt_pk_bf16(alpha * bf_lo(x.z) + v1[0], alpha * bf_hi(x.z) + v1[1]); w.w = cvt_pk_bf16(alpha * bf_lo(x.w) + v1[2], alpha * bf_hi(x.w) + v1[3]);
                    *(u32x4*)(Z + off + bj * HALF) = w; } }
    }
};
template <class Epi, class Sched, bool ALIGN_EPI = false, bool SP2 = false>
__device__ __forceinline__ void gemm_phase(PG8_LAS unsigned char* lds, const Gemm g, const Sched& S, const Epi& E) {
    int tid = threadIdx.x; asm volatile("" : "+v"(tid)); const int wid = __builtin_amdgcn_readfirstlane(tid >> 6), lane = tid & 63, wr = wid >> 2, wc = wid & 3, fr = lane & 15, fq = lane >> 4;
    const int K = g.K;
    unsigned voffA[2], voffB[2];
#pragma unroll
    for (int i = 0; i < 2; ++i) { int R, C; stage_rc(tid * 16 + i * 8192, R, C); const int Rb = Epi::PERM ? ((R & ~31) + perm32(R & 31)) : R;
        voffA[i] = (unsigned)(R * K + C) * 2u; voffB[i] = (unsigned)(Rb * K + C) * 2u; }
    const size_t kstep = (size_t)(BK * 2);
    const size_t hstep = (size_t)HALF * K * 2;
    const size_t tstep = 2 * hstep;
    const unsigned ldsw = (unsigned)wid * 1024u;
    const int aoff = lds_byte(wr * 64 + fr, fq * 8), boff = lds_byte(wc * 32 + fr, fq * 8);
#define PG8_SA(b, h) (((b) * 2 + (h)) * HTB)
#define PG8_SB(b, h) ((4 + (b) * 2 + (h)) * HTB)
#define PG8_STAGE(bufoff, gbase, voff) do { _Pragma("unroll") for (int _i = 0; _i < 2; ++_i) \
        __builtin_amdgcn_global_load_lds((const unsigned*)((const char*)(gbase) + (voff)[_i]), (PG8_LAS unsigned*)(lds + (bufoff) + ldsw + _i * 8192), 16, 0, 0); } while (0)
#define PG8_LDA(dst, b, h) do { _Pragma("unroll") for (int m = 0; m < 4; ++m) _Pragma("unroll") for (int k = 0; k < 2; ++k) dst[m][k] = *(const PG8_LAS bf16x8*)(lds + PG8_SA(b, h) + aoff + m * 2048 + k * 1024); } while (0)
#define PG8_LDB(dst, b, h) do { _Pragma("unroll") for (int n = 0; n < 2; ++n) _Pragma("unroll") for (int k = 0; k < 2; ++k) dst[n][k] = *(const PG8_LAS bf16x8*)(lds + PG8_SB(b, h) + boff + n * 2048 + k * 1024); } while (0)
#define PG8_MMA(ai, bj, At, Bt) do { __builtin_amdgcn_s_setprio(1); _Pragma("unroll") for (int m = 0; m < 4; ++m) _Pragma("unroll") for (int n = 0; n < 2; ++n) _Pragma("unroll") for (int k = 0; k < 2; ++k) \
        acc[ai][bj][m][n] = __builtin_amdgcn_mfma_f32_16x16x32_bf16(Bt[n][k], At[m][k], acc[ai][bj][m][n], 0, 0, 0); __builtin_amdgcn_s_setprio(0); } while (0)
#define PG8_WAIT_V(n) asm volatile("s_waitcnt vmcnt(" #n ")" ::: "memory")
#define PG8_WAIT_L(n) asm volatile("s_waitcnt lgkmcnt(" #n ")" ::: "memory")
#define PG8_BAR __builtin_amdgcn_s_barrier()
#define PG8_SCHED __builtin_amdgcn_sched_barrier(0)
    Unit cur, nxt; int ui = 0;
    if (!S.next(0, cur)) return;
    f32x4 acc[2][2][4][2];
#pragma unroll
    for (int a = 0; a < 2; ++a)
#pragma unroll
        for (int b = 0; b < 2; ++b)
#pragma unroll
            for (int m = 0; m < 4; ++m)
#pragma unroll
                for (int n = 0; n < 2; ++n) acc[a][b][m][n] = (f32x4){0.f, 0.f, 0.f, 0.f};
    bf16x8 At[4][2], B0[2][2], B1[2][2];
    const char* cA = (const char*)(cur.z ? g.A2 : g.A) + (size_t)cur.pm * tstep + (size_t)cur.k0 * kstep; const char* cB = (const char*)(cur.z ? g.Bt2 : g.Bt) + (size_t)cur.pn * tstep + (size_t)cur.k0 * kstep;
    S.a_ready(cur);
    if constexpr (SP2) {
        PG8_STAGE(PG8_SB(0, 0), cB, voffB); PG8_STAGE(PG8_SB(0, 1), cB + hstep, voffB); PG8_STAGE(PG8_SA(0, 0), cA, voffA); PG8_STAGE(PG8_SA(0, 1), cA + hstep, voffA);
        if (wr == 1) PG8_BAR;
        PG8_WAIT_V(2); PG8_BAR;
        PG8_STAGE(PG8_SB(1, 0), cB + kstep, voffB); PG8_STAGE(PG8_SA(1, 0), cA + kstep, voffA); PG8_STAGE(PG8_SB(1, 1), cB + hstep + kstep, voffB);
        PG8_WAIT_V(6); PG8_BAR;
    } else {
        PG8_STAGE(PG8_SB(0, 0), cB, voffB); PG8_STAGE(PG8_SA(0, 0), cA, voffA); PG8_STAGE(PG8_SB(0, 1), cB + hstep, voffB); PG8_STAGE(PG8_SA(0, 1), cA + hstep, voffA);
        if (wr == 1) PG8_BAR;
        PG8_WAIT_V(4); PG8_BAR;
        PG8_STAGE(PG8_SB(1, 0), cB + kstep, voffB); PG8_STAGE(PG8_SA(1, 0), cA + kstep, voffA); PG8_STAGE(PG8_SB(1, 1), cB + hstep + kstep, voffB);
        PG8_WAIT_V(6); PG8_BAR;
    }
    for (;;) {
        const bool has_next = S.next(ui + 1, nxt);
        const char* nA = has_next ? (const char*)(nxt.z ? g.A2 : g.A) + (size_t)nxt.pm * tstep + (size_t)nxt.k0 * kstep : cA; const char* nB = has_next ? (const char*)(nxt.z ? g.Bt2 : g.Bt) + (size_t)nxt.pn * tstep + (size_t)nxt.k0 * kstep : cB;
        const int nt = cur.nt;
        for (int t = 0; t < nt; t += 2) {
            const bool last = (t == nt - 2);
            const char* a1 = cA + (size_t)(t + 1) * kstep;
            const char* a2 = last ? nA : cA + (size_t)(t + 2) * kstep; const char* b2 = last ? nB : cB + (size_t)(t + 2) * kstep;
            const char* a3 = a2 + kstep; const char* b3 = b2 + kstep;
            if (last && has_next) S.a_ready(nxt);
            if constexpr (SP2) {
            PG8_LDB(B0, 0, 0); PG8_LDB(B1, 0, 1); PG8_SCHED; PG8_LDA(At, 0, 0); PG8_STAGE(PG8_SA(1, 1), a1 + hstep, voffA);
            PG8_WAIT_V(8); PG8_WAIT_L(0); PG8_BAR; PG8_MMA(0, 0, At, B0); PG8_MMA(0, 1, At, B1); PG8_BAR; PG8_SCHED;
            PG8_LDA(At, 0, 1); PG8_STAGE(PG8_SB(0, 0), b2, voffB); PG8_STAGE(PG8_SB(0, 1), b2 + hstep, voffB); PG8_STAGE(PG8_SA(0, 0), a2, voffA);
            PG8_WAIT_V(8); PG8_WAIT_L(0); PG8_BAR; PG8_MMA(1, 0, At, B0); PG8_MMA(1, 1, At, B1); PG8_BAR; PG8_SCHED;
            PG8_LDB(B0, 1, 0); PG8_LDB(B1, 1, 1); PG8_SCHED; PG8_LDA(At, 1, 0); PG8_STAGE(PG8_SA(0, 1), a2 + hstep, voffA);
            PG8_WAIT_V(8); PG8_WAIT_L(0); PG8_BAR; PG8_MMA(0, 0, At, B0); PG8_MMA(0, 1, At, B1); PG8_BAR; PG8_SCHED;
            PG8_LDA(At, 1, 1); PG8_STAGE(PG8_SB(1, 0), b3, voffB); PG8_STAGE(PG8_SB(1, 1), b3 + hstep, voffB); PG8_STAGE(PG8_SA(1, 0), a3, voffA);
            PG8_WAIT_V(8); PG8_WAIT_L(0); PG8_BAR; PG8_MMA(1, 0, At, B0); PG8_MMA(1, 1, At, B1); PG8_BAR; PG8_SCHED;
            } else {
            PG8_LDB(B0, 0, 0); PG8_SCHED; PG8_LDA(At, 0, 0); PG8_STAGE(PG8_SA(1, 1), a1 + hstep, voffA);
            PG8_WAIT_L(8); PG8_BAR; PG8_WAIT_L(0); PG8_MMA(0, 0, At, B0); PG8_BAR; PG8_SCHED;
            PG8_LDB(B1, 0, 1); PG8_STAGE(PG8_SB(0, 0), b2, voffB);
            PG8_BAR; PG8_WAIT_L(0); PG8_MMA(0, 1, At, B1); PG8_BAR;
            PG8_LDA(At, 0, 1); PG8_STAGE(PG8_SA(0, 0), a2, voffA);
            PG8_BAR; PG8_WAIT_L(0); PG8_MMA(1, 0, At, B0); PG8_BAR; PG8_SCHED;
            PG8_STAGE(PG8_SB(0, 1), b2 + hstep, voffB);
            PG8_WAIT_V(6); PG8_BAR; PG8_MMA(1, 1, At, B1); PG8_BAR;
            PG8_LDB(B0, 1, 0); PG8_SCHED; PG8_LDA(At, 1, 0); PG8_STAGE(PG8_SA(0, 1), a2 + hstep, voffA);
            PG8_WAIT_L(8); PG8_BAR; PG8_WAIT_L(0); PG8_MMA(0, 0, At, B0); PG8_BAR; PG8_SCHED;
            PG8_LDB(B1, 1, 1); PG8_STAGE(PG8_SB(1, 0), b3, voffB);
            PG8_BAR; PG8_WAIT_L(0); PG8_MMA(0, 1, At, B1); PG8_BAR;
            PG8_LDA(At, 1, 1); PG8_STAGE(PG8_SA(1, 0), a3, voffA);
            PG8_BAR; PG8_WAIT_L(0); PG8_MMA(1, 0, At, B0); PG8_BAR; PG8_SCHED;
            PG8_STAGE(PG8_SB(1, 1), b3 + hstep, voffB);
            PG8_WAIT_V(6); PG8_BAR; PG8_MMA(1, 1, At, B1); PG8_BAR;
            }
        }
        if constexpr (ALIGN_EPI) { if (wr == 0) PG8_BAR; }
        if constexpr (!Epi::AFTER_DRAIN) { E(acc, cur, wr, wc, fr, fq); S.done(cur); }
        if (!has_next) break;
#pragma unroll
        for (int a = 0; a < 2; ++a)
#pragma unroll
            for (int b = 0; b < 2; ++b)
#pragma unroll
                for (int m = 0; m < 4; ++m)
#pragma unroll
                    for (int n = 0; n < 2; ++n) acc[a][b][m][n] = (f32x4){0.f, 0.f, 0.f, 0.f};
        cur = nxt; cA = nA; cB = nB; ++ui;
        if constexpr (ALIGN_EPI) { if (wr == 1) PG8_BAR; }
    }
    PG8_WAIT_V(0);
    if constexpr (!ALIGN_EPI) { if (wr == 0) PG8_BAR; }
    PG8_BAR;
    if constexpr (Epi::AFTER_DRAIN) { E.fused(acc, cur, wr, wc, fr, fq, lds, wid, lane); S.done(cur); }
#undef PG8_SA
#undef PG8_SB
#undef PG8_STAGE
#undef PG8_LDA
#undef PG8_LDB
#undef PG8_MMA
#undef PG8_WAIT_V
#undef PG8_WAIT_L
#undef PG8_BAR
#undef PG8_SCHED
}
}
#define TR_LO 0
#define TR_HI 16


#define LAS __attribute__((address_space(3)))
typedef unsigned short bf16;
typedef unsigned v4u __attribute__((ext_vector_type(4)));
typedef unsigned v2u __attribute__((ext_vector_type(2)));
typedef float f32x4 __attribute__((ext_vector_type(4)));
typedef short bf16x8 __attribute__((ext_vector_type(8)));
using pg8::cvt_pk_bf16; using pg8::bf_lo; using pg8::bf_hi;

constexpr int DM = 1024, MP = 65536, MS = 1024, MT = MP + MS;
constexpr int TPR = 8192, TSM = 64;
constexpr int APROJ = 1792, NMIX = 3584, FH = 2816, NLORA = 1536, KLORA = 256;
constexpr float LN_EPS = 1e-5f, A_NORM_EPS = 64e-5f;
constexpr float DN_ALPHA = 1.681792830507429f;
constexpr int NWAVES = 8, NTHREADS = 512;
constexpr int LDS_BYTES = 132096;

constexpr size_t SZ_X = (size_t)MT * 1024 * 2;
constexpr size_t W_IN = 0, W_IN_SZ = (size_t)NMIX * 1024 * 2;
constexpr size_t W_LO = W_IN + 2 * W_IN_SZ, W_LO_SZ = (size_t)NLORA * KLORA * 2;
constexpr size_t W_OM = W_LO + 2 * W_LO_SZ, W_SQ_SZ = (size_t)1024 * 1024 * 2;
constexpr size_t W_QKV = W_OM + 2 * W_SQ_SZ, W_QKV_SZ = (size_t)3072 * 1024 * 2;
constexpr size_t W_O = W_QKV + 2 * W_QKV_SZ;
constexpr size_t W_FI = W_O + 2 * W_SQ_SZ, W_FI_SZ = (size_t)2 * FH * 1024 * 2;
constexpr size_t W_FO = W_FI + 4 * W_FI_SZ, W_FO_SZ = (size_t)1024 * FH * 2;
constexpr size_t OFF_XB = W_FO + 4 * W_FO_SZ;
constexpr size_t OFF_R1 = OFF_XB + SZ_X;
constexpr size_t OFF_G = OFF_R1 + SZ_X;
constexpr size_t OFF_Z = OFF_G + SZ_X / 2;
constexpr size_t OFF_BIG = OFF_Z + SZ_X;
constexpr size_t WS_END = OFF_BIG + (size_t)MT * NMIX * 2;
constexpr size_t WS_BAR = WS_END, WS_BAR_BYTES = 16384;
static_assert(OFF_XB % 256 == 0 && WS_BAR % 256 == 0 && WS_BAR + WS_BAR_BYTES <= (size_t)1073741824, "ws map");

constexpr size_t O_YP = 0, O_YS = 67108864, O_PWKV = 68157440, O_PSHIFT = 68681728, O_PGLA = 68710400, O_PK = 69234688, O_PV = 77623296,
                 O_SWKV = 86011904, O_SSHIFT = 87060480, O_SGLA = 87117824, O_SK = 88166400, O_SV = 90263552;

__device__ __forceinline__ int tid_opaque() { int t = threadIdx.x; asm volatile("" : "+v"(t)); return t; }
struct Args { const float* in[32]; float* out; unsigned char* ws; int ph_lo, ph_hi; };

__device__ __forceinline__ float wave_sum(float v) {
#pragma unroll
    for (int o = 1; o < 64; o <<= 1) v += __shfl_xor(v, o);
    return v;
}
__device__ __forceinline__ void unpack8(const v4u w, float* f) {
    f[0] = bf_lo(w.x); f[1] = bf_hi(w.x); f[2] = bf_lo(w.y); f[3] = bf_hi(w.y); f[4] = bf_lo(w.z); f[5] = bf_hi(w.z); f[6] = bf_lo(w.w); f[7] = bf_hi(w.w);
}
__device__ __forceinline__ v4u pack8(const float* f) {
    v4u w; w.x = cvt_pk_bf16(f[0], f[1]); w.y = cvt_pk_bf16(f[2], f[3]); w.z = cvt_pk_bf16(f[4], f[5]); w.w = cvt_pk_bf16(f[6], f[7]); return w;
}
__device__ __forceinline__ void load8f(const float* p, float* f) {
    const f32x4 a = *(const f32x4*)p, b = *(const f32x4*)(p + 4);
    f[0] = a.x; f[1] = a.y; f[2] = a.z; f[3] = a.w; f[4] = b.x; f[5] = b.y; f[6] = b.z; f[7] = b.w;
}
__device__ __forceinline__ float softplus_f(float x) { return fmaxf(x, 0.f) + __logf(1.0f + __expf(-fabsf(x))); }
__device__ __forceinline__ float sigmoid_f(float x) { return __builtin_amdgcn_rcpf(1.0f + __expf(-x)); }
#define LDS_WAIT() asm volatile("s_waitcnt lgkmcnt(0)" ::: "memory")

__device__ __forceinline__ int xcd_vcu() { const int G = gridDim.x, bx = blockIdx.x; return (G % 8 == 0) ? (bx % 8) * (G / 8) + bx / 8 : bx; }
__device__ __forceinline__ int src_col(int mode, int n) {
    if (mode == 0) return n;
    if (mode == 1) {
        if (n < 1792) return n;
        if (n < 2816) { const int h = (n - 1792) >> 8, r = (n - 1792) & 255;
            if (r < 64) return 1792 + h * 64 + r; if (r < 128) return 1792 + 256 + h * 64 + (r - 64); return 1792 + 512 + h * 128 + (r - 128); }
        if (n < 3328) return 1792 + 1040 + (n - 2816);
        if (n < 3344) return 1792 + 1024 + (n - 3328);
        return -1;
    }
    const int pn = n >> 8, jj = n & 255;
    return jj < 128 ? pn * 128 + jj : FH + pn * 128 + (jj - 128);
}
__device__ __forceinline__ void transpose_item(const float* W, int ldw, int mode, bf16* WT, int K, int N, int it, int lane) {
    const int nblk = N / 64;
    const int kb = it / nblk, nb = it - kb * nblk, k0 = 64 * kb, n = 64 * nb + lane;
    const int sc = src_col(mode, n); const float msk = sc >= 0 ? 1.f : 0.f; const int scc = sc >= 0 ? sc : 0;
    const float* wp = W + (size_t)k0 * ldw + scc; bf16* op = WT + (size_t)n * K + k0;
#pragma unroll 4
    for (int k8 = 0; k8 < 8; ++k8) {
        float f[8];
#pragma unroll
        for (int i = 0; i < 8; ++i) f[i] = wp[(size_t)(8 * k8 + i) * ldw] * msk;
        *(v4u*)(op + 8 * k8) = pack8(f);
    }
}
__device__ __forceinline__ void prologue_phase(const Args& a, LAS unsigned char* lds) {
    const int tid = tid_opaque(), lane = tid & 63, wave = tid >> 6;
    const int gw = blockIdx.x * NWAVES + wave, ngw = gridDim.x * NWAVES;
    LAS float* scr = (LAS float*)(lds + wave * 8704);
    unsigned char* ws = a.ws;
    for (int itg = gw; itg < 12800; itg += ngw) {
        int j, base;
        if (itg < 1792) { j = itg / 896; base = j * 896; }
        else if (itg < 2304) { j = 2 + (itg - 1792) / 256; base = 1792 + (j - 2) * 256; }
        else if (itg < 3840) { j = 4 + (itg - 2304) / 768; base = 2304 + (j - 4) * 768; }
        else if (itg < 4352) { j = 6 + (itg - 3840) / 256; base = 3840 + (j - 6) * 256; }
        else if (itg < 9984) { j = 8 + (itg - 4352) / 1408; base = 4352 + (j - 8) * 1408; }
        else { j = 12 + (itg - 9984) / 704; base = 9984 + (j - 12) * 704; }
        const float* W; int ldw, mode, K, N; bf16* WT;
        if (j < 2)       { W = a.in[7] + (size_t)j * 1024 * 3344; ldw = 3344; mode = 1; K = 1024; N = NMIX; WT = (bf16*)(ws + W_IN + j * W_IN_SZ); }
        else if (j < 4)  { const int e = j - 2;  W = a.in[22] + (size_t)e * 1024 * 1024; ldw = 1024; mode = 0; K = 1024; N = 1024; WT = (bf16*)(ws + W_OM + e * W_SQ_SZ); }
        else if (j < 6)  { const int e = j - 4;  W = a.in[23] + (size_t)e * 1024 * 3072; ldw = 3072; mode = 0; K = 1024; N = 3072; WT = (bf16*)(ws + W_QKV + e * W_QKV_SZ); }
        else if (j < 8)  { const int e = j - 6;  W = a.in[25] + (size_t)e * 1024 * 1024; ldw = 1024; mode = 0; K = 1024; N = 1024; WT = (bf16*)(ws + W_O + e * W_SQ_SZ); }
        else if (j < 12) { const int l = j - 8;  W = a.in[30] + (size_t)l * 1024 * 2 * FH; ldw = 2 * FH; mode = 2; K = 1024; N = 2 * FH; WT = (bf16*)(ws + W_FI + l * W_FI_SZ); }
        else             { const int l = j - 12; W = a.in[31] + (size_t)l * FH * 1024; ldw = 1024; mode = 0; K = FH; N = 1024; WT = (bf16*)(ws + W_FO + l * W_FO_SZ); }
        transpose_item(W, ldw, mode, WT, K, N, itg - base, lane);
    }
    const int gt = blockIdx.x * NTHREADS + tid, ngt = gridDim.x * NTHREADS;
#ifndef SKIP_LORA
    for (int idx = gt; idx < 2 * NLORA * 32; idx += ngt) {
        const int e = idx / (NLORA * 32), r = idx - e * (NLORA * 32), n = r >> 5, k0 = (r & 31) * 8;
        float f[8];
#pragma unroll
        for (int i = 0; i < 8; ++i) { const int k = k0 + i; float v = 0.f;
            if (n < 512) { if (k < 64) v = a.in[10][((size_t)e * 64 + k) * 512 + n]; }
            else if (n < 1024) { if (k >= 64 && k < 128) v = a.in[12][((size_t)e * 64 + (k - 64)) * 512 + (n - 512)]; }
            else { if (k >= 128) v = a.in[13][((size_t)e * 128 + (k - 128)) * 512 + (n - 1024)]; }
            f[i] = v; }
        *(v4u*)((bf16*)(ws + W_LO + e * W_LO_SZ) + (size_t)n * KLORA + k0) = pack8(f);
    }
#endif
    bf16* XB = (bf16*)(ws + OFF_XB);
    for (size_t idx = gt; idx < (size_t)MT * 128; idx += ngt) {
        const size_t e0 = idx * 8; const float* src = e0 < (size_t)MP * 1024 ? a.in[0] + e0 : a.in[1] + (e0 - (size_t)MP * 1024);
        float f[8]; load8f(src, f); *(v4u*)(XB + e0) = pack8(f);
    }
}

__device__ __forceinline__ void prep1_phase(const Args& a, int e) {
    const int tid = tid_opaque(), lane = tid & 63, wave = tid >> 6;
    const int gw = blockIdx.x * NWAVES + wave, ngw = gridDim.x * NWAVES;
    const bf16* PA = (const bf16*)(a.ws + OFF_BIG); bf16* L = (bf16*)(a.ws + OFF_Z);
    const float* mu = a.in[8] + (size_t)e * APROJ; const float* shift0 = a.in[3] + (size_t)e * 16 * APROJ;
    const int c = 1536 + 4 * lane;
    const f32x4 mu4 = *(const f32x4*)(mu + c);
    for (int m = gw; m < MT; m += ngw) {
        const v2u pw = *(const v2u*)(PA + (size_t)m * APROJ + c);
        float p[4] = {bf_lo(pw.x), bf_hi(pw.x), bf_lo(pw.y), bf_hi(pw.y)}, q[4];
        const int t = m < MP ? (m & (TPR - 1)) : ((m - MP) & (TSM - 1));
        if (t > 0) { const v2u qw = *(const v2u*)(PA + (size_t)(m - 1) * APROJ + c); q[0] = bf_lo(qw.x); q[1] = bf_hi(qw.x); q[2] = bf_lo(qw.y); q[3] = bf_hi(qw.y); }
        else if (m < MP) { q[0] = q[1] = q[2] = q[3] = 0.f; }
        else { const f32x4 s = *(const f32x4*)(shift0 + (size_t)((m - MP) >> 6) * APROJ + c); q[0] = s.x; q[1] = s.y; q[2] = s.z; q[3] = s.w; }
        float r[4];
#pragma unroll
        for (int i = 0; i < 4; ++i) { const float xs = p[i] + (q[i] - p[i]) * mu4[i]; r[i] = lane < 16 ? tanhf(xs) : (lane < 32 ? xs : sigmoid_f(xs)); }
        v2u o; o.x = cvt_pk_bf16(r[0], r[1]); o.y = cvt_pk_bf16(r[2], r[3]);
        *(v2u*)(L + (size_t)m * KLORA + 4 * lane) = o;
    }
}
__device__ __forceinline__ void prep2_phase(const Args& a, int e) {
    const int tid = tid_opaque(), lane = tid & 63, wave = tid >> 6;
    const int gw = blockIdx.x * NWAVES + wave, ngw = gridDim.x * NWAVES;
    const bf16* PA = (const bf16*)(a.ws + OFF_BIG); bf16* PB = (bf16*)(a.ws + OFF_BIG) + (size_t)MT * APROJ;
    const bf16* Lw = (const bf16*)(a.ws + OFF_R1); const bf16* La = Lw + (size_t)MT * 512;
    bf16* SA = (bf16*)a.out; bf16* SB = (bf16*)(a.ws + OFF_Z);
    const float* mu = a.in[8] + (size_t)e * APROJ; const float* shift0 = a.in[3] + (size_t)e * 16 * APROJ;
    const int c8 = 8 * lane, h = lane >> 3;
    float mur[8], muk[8], muv[8], w0[8], a0[8], kkw[8], kaw[8];
    load8f(mu + c8, mur); load8f(mu + 512 + c8, muk); load8f(mu + 1024 + c8, muv);
    load8f(a.in[9] + (size_t)e * 512 + c8, w0); load8f(a.in[11] + (size_t)e * 512 + c8, a0);
    load8f(a.in[14] + (size_t)e * 512 + c8, kkw); load8f(a.in[15] + (size_t)e * 512 + c8, kaw);
    const float* aup = a.in[19] + (size_t)e * 16 * 256; const f32x4 ab = *(const f32x4*)(a.in[20] + (size_t)e * 256 + 4 * lane);
    for (int m = gw; m < MT; m += ngw) {
        const bf16* pr = PA + (size_t)m * APROJ;
        float r[8], k[8], v[8], pq[8];
        unpack8(*(const v4u*)(pr + c8), r); unpack8(*(const v4u*)(pr + 512 + c8), k); unpack8(*(const v4u*)(pr + 1024 + c8), v);
        const int t = m < MP ? (m & (TPR - 1)) : ((m - MP) & (TSM - 1));
        if (t > 0) {
            unpack8(*(const v4u*)(pr - APROJ + c8), pq);
#pragma unroll
            for (int i = 0; i < 8; ++i) r[i] += (pq[i] - r[i]) * mur[i];
            unpack8(*(const v4u*)(pr - APROJ + 512 + c8), pq);
#pragma unroll
            for (int i = 0; i < 8; ++i) k[i] += (pq[i] - k[i]) * muk[i];
            unpack8(*(const v4u*)(pr - APROJ + 1024 + c8), pq);
#pragma unroll
            for (int i = 0; i < 8; ++i) v[i] += (pq[i] - v[i]) * muv[i];
        } else if (m < MP) {
#pragma unroll
            for (int i = 0; i < 8; ++i) { r[i] -= r[i] * mur[i]; k[i] -= k[i] * muk[i]; v[i] -= v[i] * muv[i]; }
        } else {
            const float* s0 = shift0 + (size_t)((m - MP) >> 6) * APROJ;
            load8f(s0 + c8, pq);
#pragma unroll
            for (int i = 0; i < 8; ++i) r[i] += (pq[i] - r[i]) * mur[i];
            load8f(s0 + 512 + c8, pq);
#pragma unroll
            for (int i = 0; i < 8; ++i) k[i] += (pq[i] - k[i]) * muk[i];
            load8f(s0 + 1024 + c8, pq);
#pragma unroll
            for (int i = 0; i < 8; ++i) v[i] += (pq[i] - v[i]) * muv[i];
        }
        float lw[8], la[8], u[8], av[8], kk[8], km[8], ka[8];
        unpack8(*(const v4u*)(Lw + (size_t)m * 512 + c8), lw); unpack8(*(const v4u*)(La + (size_t)m * 512 + c8), la);
        float ss = 0.f;
#pragma unroll
        for (int i = 0; i < 8; ++i) {
            u[i] = 1.0f - __expf(-0.6065306597126334f * sigmoid_f(w0[i] + lw[i]));
            av[i] = sigmoid_f(a0[i] + la[i]);
            kk[i] = k[i] * kkw[i]; ss += kk[i] * kk[i];
            km[i] = k[i] * (1.0f + (av[i] - 1.0f) * kaw[i]);
        }
        ss += __shfl_xor(ss, 1); ss += __shfl_xor(ss, 2); ss += __shfl_xor(ss, 4);
        const float rn = rsqrtf(ss + 1e-12f);
#pragma unroll
        for (int i = 0; i < 8; ++i) { kk[i] *= rn; ka[i] = kk[i] * av[i]; }
        bf16* sa = SA + ((size_t)m * 8 + h) * 256 + (lane & 7) * 8; bf16* sb = SB + ((size_t)m * 8 + h) * 128 + (lane & 7) * 8;
        *(v4u*)(sa) = pack8(r); *(v4u*)(sa + 64) = pack8(u); *(v4u*)(sa + 128) = pack8(km); *(v4u*)(sa + 192) = pack8(v);
        *(v4u*)(sb) = pack8(kk); *(v4u*)(sb + 64) = pack8(ka);
        bf16* pb = PB + (size_t)m * APROJ + 1536;
        float xa[16]; unpack8(*(const v4u*)(pb), xa); unpack8(*(const v4u*)(pb + 8), xa + 8);
        f32x4 acc = ab;
#pragma unroll
        for (int i = 0; i < 16; ++i) { const f32x4 wv = *(const f32x4*)(aup + i * 256 + 4 * lane); acc += xa[i] * wv; }
        float ug[4];
#pragma unroll
        for (int i = 0; i < 4; ++i) ug[i] = 1.0f - __expf(-softplus_f(-acc[i]) * (1.0f / 16.0f));
        v2u o; o.x = cvt_pk_bf16(ug[0], ug[1]); o.y = cvt_pk_bf16(ug[2], ug[3]);
        *(v2u*)(pb + 4 * lane) = o;
    }
}
struct PostRaw { v4u o, r, km, v, g, og, rg; };
__device__ __forceinline__ void post_phase(const Args& a, int e) {
    const int tid = tid_opaque(), lane = tid & 63, wave = tid >> 6;
    const int gw = blockIdx.x * NWAVES + wave, ngw = gridDim.x * NWAVES;
    bf16* Y = (bf16*)(a.ws + OFF_R1); const bf16* G = (const bf16*)(a.ws + OFF_G);
    const bf16* PB = (const bf16*)(a.ws + OFF_BIG) + (size_t)MT * APROJ; const bf16* SA = (const bf16*)a.out;
    const int c8 = 8 * lane, h = lane >> 3;
    float lnw[8], lnb[8], rk[8], nw[8];
    load8f(a.in[17] + (size_t)e * 512 + c8, lnw); load8f(a.in[18] + (size_t)e * 512 + c8, lnb); load8f(a.in[16] + (size_t)e * 512 + c8, rk);
    load8f(a.in[21] + (size_t)e * 128 + (lane & 15) * 8, nw);
    for (int mb = gw; mb < MT; mb += 2 * ngw) {
        PostRaw raw[2];
#pragma unroll
        for (int j = 0; j < 2; ++j) { const int m_ = mb + j * ngw; const size_t m = m_ < MT ? m_ : mb;
            const bf16* sa = SA + (m * 8 + h) * 256 + (lane & 7) * 8;
            raw[j].o = *(const v4u*)(Y + m * 1024 + c8); raw[j].r = *(const v4u*)(sa); raw[j].km = *(const v4u*)(sa + 128); raw[j].v = *(const v4u*)(sa + 192);
            raw[j].g = *(const v4u*)(G + m * 512 + c8); raw[j].og = *(const v4u*)(Y + m * 1024 + 512 + c8); raw[j].rg = *(const v4u*)(PB + m * APROJ + 1024 + c8); }
#pragma unroll
        for (int j = 0; j < 2; ++j) {
            const int m = mb + j * ngw;
            float o[8], r[8], km[8], v[8], g[8];
            unpack8(raw[j].o, o); unpack8(raw[j].r, r); unpack8(raw[j].km, km); unpack8(raw[j].v, v); unpack8(raw[j].g, g);
            float s = 0.f, bn = 0.f;
#pragma unroll
            for (int i = 0; i < 8; ++i) { s += o[i]; bn += r[i] * km[i] * rk[i]; }
            s += __shfl_xor(s, 1); s += __shfl_xor(s, 2); s += __shfl_xor(s, 4);
            bn += __shfl_xor(bn, 1); bn += __shfl_xor(bn, 2); bn += __shfl_xor(bn, 4);
            const float mean = s * (1.0f / 64.0f); float q = 0.f;
#pragma unroll
            for (int i = 0; i < 8; ++i) { o[i] -= mean; q += o[i] * o[i]; }
            q += __shfl_xor(q, 1); q += __shfl_xor(q, 2); q += __shfl_xor(q, 4);
            const float rstd = rsqrtf(q * (1.0f / 64.0f) + A_NORM_EPS);
#pragma unroll
            for (int i = 0; i < 8; ++i) o[i] = (o[i] * rstd * lnw[i] + lnb[i] + bn * v[i]) * g[i];
            float og[8], rg[8];
            unpack8(raw[j].og, og); unpack8(raw[j].rg, rg);
            float ms = 0.f;
#pragma unroll
            for (int i = 0; i < 8; ++i) ms += og[i] * og[i];
            ms += __shfl_xor(ms, 1); ms += __shfl_xor(ms, 2); ms += __shfl_xor(ms, 4); ms += __shfl_xor(ms, 8);
            const float rr = rsqrtf(ms * (1.0f / 128.0f) + LN_EPS);
#pragma unroll
            for (int i = 0; i < 8; ++i) og[i] = og[i] * rr * nw[i] * (rg[i] * sigmoid_f(rg[i]));
            if (m < MT) { *(v4u*)(Y + (size_t)m * 1024 + c8) = pack8(o); *(v4u*)(Y + (size_t)m * 1024 + 512 + c8) = pack8(og); }
        }
    }
}
__device__ __forceinline__ void ln_row_out(float* x0, float* x1, const float* w0, const float* w1, const float* b0, const float* b1, bf16* XB, float* fout, int m, int lane) {
    float s = 0.f;
#pragma unroll
    for (int i = 0; i < 8; ++i) s += x0[i] + x1[i];
    const float mean = wave_sum(s) * (1.0f / 1024.0f); float q = 0.f;
#pragma unroll
    for (int i = 0; i < 8; ++i) { x0[i] -= mean; x1[i] -= mean; q += x0[i] * x0[i] + x1[i] * x1[i]; }
    const float rstd = rsqrtf(wave_sum(q) * (1.0f / 1024.0f) + LN_EPS);
#pragma unroll
    for (int i = 0; i < 8; ++i) { x0[i] = x0[i] * rstd * w0[i] + b0[i]; x1[i] = x1[i] * rstd * w1[i] + b1[i]; }
    if (fout) {
        float* fo = fout + (size_t)m * 1024 + 8 * lane;
        *(f32x4*)(fo) = (f32x4){x0[0], x0[1], x0[2], x0[3]}; *(f32x4*)(fo + 4) = (f32x4){x0[4], x0[5], x0[6], x0[7]};
        *(f32x4*)(fo + 512) = (f32x4){x1[0], x1[1], x1[2], x1[3]}; *(f32x4*)(fo + 516) = (f32x4){x1[4], x1[5], x1[6], x1[7]};
    } else {
        *(v4u*)(XB + (size_t)m * 1024 + 8 * lane) = pack8(x0); *(v4u*)(XB + (size_t)m * 1024 + 512 + 8 * lane) = pack8(x1);
    }
}
__device__ __forceinline__ void ln_phase(const Args& a, const float* w, const float* b, float* fout, int ns) {
    const int tid = tid_opaque(), lane = tid & 63, wave = tid >> 6;
    const int gw = blockIdx.x * NWAVES + wave, ngw = gridDim.x * NWAVES;
    const bf16* Z = (const bf16*)(a.ws + OFF_Z); bf16* XB = (bf16*)(a.ws + OFF_XB);
    float w0[8], w1[8], b0[8], b1[8];
    load8f(w + 8 * lane, w0); load8f(w + 512 + 8 * lane, w1); load8f(b + 8 * lane, b0); load8f(b + 512 + 8 * lane, b1);
    for (int mb = gw; mb < MP; mb += 4 * ngw) {
        v4u r0[4], r1[4];
#pragma unroll
        for (int j = 0; j < 4; ++j) { const int m = mb + j * ngw; const int mc = m < MP ? m : mb;
            r0[j] = *(const v4u*)(Z + (size_t)mc * 1024 + 8 * lane); r1[j] = *(const v4u*)(Z + (size_t)mc * 1024 + 512 + 8 * lane); }
#pragma unroll
        for (int j = 0; j < 4; ++j) {
            const int m = mb + j * ngw;
            float x0[8], x1[8];
            unpack8(r0[j], x0); unpack8(r1[j], x1);
            if (m < MP) ln_row_out(x0, x1, w0, w1, b0, b1, XB, fout, m, lane);
        }
    }
#pragma unroll 1
    for (int m = MP + gw; m < MT; m += ngw) {
        float x0[8], x1[8];
        unpack8(*(const v4u*)(XB + (size_t)m * 1024 + 8 * lane), x0); unpack8(*(const v4u*)(XB + (size_t)m * 1024 + 512 + 8 * lane), x1);
#pragma unroll
        for (int i = 0; i < 8; ++i) { x0[i] *= DN_ALPHA; x1[i] *= DN_ALPHA; }
        const float* zs = (const float*)(a.ws + OFF_G) + (size_t)(m - MP) * 1024 + 8 * lane;
#pragma unroll 1
        for (int sl = 0; sl < ns; ++sl) { float t0[8], t1[8]; load8f(zs + (size_t)sl * 1024 * 1024, t0); load8f(zs + (size_t)sl * 1024 * 1024 + 512, t1);
#pragma unroll
            for (int i = 0; i < 8; ++i) { x0[i] += t0[i]; x1[i] += t1[i]; } }
        ln_row_out(x0, x1, w0, w1, b0, b1, XB, fout, m, lane);
    }
}

#define TR_DPP(x, ctrl) __builtin_bit_cast(float, __builtin_amdgcn_update_dpp(0, __builtin_bit_cast(int, x), ctrl, 0xf, 0xf, false))
__device__ __forceinline__ float transpose_reduce16(const float* p, int g) {
    const bool h1 = (g & 8) != 0, h2 = (g & 4) != 0, h3 = (g & 2) != 0, h4 = (g & 1) != 0;
    float q[8], r[4], t[2];
#pragma unroll
    for (int i = 0; i < 8; ++i) { const float keep = h1 ? p[i + 8] : p[i], send = h1 ? p[i] : p[i + 8]; q[i] = keep + TR_DPP(send, 0x140); }
#pragma unroll
    for (int i = 0; i < 4; ++i) { const float keep = h2 ? q[i + 4] : q[i], send = h2 ? q[i] : q[i + 4]; r[i] = keep + TR_DPP(send, 0x141); }
#pragma unroll
    for (int i = 0; i < 2; ++i) { const float keep = h3 ? r[i + 2] : r[i], send = h3 ? r[i] : r[i + 2]; t[i] = keep + TR_DPP(send, 0x4E); }
    const float keep = h4 ? t[1] : t[0], send = h4 ? t[0] : t[1];
    return keep + TR_DPP(send, 0xB1);
}
constexpr int TC = 16;
constexpr int SCW = 384, SCG = 320;
__device__ __forceinline__ void st8n(LAS float* d, const v4u w) {
    *(LAS f32x4*)(d) = (f32x4){bf_lo(w.x), bf_hi(w.x), bf_lo(w.y), bf_hi(w.y)};
    *(LAS f32x4*)(d + 4) = (f32x4){bf_lo(w.z), bf_hi(w.z), bf_lo(w.w), bf_hi(w.w)};
}
__device__ __forceinline__ void st8(LAS float* d, const v4u w, float sc) {
    *(LAS f32x4*)(d) = (f32x4){bf_lo(w.x) * sc, bf_hi(w.x) * sc, bf_lo(w.y) * sc, bf_hi(w.y) * sc};
    *(LAS f32x4*)(d + 4) = (f32x4){bf_lo(w.z) * sc, bf_hi(w.z) * sc, bf_lo(w.w) * sc, bf_hi(w.w) * sc};
}
typedef float f32x2 __attribute__((ext_vector_type(2)));
#define LO2(v4) (__builtin_shufflevector(v4, v4, 0, 1))
#define HI2(v4) (__builtin_shufflevector(v4, v4, 2, 3))
__device__ __forceinline__ f32x2 fma2(f32x2 a, f32x2 b, f32x2 c) { return __builtin_elementwise_fma(a, b, c); }
__device__ __forceinline__ float rowsum16(float x) {
    x += __builtin_bit_cast(float, __builtin_amdgcn_update_dpp(0, __builtin_bit_cast(int, x), 0x128, 0xf, 0xf, false));
    x += __builtin_bit_cast(float, __builtin_amdgcn_update_dpp(0, __builtin_bit_cast(int, x), 0x124, 0xf, 0xf, false));
    x += __builtin_bit_cast(float, __builtin_amdgcn_update_dpp(0, __builtin_bit_cast(int, x), 0x122, 0xf, 0xf, false));
    x += __builtin_bit_cast(float, __builtin_amdgcn_update_dpp(0, __builtin_bit_cast(int, x), 0x121, 0xf, 0xf, false));
    return x;
}
struct WkvIn { f32x4 r, u, km, kk, ka; float v; };
struct GlaIn { f32x4 q, k, u; float v; };
__device__ __forceinline__ void scan_phase(const Args& a, int e, LAS unsigned char* lds) {
    const int tid = tid_opaque(), lane = tid & 63, wave = tid >> 6;
    const bool isW = wave < 4; const int ltid = tid & 255, lw = wave & 3;
    const int g = lane & 15, rl = lw * 4 + (lane >> 4);
    const bf16* SA = (const bf16*)a.out; const bf16* SB = (const bf16*)(a.ws + OFF_Z);
    const bf16* PB = (const bf16*)(a.ws + OFF_BIG) + (size_t)MT * APROJ;
    bf16* O1 = (bf16*)(a.ws + OFF_R1);
    LAS float* bufW = (LAS float*)lds;
    LAS float* bufG = (LAS float*)(lds + 2 * TC * SCW * 4);
    int ps[3], pp[3];
#pragma unroll
    for (int j = 0; j < 3; ++j) { const int p = ltid + 256 * j; if (isW) { ps[j] = p / 48; pp[j] = p - ps[j] * 48; } else { ps[j] = p / 40; pp[j] = p - ps[j] * 40; } }
    const bool v2ok = isW || (ltid + 512 < 640);
#pragma unroll 1
    for (int it = xcd_vcu(); it < 768; it += gridDim.x) {
        const bool samp = it >= 256; const int wi = samp ? it - 256 : it;
        const int b = wi >> 5; const int T = samp ? TSM : TPR; const size_t row0 = samp ? (size_t)MP + b * TSM : (size_t)b * TPR;
        const int nb = samp ? 16 : 8;
        int h, sub;
        if (isW) { h = (wi >> 2) & 7; sub = wi & 3; } else { h = (wi >> 3) & 3; sub = wi & 7; }
        const int vrow = sub * 16 + rl;
        f32x2 P0 = {0.f, 0.f}, P1 = {0.f, 0.f};
        if (samp) {
            if (isW) { const f32x4 S = *(const f32x4*)(a.in[2] + ((((size_t)e * 16 + b) * 8 + h) * 64 + vrow) * 64 + 4 * g); P0 = LO2(S); P1 = HI2(S); }
            else { const float* s0 = a.in[4] + (((size_t)e * 16 + b) * 4 + h) * 8192 + vrow;
                P0 = (f32x2){s0[(4 * g + 0) * 128], s0[(4 * g + 1) * 128]}; P1 = (f32x2){s0[(4 * g + 2) * 128], s0[(4 * g + 3) * 128]}; }
        }
        const int nc = T / TC;
        bf16* obase = isW ? O1 + (row0 + g) * 1024 + h * 64 + vrow : O1 + (row0 + g) * 1024 + 512 + h * 128 + vrow;
        v4u pre[3];
        unsigned so[3];
#pragma unroll
        for (int j = 0; j < 3; ++j) { const unsigned row = (unsigned)row0 + ps[j];
            if (isW) so[j] = pp[j] < 32 ? (row * 8 + h) * 256 + pp[j] * 8 : (row * 8 + h) * 128 + (pp[j] - 32) * 8;
            else so[j] = pp[j] < 32 ? row * APROJ + h * 256 + pp[j] * 8 : row * APROJ + 1536 + h * 64 + (pp[j] - 32) * 8; }
#define SCAN_ISSUE(t0) do { _Pragma("unroll") for (int j = 0; j < 3; ++j) { const bf16* src = (isW ? (pp[j] < 32 ? SA : SB) : PB) + so[j]; \
            if (j < 2 || v2ok) pre[j] = *(const v4u*)src; so[j] += isW ? (pp[j] < 32 ? TC * 2048 : TC * 1024) : TC * APROJ; } } while (0)
#define SCAN_COMMIT(bi) do { _Pragma("unroll") for (int j = 0; j < 3; ++j) { if (j < 2 || v2ok) { \
            if (isW) st8n(bufW + ((bi) * TC + ps[j]) * SCW + pp[j] * 8, pre[j]); else st8n(bufG + ((bi) * TC + ps[j]) * SCG + pp[j] * 8, pre[j]); } } } while (0)
        __syncthreads();
        SCAN_ISSUE(0); SCAN_COMMIT(0);
        __syncthreads();
#pragma unroll 1
        for (int c = 0; c < nc; ++c) {
            const int bi = c & 1;
            if (c + 1 < nc) SCAN_ISSUE((c + 1) * TC);
            float oacc = 0.f; float op[16];
            if (isW) {
                const LAS float* bw = bufW + bi * TC * SCW + 4 * g; const LAS float* bv = bufW + bi * TC * SCW + 192 + vrow;
#define WKV_LOAD(d, s) do { const LAS float* p_ = bw + (s) * SCW; d.r = *(const LAS f32x4*)(p_); d.u = *(const LAS f32x4*)(p_ + 64); d.km = *(const LAS f32x4*)(p_ + 128); \
                    d.kk = *(const LAS f32x4*)(p_ + 256); d.ka = *(const LAS f32x4*)(p_ + 320); d.v = bv[(s) * SCW]; } while (0)
                WkvIn in[3];
                WKV_LOAD(in[0], 0); WKV_LOAD(in[1], 1);
#pragma unroll
                for (int s = 0; s < TC; ++s) {
                    if (s + 2 < TC) WKV_LOAD(in[(s + 2) % 3], s + 2);
                    __builtin_amdgcn_sched_barrier(0);
                    const WkvIn& x = in[s % 3];
                    const f32x2 vv = {x.v, x.v};
                    const f32x2 s2 = fma2(P1, HI2(x.kk), P0 * LO2(x.kk));
                    const f32x2 T0 = fma2(vv, LO2(x.km), fma2(-LO2(x.u), P0, P0)), T1 = fma2(vv, HI2(x.km), fma2(-HI2(x.u), P1, P1));
                    const float sa = rowsum16(s2.x + s2.y);
                    const f32x2 ns = {-sa, -sa};
                    P0 = fma2(ns, LO2(x.ka), T0); P1 = fma2(ns, HI2(x.ka), T1);
                    const f32x2 o2 = fma2(P1, HI2(x.r), P0 * LO2(x.r));
                    op[s] = o2.x + o2.y;
                }
                oacc = transpose_reduce16(op, g);
#undef WKV_LOAD
            } else {
                const LAS float* bg = bufG + bi * TC * SCG + 4 * g; const LAS float* bv = bufG + bi * TC * SCG + 128 + vrow;
#define GLA_LOAD(d, s) do { const LAS float* p_ = bg + (s) * SCG; d.q = *(const LAS f32x4*)(p_); d.k = *(const LAS f32x4*)(p_ + 64); d.u = *(const LAS f32x4*)(p_ + 256); d.v = bv[(s) * SCG]; } while (0)
                GlaIn in[3];
                GLA_LOAD(in[0], 0); GLA_LOAD(in[1], 1);
#pragma unroll
                for (int s = 0; s < TC; ++s) {
                    if (s + 2 < TC) GLA_LOAD(in[(s + 2) % 3], s + 2);
                    __builtin_amdgcn_sched_barrier(0);
                    const GlaIn& x = in[s % 3];
                    const f32x2 vv = {x.v, x.v};
                    P0 = fma2(vv, LO2(x.k), fma2(-LO2(x.u), P0, P0)); P1 = fma2(vv, HI2(x.k), fma2(-HI2(x.u), P1, P1));
                    const f32x2 o2 = fma2(P1, HI2(x.q), P0 * LO2(x.q));
                    op[s] = o2.x + o2.y;
                }
                oacc = transpose_reduce16(op, g);
#undef GLA_LOAD
            }
            obase[(size_t)c * TC * 1024] = (bf16)(cvt_pk_bf16(isW ? oacc : oacc * 0.125f, 0.f) & 0xffffu);
            if (c + 1 < nc) SCAN_COMMIT(bi ^ 1);
            __syncthreads();
        }
#undef SCAN_ISSUE
#undef SCAN_COMMIT
        if (isW) { float* so = a.out + (samp ? O_SWKV : O_PWKV) + ((((size_t)e * nb + b) * 8 + h) * 64 + vrow) * 64 + 4 * g; *(f32x4*)so = (f32x4){P0.x, P0.y, P1.x, P1.y}; }
        else { float* so = a.out + (samp ? O_SGLA : O_PGLA) + (((size_t)e * nb + b) * 4 + h) * 8192 + vrow;
            so[(4 * g + 0) * 128] = P0.x; so[(4 * g + 1) * 128] = P0.y; so[(4 * g + 2) * 128] = P1.x; so[(4 * g + 3) * 128] = P1.y; }
    }
    const bf16* PA = (const bf16*)(a.ws + OFF_BIG);
    for (int idx = blockIdx.x * NTHREADS + tid; idx < 24 * APROJ; idx += gridDim.x * NTHREADS) {
        const int bb = idx / APROJ, c = idx - bb * APROJ;
        if (bb < 8) a.out[O_PSHIFT + ((size_t)e * 8 + bb) * APROJ + c] = bf_lo((unsigned)PA[((size_t)bb * TPR + TPR - 1) * APROJ + c]);
        else a.out[O_SSHIFT + ((size_t)e * 16 + (bb - 8)) * APROJ + c] = bf_lo((unsigned)PA[((size_t)MP + (bb - 8) * TSM + TSM - 1) * APROJ + c]);
    }
}

constexpr int KEXT = 8192, LDV = MT + KEXT;
constexpr size_t BIG_K = (size_t)MT * 1024, BIG_VT = (size_t)(2 * MT + KEXT) * 1024;
__device__ __forceinline__ bf16x8 ld_frag(const bf16* p) { return __builtin_bit_cast(bf16x8, *(const v4u*)p); }
__device__ __forceinline__ void cache_convert(const Args& a, int o) {
    const int tid = tid_opaque();
    const int gt = blockIdx.x * NTHREADS + tid, ngt = gridDim.x * NTHREADS;
    bf16* Kb = (bf16*)(a.ws + OFF_BIG) + BIG_K; bf16* Vt = (bf16*)(a.ws + OFF_BIG) + BIG_VT;
    const float* ck = a.in[5] + (size_t)o * 16 * 16 * 512 * 64; const float* cv = a.in[6] + (size_t)o * 16 * 16 * 512 * 64;
    for (int idx = gt; idx < 16 * 16 * 512 * 8; idx += ngt) {
        const int d8 = idx & 7, key = (idx >> 3) & 511, h = (idx >> 12) & 15, b = idx >> 16;
        float f[8]; load8f(ck + (size_t)idx * 8, f);
        *(v4u*)(Kb + ((size_t)MT + b * 512 + key) * 1024 + h * 64 + d8 * 8) = pack8(f);
    }
    for (int idx = gt; idx < 16 * 16 * 64 * 64; idx += ngt) {
        const int d = idx & 63, k8 = (idx >> 6) & 63, h = (idx >> 12) & 15, b = idx >> 16;
        const float* src = cv + (((size_t)b * 16 + h) * 512 + k8 * 8) * 64 + d; float f[8];
#pragma unroll
        for (int j = 0; j < 8; ++j) f[j] = src[j * 64];
        *(v4u*)(Vt + (size_t)(h * 64 + d) * LDV + MT + b * 512 + k8 * 8) = pack8(f);
    }
}
__device__ __forceinline__ void attn_phase(const Args& a, int o, LAS unsigned char* lds) {
    const int tid = tid_opaque(), lane = tid & 63, wave = tid >> 6;
    const int gw = blockIdx.x * NWAVES + wave, ngw = gridDim.x * NWAVES;
    const bf16* Q = (const bf16*)(a.ws + OFF_BIG); const bf16* Kb = Q + BIG_K; const bf16* Vt = Q + BIG_VT;
    bf16* O = (bf16*)(a.ws + OFF_R1);
    LAS float* bias = (LAS float*)lds;
    constexpr int KVP = 72;
    LAS bf16* KT = (LAS bf16*)(lds + 16512);
    LAS bf16* VT = KT + 2 * 64 * KVP;
    for (int i = tid; i < 16 * 257; i += NTHREADS) bias[i] = a.in[24][(size_t)o * 16 * 257 + i] * 1.4426950408889634f;
    __syncthreads();
    const int i16 = lane & 15, g = lane >> 4;
    const int keyoff = 8 * (i16 >> 2) + (i16 & 3);
    {
        const int wu = __builtin_amdgcn_readfirstlane(wave);
        const int srow = tid >> 3, sseg = (tid & 7) * 8;
#pragma unroll 1
        for (int unit = xcd_vcu(); unit < 4096; unit += gridDim.x) {
            const int b = unit >> 9, h = (unit >> 5) & 15, c0 = (unit & 31) * 4;
            const int c = c0 + (wu >> 1), half = wu & 1;
            const size_t qrow0 = (size_t)b * TPR + c * 64 + half * 32;
            const int qpos0 = c * 64 + half * 32;
            const int kc_lo = c0 >= 8 ? c0 - 8 : 0, kc_hi = c0 + 3, my_lo = c >= 8 ? c - 8 : 0;
            const LAS float* bh = bias + h * 257 + 128;
            const float bfar = bh[128];
            bf16x8 qf[2][2];
#pragma unroll
            for (int qt = 0; qt < 2; ++qt)
#pragma unroll
                for (int kk = 0; kk < 2; ++kk) qf[qt][kk] = ld_frag(Q + (qrow0 + 16 * qt + i16) * 1024 + h * 64 + 32 * kk + 8 * g);
            f32x4 ot[4][2];
#pragma unroll
            for (int dt = 0; dt < 4; ++dt) { ot[dt][0] = (f32x4){0.f, 0.f, 0.f, 0.f}; ot[dt][1] = (f32x4){0.f, 0.f, 0.f, 0.f}; }
            float mrun[2] = {-1e30f, -1e30f}, lrun[2] = {0.f, 0.f};
            const bf16* kg_ = Kb + ((size_t)b * TPR + srow) * 1024 + h * 64 + sseg;
            const bf16* vg_ = Vt + (size_t)(h * 64 + srow) * LDV + (size_t)b * TPR + sseg;
            v4u kreg = *(const v4u*)(kg_ + (size_t)(64 * kc_lo) * 1024), vreg = *(const v4u*)(vg_ + 64 * kc_lo);
            *(LAS v4u*)(KT + srow * KVP + sseg) = kreg; *(LAS v4u*)(VT + srow * KVP + sseg) = vreg;
            kreg = *(const v4u*)(kg_ + (size_t)(64 * (kc_lo + 1)) * 1024); vreg = *(const v4u*)(vg_ + 64 * (kc_lo + 1));
            v4u kreg2 = kreg, vreg2 = vreg;
            __syncthreads();
#pragma unroll 1
            for (int kc = kc_lo; kc <= kc_hi; ++kc) {
                const int buf = (kc - kc_lo) & 1;
                if (kc + 2 <= kc_hi) { kreg2 = *(const v4u*)(kg_ + (size_t)(64 * (kc + 2)) * 1024); vreg2 = *(const v4u*)(vg_ + 64 * (kc + 2)); }
                if (kc >= my_lo && kc <= c) {
                    const int kpos0 = 64 * kc;
                    const LAS bf16* kt = KT + buf * 64 * KVP + keyoff * KVP + 8 * g; const LAS bf16* vt = VT + buf * 64 * KVP + i16 * KVP + 8 * g;
                    f32x4 st[4][2];
#pragma unroll
                    for (int t4 = 0; t4 < 4; ++t4) {
                        const LAS bf16* p = kt + (32 * (t4 >> 1) + 4 * (t4 & 1)) * KVP;
                        const bf16x8 k0 = *(const LAS bf16x8*)p, k1 = *(const LAS bf16x8*)(p + 32);
#pragma unroll
                        for (int qt = 0; qt < 2; ++qt) {
                            f32x4 acc = {0.f, 0.f, 0.f, 0.f};
                            acc = __builtin_amdgcn_mfma_f32_16x16x32_bf16(k0, qf[qt][0], acc, 0, 0, 0);
                            acc = __builtin_amdgcn_mfma_f32_16x16x32_bf16(k1, qf[qt][1], acc, 0, 0, 0);
                            st[t4][qt] = acc;
                        }
                    }
                    const bool far = qpos0 - (kpos0 + 63) >= 128;
                    bf16x8 pf[2][2];
#pragma unroll
                    for (int qt = 0; qt < 2; ++qt) {
                        const int qpos = qpos0 + 16 * qt + i16;
                        float mx = -1e30f;
                        float boff = 0.f;
                        if (far) {
#pragma unroll
                            for (int t4 = 0; t4 < 4; ++t4)
#pragma unroll
                                for (int j = 0; j < 4; ++j) mx = fmaxf(mx, st[t4][qt][j]);
                            mx += bfar; boff = bfar;
                        } else {
#pragma unroll
                            for (int t4 = 0; t4 < 4; ++t4)
#pragma unroll
                                for (int j = 0; j < 4; ++j) {
                                    int rel = qpos - (kpos0 + 32 * (t4 >> 1) + 8 * g + 4 * (t4 & 1) + j); rel = rel > 128 ? 128 : (rel < -128 ? -128 : rel);
                                    const float sv = st[t4][qt][j] + bh[rel]; st[t4][qt][j] = sv; mx = fmaxf(mx, sv);
                                }
                        }
                        mx = fmaxf(mx, __shfl_xor(mx, 16)); mx = fmaxf(mx, __shfl_xor(mx, 32));
                        const float mnew = fmaxf(mrun[qt], mx), corr = __builtin_amdgcn_exp2f(mrun[qt] - mnew), msub = mnew - boff; mrun[qt] = mnew;
                        float psum = 0.f;
#pragma unroll
                        for (int sb = 0; sb < 2; ++sb) {
                            float p[8];
#pragma unroll
                            for (int T = 0; T < 2; ++T)
#pragma unroll
                                for (int j = 0; j < 4; ++j) { p[4 * T + j] = __builtin_amdgcn_exp2f(st[2 * sb + T][qt][j] - msub); psum += p[4 * T + j]; }
                            pf[sb][qt] = __builtin_bit_cast(bf16x8, pack8(p));
                        }
                        lrun[qt] = lrun[qt] * corr + psum;
#pragma unroll
                        for (int dt = 0; dt < 4; ++dt) ot[dt][qt] *= corr;
                    }
#pragma unroll
                    for (int sb = 0; sb < 2; ++sb)
#pragma unroll
                        for (int dt = 0; dt < 4; ++dt) {
                            const bf16x8 vf = *(const LAS bf16x8*)(vt + 16 * dt * KVP + 32 * sb);
#pragma unroll
                            for (int qt = 0; qt < 2; ++qt) ot[dt][qt] = __builtin_amdgcn_mfma_f32_16x16x32_bf16(vf, pf[sb][qt], ot[dt][qt], 0, 0, 0);
                        }
                }
                if (kc < kc_hi) { *(LAS v4u*)(KT + (buf ^ 1) * 64 * KVP + srow * KVP + sseg) = kreg; *(LAS v4u*)(VT + (buf ^ 1) * 64 * KVP + srow * KVP + sseg) = vreg; }
                kreg = kreg2; vreg = vreg2;
                __syncthreads();
            }
#pragma unroll
            for (int qt = 0; qt < 2; ++qt) {
                float l = lrun[qt]; l += __shfl_xor(l, 16); l += __shfl_xor(l, 32);
                const float inv = 1.0f / l;
                bf16* op = O + (qrow0 + 16 * qt + i16) * 1024 + h * 64 + 4 * g;
#pragma unroll
                for (int dt = 0; dt < 4; ++dt) { const f32x4 v = ot[dt][qt] * inv; v2u w; w.x = cvt_pk_bf16(v[0], v[1]); w.y = cvt_pk_bf16(v[2], v[3]); *(v2u*)(op + 16 * dt) = w; }
            }
        }
    }
#pragma unroll 1
    for (int it = 32768 + gw; it < 32768 + 512; it += ngw) {
        const bool samp = it >= 32768;
        int b, c, h, half;
        if (!samp) { b = it >> 12; c = (it >> 5) & 127; h = (it >> 1) & 15; half = it & 1; }
        else { const int r = it - 32768; b = r >> 5; c = 8; h = (r >> 1) & 15; half = r & 1; }
        const size_t qrow0 = samp ? (size_t)MP + b * 64 + half * 32 : (size_t)b * TPR + c * 64 + half * 32;
        const int qpos0 = c * 64 + half * 32;
        const int kstart = c >= 8 ? c * 64 - 512 : 0, nkb = (c * 64 + 64 - kstart) >> 6;
        const size_t kbase = samp ? (size_t)MT + b * 512 : (size_t)b * TPR + kstart;
        const size_t knew = (size_t)MP + b * 64;
        const LAS float* bh = bias + h * 257 + 128;
        const float bfar = bh[128];
        bf16x8 qf[2][2];
#pragma unroll
        for (int qt = 0; qt < 2; ++qt)
#pragma unroll
            for (int kk = 0; kk < 2; ++kk) qf[qt][kk] = ld_frag(Q + (qrow0 + 16 * qt + i16) * 1024 + h * 64 + 32 * kk + 8 * g);
        f32x4 ot[4][2];
#pragma unroll
        for (int dt = 0; dt < 4; ++dt) { ot[dt][0] = (f32x4){0.f, 0.f, 0.f, 0.f}; ot[dt][1] = (f32x4){0.f, 0.f, 0.f, 0.f}; }
        float mrun[2] = {-1e30f, -1e30f}, lrun[2] = {0.f, 0.f};
        bf16x8 kc[4][2], kn[4][2];
        {   const bf16* kp = Kb + (kbase + keyoff) * 1024 + h * 64 + 8 * g;
#pragma unroll
            for (int t4 = 0; t4 < 4; ++t4) { const bf16* p = kp + (size_t)(32 * (t4 >> 1) + 4 * (t4 & 1)) * 1024; kc[t4][0] = ld_frag(p); kc[t4][1] = ld_frag(p + 32); } }
#pragma unroll 1
        for (int kb = 0; kb < nkb; ++kb) {
            const int kpos0 = kstart + 64 * kb;
            const size_t krow0 = (samp && kb == 8) ? knew : kbase + 64 * kb;
            bf16x8 vf[2][4];
            {   const bf16* vp = Vt + (size_t)(h * 64 + i16) * LDV + krow0 + 8 * g;
#pragma unroll
                for (int sb = 0; sb < 2; ++sb)
#pragma unroll
                    for (int dt = 0; dt < 4; ++dt) vf[sb][dt] = ld_frag(vp + (size_t)(16 * dt) * LDV + 32 * sb); }
            if (kb + 1 < nkb) {
                const size_t krow1 = (samp && kb + 1 == 8) ? knew : kbase + 64 * (kb + 1);
                const bf16* kp = Kb + (krow1 + keyoff) * 1024 + h * 64 + 8 * g;
#pragma unroll
                for (int t4 = 0; t4 < 4; ++t4) { const bf16* p = kp + (size_t)(32 * (t4 >> 1) + 4 * (t4 & 1)) * 1024; kn[t4][0] = ld_frag(p); kn[t4][1] = ld_frag(p + 32); }
            }
            f32x4 st[4][2];
#pragma unroll
            for (int t4 = 0; t4 < 4; ++t4)
#pragma unroll
                for (int qt = 0; qt < 2; ++qt) {
                    f32x4 acc = {0.f, 0.f, 0.f, 0.f};
                    acc = __builtin_amdgcn_mfma_f32_16x16x32_bf16(kc[t4][0], qf[qt][0], acc, 0, 0, 0);
                    acc = __builtin_amdgcn_mfma_f32_16x16x32_bf16(kc[t4][1], qf[qt][1], acc, 0, 0, 0);
                    st[t4][qt] = acc;
                }
            const bool far = qpos0 - (kpos0 + 63) >= 128;
            bf16x8 pf[2][2];
#pragma unroll
            for (int qt = 0; qt < 2; ++qt) {
                const int qpos = qpos0 + 16 * qt + i16;
                float mx = -1e30f;
                float boff = 0.f;
                if (far) {
#pragma unroll
                    for (int t4 = 0; t4 < 4; ++t4)
#pragma unroll
                        for (int j = 0; j < 4; ++j) mx = fmaxf(mx, st[t4][qt][j]);
                    mx += bfar; boff = bfar;
                } else {
#pragma unroll
                    for (int t4 = 0; t4 < 4; ++t4)
#pragma unroll
                        for (int j = 0; j < 4; ++j) {
                            int rel = qpos - (kpos0 + 32 * (t4 >> 1) + 8 * g + 4 * (t4 & 1) + j); rel = rel > 128 ? 128 : (rel < -128 ? -128 : rel);
                            const float s = st[t4][qt][j] + bh[rel]; st[t4][qt][j] = s; mx = fmaxf(mx, s);
                        }
                }
                mx = fmaxf(mx, __shfl_xor(mx, 16)); mx = fmaxf(mx, __shfl_xor(mx, 32));
                const float mnew = fmaxf(mrun[qt], mx), corr = __builtin_amdgcn_exp2f(mrun[qt] - mnew), msub = mnew - boff; mrun[qt] = mnew;
                float psum = 0.f;
#pragma unroll
                for (int sb = 0; sb < 2; ++sb) {
                    float p[8];
#pragma unroll
                    for (int T = 0; T < 2; ++T)
#pragma unroll
                        for (int j = 0; j < 4; ++j) { p[4 * T + j] = __builtin_amdgcn_exp2f(st[2 * sb + T][qt][j] - msub); psum += p[4 * T + j]; }
                    pf[sb][qt] = __builtin_bit_cast(bf16x8, pack8(p));
                }
                lrun[qt] = lrun[qt] * corr + psum;
#pragma unroll
                for (int dt = 0; dt < 4; ++dt) ot[dt][qt] *= corr;
            }
#pragma unroll
            for (int sb = 0; sb < 2; ++sb)
#pragma unroll
                for (int dt = 0; dt < 4; ++dt)
#pragma unroll
                    for (int qt = 0; qt < 2; ++qt) ot[dt][qt] = __builtin_amdgcn_mfma_f32_16x16x32_bf16(vf[sb][dt], pf[sb][qt], ot[dt][qt], 0, 0, 0);
#pragma unroll
            for (int t4 = 0; t4 < 4; ++t4) { kc[t4][0] = kn[t4][0]; kc[t4][1] = kn[t4][1]; }
        }
#pragma unroll
        for (int qt = 0; qt < 2; ++qt) {
            float l = lrun[qt]; l += __shfl_xor(l, 16); l += __shfl_xor(l, 32);
            const float inv = 1.0f / l;
            bf16* op = O + (qrow0 + 16 * qt + i16) * 1024 + h * 64 + 4 * g;
#pragma unroll
            for (int dt = 0; dt < 4; ++dt) { const f32x4 v = ot[dt][qt] * inv; v2u w; w.x = cvt_pk_bf16(v[0], v[1]); w.y = cvt_pk_bf16(v[2], v[3]); *(v2u*)(op + 16 * dt) = w; }
        }
    }
    const int gt = blockIdx.x * NTHREADS + tid, ngt = gridDim.x * NTHREADS;
    for (int idx = gt; idx < 8 * 16 * 512 * 8; idx += ngt) {
        const int d8 = idx & 7, r = (idx >> 3) & 511, h = (idx >> 12) & 15, b = idx >> 16;
        float f[8]; unpack8(*(const v4u*)(Kb + ((size_t)b * TPR + 7680 + r) * 1024 + h * 64 + d8 * 8), f);
        float* dst = a.out + O_PK + ((((size_t)o * 8 + b) * 16 + h) * 512 + r) * 64 + d8 * 8;
        *(f32x4*)dst = (f32x4){f[0], f[1], f[2], f[3]}; *(f32x4*)(dst + 4) = (f32x4){f[4], f[5], f[6], f[7]};
    }
    for (int idx = gt; idx < 8 * 16 * 64 * 64; idx += ngt) {
        const int r8 = idx & 63, d = (idx >> 6) & 63, h = (idx >> 12) & 15, b = idx >> 16;
        float f[8]; unpack8(*(const v4u*)(Vt + (size_t)(h * 64 + d) * LDV + (size_t)b * TPR + 7680 + r8 * 8), f);
        float* dst = a.out + O_PV + ((((size_t)o * 8 + b) * 16 + h) * 512 + r8 * 8) * 64 + d;
#pragma unroll
        for (int j = 0; j < 8; ++j) dst[j * 64] = f[j];
    }
    for (int idx = gt; idx < 16 * 16 * 64 * 8; idx += ngt) {
        const int d8 = idx & 7, t = (idx >> 3) & 63, h = (idx >> 9) & 15, b = idx >> 13;
        float f[8]; unpack8(*(const v4u*)(Kb + ((size_t)MP + b * 64 + t) * 1024 + h * 64 + d8 * 8), f);
        float* dst = a.out + O_SK + ((((size_t)o * 16 + b) * 16 + h) * 64 + t) * 64 + d8 * 8;
        *(f32x4*)dst = (f32x4){f[0], f[1], f[2], f[3]}; *(f32x4*)(dst + 4) = (f32x4){f[4], f[5], f[6], f[7]};
    }
    for (int idx = gt; idx < 16 * 16 * 64 * 8; idx += ngt) {
        const int t8 = idx & 7, d = (idx >> 3) & 63, h = (idx >> 9) & 15, b = idx >> 13;
        float f[8]; unpack8(*(const v4u*)(Vt + (size_t)(h * 64 + d) * LDV + (size_t)MP + b * 64 + t8 * 8), f);
        float* dst = a.out + O_SV + ((((size_t)o * 16 + b) * 16 + h) * 64 + t8 * 8) * 64 + d;
#pragma unroll
        for (int j = 0; j < 8; ++j) dst[j * 64] = f[j];
    }
}

#define XB_TMO      128
#define XB_XCNT(j)  (256  + 64 * (j))
#define XB_XSUB(j)  (1280 + 64 * (j))
#define XB_XGEN(j)  (2304 + 64 * (j))
#define XB_TOP      3328
#define XB_TOPGEN   3392
#define XCD_BAR_WORDS 3456
#define XB_SPIN_CAP (1u << 18)

__device__ __forceinline__ unsigned xb_ld(unsigned* p)              { return __hip_atomic_load(p, __ATOMIC_RELAXED, __HIP_MEMORY_SCOPE_AGENT); }
__device__ __forceinline__ unsigned xb_add(unsigned* p, unsigned v) { return __hip_atomic_fetch_add(p, v, __ATOMIC_RELAXED, __HIP_MEMORY_SCOPE_AGENT); }
__device__ __forceinline__ unsigned xb_xcc_id() { return (unsigned)__builtin_amdgcn_s_getreg((3 << 11) | 20) & 0xFu; }
#define XB_SPIN(cond, bar) do { unsigned _sp = 0; while (cond) { __builtin_amdgcn_s_sleep(1); \
    if ((++_sp & 255u) == 0u) { if (xb_ld(&(bar)[XB_TMO])) break; if (_sp > XB_SPIN_CAP) { atomicAdd(&(bar)[XB_TMO], 1u); break; } } } } while (0)

struct XcdBarrier {
    unsigned* bar; unsigned x;
    volatile LAS unsigned* st;
};

__device__ __forceinline__ XcdBarrier xcd_barrier_post(unsigned* bar, volatile LAS unsigned* st) {
    XcdBarrier b; b.bar = bar; b.x = xb_xcc_id(); b.st = st;
    if (threadIdx.x == 0) (void)xb_add(&bar[XB_XCNT(b.x)], 1u);
    return b;
}
__device__ __forceinline__ void xcd_barrier_complete(unsigned* bar, unsigned x, unsigned& nloc, unsigned& nx) {
    const unsigned G = gridDim.x * gridDim.y * gridDim.z;
    unsigned sum, cnt, mine, sp = 0u;
    for (;;) {
        sum = 0u; cnt = 0u; mine = 0u;
#pragma unroll
        for (unsigned j = 0; j < 16; ++j) { const unsigned c = xb_ld(&bar[XB_XCNT(j)]); sum += c; cnt += (c > 0u) ? 1u : 0u; mine = (j == x) ? c : mine; }
        if (sum == G) break;
        __builtin_amdgcn_s_sleep(1);
        if ((++sp & 255u) == 0u) { if (xb_ld(&bar[XB_TMO])) break; if (sp > XB_SPIN_CAP) { atomicAdd(&bar[XB_TMO], 1u); break; } }
    }
    nloc = mine > 0u ? mine : 1u; nx = cnt > 0u ? cnt : 1u;
}

__device__ __forceinline__ void xcd_barrier(const XcdBarrier& b) {
    asm volatile("s_waitcnt vmcnt(0)" ::: "memory");
    __syncthreads();
    if (threadIdx.x == 0) {
        unsigned* bar = b.bar;
        __builtin_amdgcn_s_waitcnt(0);
        unsigned nloc = b.st[0], nx = b.st[1];
        if (nloc == 0u) { xcd_barrier_complete(bar, b.x, nloc, nx); b.st[0] = nloc; b.st[1] = nx; }
        const unsigned old = xb_add(&bar[XB_XSUB(b.x)], 1u);
        const unsigned gen = old / nloc;
        if (old + 1u == (gen + 1u) * nloc) {
            __builtin_amdgcn_fence(__ATOMIC_RELEASE, "agent");
            asm volatile("s_waitcnt vmcnt(0)" ::: "memory");
            const unsigned og = xb_add(&bar[XB_TOP], 1u);
            const unsigned tg = og / nx;
            if (og + 1u == (tg + 1u) * nx) xb_add(&bar[XB_TOPGEN], 1u);
            else XB_SPIN(xb_ld(&bar[XB_TOPGEN]) == tg, bar);
            __builtin_amdgcn_fence(__ATOMIC_ACQUIRE, "agent");
            xb_add(&bar[XB_XGEN(b.x)], 1u);
            asm volatile("s_waitcnt vmcnt(0)" ::: "memory");
        } else {
            XB_SPIN(xb_ld(&bar[XB_XGEN(b.x)]) == gen, bar);
            __builtin_amdgcn_fence(__ATOMIC_ACQUIRE, "agent");
            asm volatile("s_waitcnt vmcnt(0)" ::: "memory");
        }
    }
    __syncthreads();
}

#ifndef REP_GEMM
#define REP_GEMM 1
#endif
#ifndef REP_SCAN
#define REP_SCAN 1
#endif
#ifndef REP_ATTN
#define REP_ATTN 1
#endif
#ifndef REP_LN
#define REP_LN 1
#endif
#ifndef EXTRA_SYNC
#define EXTRA_SYNC 2
#endif
#ifndef PH_STOP
#define PH_STOP N_PHASES
#endif
#ifndef PHMASK
#define PHMASK 0xffff
#endif
#define PHM(i) (((PHMASK) >> (i)) & 1)
constexpr int NS_K1 = 4, NS_K2 = 11;
constexpr int PH_PER_PAIR = 19, N_PHASES = 1 + 2 * PH_PER_PAIR;
__global__ void __launch_bounds__(NTHREADS, 2) trunk_fwd(Args a) {
    __shared__ __attribute__((aligned(16))) unsigned char lds_raw[LDS_BYTES];
    LAS unsigned char* lds = (LAS unsigned char*)lds_raw;
    cg::grid_group grid = cg::this_grid();
    volatile LAS unsigned* bar_st = (volatile LAS unsigned*)(lds + 131072);
    if (threadIdx.x < 2) bar_st[threadIdx.x] = 0u;
    __syncthreads();
    XcdBarrier xbar = xcd_barrier_post((unsigned*)(a.ws + WS_BAR), bar_st);
    unsigned char* ws = a.ws;
    bf16* XB = (bf16*)(ws + OFF_XB); bf16* R1 = (bf16*)(ws + OFF_R1); bf16* Z = (bf16*)(ws + OFF_Z); bf16* BIG = (bf16*)(ws + OFF_BIG);
    const int G = gridDim.x, cb = blockIdx.x;
#pragma unroll 1
    for (int ph = a.ph_lo; ph < a.ph_hi; ++ph) {
        bool nosync = false;
        if (ph == 0) { if (PHM(0)) prologue_phase(a, lds); }
        else {
            const int e = (ph - 1) / PH_PER_PAIR, q = (ph - 1) - e * PH_PER_PAIR;
            const int layer = 2 * e + (q >= 11 ? 1 : 0);
            int kind = -1; pg8::Gemm g{nullptr, nullptr, MT, 0, 0, nullptr, nullptr};
            pg8::EpiBf16 eb{nullptr, 0, 0, 0, 1.f, nullptr, 0}; int m2 = 0, n2 = 0;
            switch (q) {
            case 0:  kind = 0; g = pg8::Gemm{XB, (const bf16*)(ws + W_IN + e * W_IN_SZ), MT, NMIX, 1024, nullptr, nullptr}; eb = pg8::EpiBf16{BIG, APROJ, APROJ, (size_t)MT * APROJ, 1.f, nullptr, 0}; break;
            case 2:  kind = 0; g = pg8::Gemm{Z, (const bf16*)(ws + W_LO + e * W_LO_SZ), MT, NLORA, KLORA, nullptr, nullptr}; eb = pg8::EpiBf16{R1, 512, 512, (size_t)MT * 512, 1.f, nullptr, 0}; break;
            case 11: kind = 0; g = pg8::Gemm{XB, (const bf16*)(ws + W_QKV + e * W_QKV_SZ), MT, 2048, 1024, (const bf16*)(ws + W_QKV + e * W_QKV_SZ) + (size_t)2048 * 1024, XB};
                     eb = pg8::EpiBf16{BIG, 1024, 1024, (size_t)MT * 1024, 0.125f * 1.4426950408889634f, BIG + BIG_VT, LDV}; m2 = 1024; n2 = MT; break;
            case 12: nosync = true; break;
            case 8: case 16: kind = 1; g = pg8::Gemm{XB, (const bf16*)(ws + W_FI + layer * W_FI_SZ), MT, 2 * FH, 1024, nullptr, nullptr}; break;
            case 6:  kind = 2; g = pg8::Gemm{R1, (const bf16*)(ws + W_OM + e * W_SQ_SZ), MT, 1024, 1024, nullptr, nullptr}; break;
            case 14: kind = 2; g = pg8::Gemm{R1, (const bf16*)(ws + W_O + e * W_SQ_SZ), MT, 1024, 1024, nullptr, nullptr}; break;
            case 9: case 17: kind = 2; g = pg8::Gemm{BIG, (const bf16*)(ws + W_FO + layer * W_FO_SZ), MT, 1024, FH, nullptr, nullptr}; break;
            default: break;
            }
            const int nrep = kind >= 0 ? REP_GEMM : (q == 4 ? REP_SCAN : (q == 13 ? REP_ATTN : ((q == 7 || q == 15 || q == 10 || q == 18) ? REP_LN : 1)));
            if (q == 11) cache_convert(a, e);
#pragma unroll 1
            for (int rep = 0; rep < nrep; ++rep) {
            if (kind == 0 && PHM(1)) { pg8::StaticOrder S; S.init(g.M, g.N, G, cb, g.K, q == 2 ? 1 : 0); if (m2) S.second(m2, n2); pg8::gemm_phase<pg8::EpiBf16, pg8::StaticOrder, true, true>(lds, g, S, eb); }
            else if (kind == 1 && PHM(2)) { pg8::StaticOrder S; S.init(g.M, g.N, G, cb, g.K); pg8::EpiSwiglu es{BIG, FH}; pg8::gemm_phase<pg8::EpiSwiglu, pg8::StaticOrder, true, true>(lds, g, S, es); }
            else if (kind == 2 && PHM(3)) { pg8::SplitOrder S; S.init(G, cb, g.K, g.K == 1024 ? NS_K1 : NS_K2); pg8::EpiResid er{XB, Z, 1024, DN_ALPHA, (float*)(ws + OFF_G)}; pg8::gemm_phase<pg8::EpiResid, pg8::SplitOrder, true, true>(lds, g, S, er); }
            else if (q == 1 && PHM(4)) prep1_phase(a, e);
            else if (q == 3 && PHM(5)) prep2_phase(a, e);
            else if (q == 4 && PHM(6)) scan_phase(a, e, lds);
            else if (q == 5 && PHM(7)) post_phase(a, e);
            else if (q == 13 && PHM(8)) attn_phase(a, e, lds);
            else if ((q == 7 || q == 15) && PHM(9)) ln_phase(a, a.in[26] + (size_t)layer * 1024, a.in[27] + (size_t)layer * 1024, nullptr, NS_K1);
            else if ((q == 10 || q == 18) && PHM(9)) ln_phase(a, a.in[28] + (size_t)layer * 1024, a.in[29] + (size_t)layer * 1024, (layer == 3) ? a.out : nullptr, NS_K2);
        }
        }
        if (ph + 1 < a.ph_hi && !nosync) { if (ph == 0) grid.sync(); else xcd_barrier(xbar); }
        else __syncthreads();
    }
}

extern "C" void kernel_launch(void* const* d_in, const int* in_sizes, int n_in, void* d_out, int out_size, void* d_ws, size_t ws_size, hipStream_t stream) {
    static int grid = 0; static int badsz = 0;
    if (grid == 0) {
        if (n_in != 32 || ws_size < WS_BAR + WS_BAR_BYTES || out_size != 92360704) { fprintf(stderr, "kernel_launch: unexpected shapes (n_in %d, ws %zu, out %d)\n", n_in, ws_size, out_size); grid = -1; return; }
        static const long long exp_sz[32] = {67108864LL, 1048576, 1048576, 57344, 1048576, 16777216, 16777216, 6848512, 3584, 1024, 65536, 1024, 65536, 131072, 1024, 1024, 1024, 1024, 1024, 8192, 512, 256, 2097152, 6291456, 8224, 2097152, 4096, 4096, 4096, 4096, 23068672, 11534336};
        for (int i = 0; i < 32; ++i) if ((long long)in_sizes[i] != exp_sz[i]) { fprintf(stderr, "kernel_launch: input %d has %d elements, expected %lld\n", i, in_sizes[i], exp_sz[i]); badsz = 1; }
        int dev = 0, cus = 0, per_cu = 0;
        hipGetDevice(&dev); hipDeviceGetAttribute(&cus, hipDeviceAttributeMultiprocessorCount, dev);
        if (hipOccupancyMaxActiveBlocksPerMultiprocessor(&per_cu, (const void*)trunk_fwd, NTHREADS, 0) != hipSuccess || per_cu < 1) { fprintf(stderr, "kernel_launch: occupancy query says %d\n", per_cu); per_cu = 1; }
        (void)hipGetLastError();
        grid = cus * per_cu;
    }
    if (grid < 0) return;
    Args a{};
    for (int i = 0; i < 32; ++i) a.in[i] = (const float*)d_in[i];
    a.out = (float*)d_out; a.ws = (unsigned char*)d_ws;
#if defined(MK_PER_PHASE)
    for (int p = 0; p < N_PHASES; ++p) { a.ph_lo = p; a.ph_hi = p + 1; hipLaunchKernelGGL(trunk_fwd, dim3(grid), dim3(NTHREADS), 0, stream, a); }
#else
    a.ph_lo = 0; a.ph_hi = badsz ? 0 : PH_STOP;
    if (hipMemsetAsync((char*)d_ws + WS_BAR, 0, WS_BAR_BYTES, stream) != hipSuccess) { fprintf(stderr, "kernel_launch: memset of the barrier words failed\n"); return; }
    void* args[] = {&a};
    hipError_t err = hipLaunchCooperativeKernel((const void*)trunk_fwd, dim3(grid), dim3(NTHREADS), args, 0, stream);
    if (err != hipSuccess) fprintf(stderr, "kernel_launch: cooperative launch failed: %s (grid %d)\n", hipGetErrorString(err), grid);
#endif
}
```

```cpp
#include <hip/hip_runtime.h>
#include <hip/hip_cooperative_groups.h>
#include <cstdio>
#include <cstdint>
namespace cg = cooperative_groups;
namespace pg8 {
#define PG8_LAS __attribute__((address_space(3)))
typedef unsigned short bf16_t;
typedef short bf16x8 __attribute__((ext_vector_type(8)));
typedef float f32x4 __attribute__((ext_vector_type(4)));
typedef unsigned u32x4 __attribute__((ext_vector_type(4)));
constexpr int BM = 256, BK = 64, HALF = 128, HTB = HALF * BK * 2  , STAGE_BYTES = 8 * HTB, NXCD = 8, WGM = 8;

__host__ __device__ __forceinline__ int lds_byte(int r, int c) { const int st = (r >> 4) * 2 + (c >> 5), rr = r & 15, cc = c & 31, ob = rr * 64 + cc * 2; return st * 1024 + (ob ^ (((ob >> 9) & 1) << 5)); }
__host__ __device__ __forceinline__ void stage_rc(int b, int& R, int& C) { const int st = b / 1024, sb = b % 1024, swz = sb ^ (((sb >> 9) & 1) << 5); R = (st >> 1) * 16 + swz / 64; C = (st & 1) * 32 + (swz % 64) / 2; }
__host__ __device__ __forceinline__ int perm32(int rho) { const int n = rho >> 4, i = rho & 15; return 8 * (i >> 2) + 4 * n + (i & 3); }

struct Unit { int pm, pn, k0, nt, sl, z; };
struct Gemm { const bf16_t* A; const bf16_t* Bt; int M, N, K; const bf16_t* A2; const bf16_t* Bt2; };

struct StaticOrder {
    int nM, nN, nwg, G, c, ntk, lora, nM2, nN2, nwg2;
    __host__ __device__ void init(int M, int N, int G_, int c_, int K_, int lora_ = 0) { nM = M / BM; nN = N / BM; nwg = nM * nN; G = G_; c = c_; ntk = K_ / BK; lora = lora_; nM2 = 0; nN2 = 0; nwg2 = 0; }
    __host__ __device__ void second(int M2, int N2) { nM2 = M2 / BM; nN2 = N2 / BM; nwg2 = nM2 * nN2; }
    __host__ __device__ bool next(int i, Unit& u) const {
        long L = (long)i * G + c; int nM_ = nM, nN_ = nN, nwg_ = nwg, z_ = 0;
        if (L >= nwg) { L -= nwg; if (L >= nwg2) return false; nM_ = nM2; nN_ = nN2; nwg_ = nwg2; z_ = 1; }
        int wgid = (int)L; { const int q = nwg_ / NXCD, r = nwg_ % NXCD, xcd = wgid % NXCD, off = wgid / NXCD; wgid = (xcd < r ? xcd * (q + 1) : r * (q + 1) + (xcd - r) * q) + off; }
        const int nig = WGM * nN_, gid = wgid / nig, fm = gid * WGM, gsz = (nM_ - fm) < WGM ? (nM_ - fm) : WGM;
        u.pm = fm + ((wgid % nig) % gsz); u.pn = (wgid % nig) / gsz; u.k0 = 0; u.nt = ntk; u.sl = -1; u.z = z_; if (lora) { u.k0 = u.pn < 4 ? 0 : 2; u.nt = 2; } return true;
    }
    __device__ __forceinline__ void a_ready(const Unit&) const {}
    __device__ __forceinline__ void done(const Unit&) const {}
};

struct SplitOrder {
    StaticOrder so; int NS, nts, G, c;
    __host__ __device__ void init(int G_, int c_, int K_, int NS_) { so.init(65536, 1024, G_, c_, K_); NS = NS_; nts = (K_ / BK) / NS_; G = G_; c = c_; }
    __host__ __device__ bool next(int i, Unit& u) const {
        if (so.next(i, u)) return true;
        const long L = (long)i * G + c - 1024; if (L < 0 || L >= 16 * NS) return false;
        const int tile = (int)L / NS, sl = (int)L - tile * NS;
        u.pm = 256 + (tile >> 2); u.pn = tile & 3; u.k0 = sl * nts; u.nt = nts; u.sl = sl; u.z = 0; return true;
    }
    __device__ __forceinline__ void a_ready(const Unit&) const {}
    __device__ __forceinline__ void done(const Unit&) const {}
};

__device__ __forceinline__ unsigned cvt_pk_bf16(float lo, float hi) { unsigned r; asm volatile("v_cvt_pk_bf16_f32 %0, %1, %2" : "=v"(r) : "v"(lo), "v"(hi)); return r; }
__device__ __forceinline__ float bf_lo(unsigned w) { return __uint_as_float(w << 16); }
__device__ __forceinline__ float bf_hi(unsigned w) { return __uint_as_float(w & 0xffff0000u); }
struct EpiBf16 {
    static constexpr bool PERM = true, AFTER_DRAIN = false;
    bf16_t* O; int ldc; int split_cols; size_t split_stride; float scale0; bf16_t* O2; int ldc2;
    __device__ __forceinline__ void operator()(const f32x4 (&acc)[2][2][4][2], const Unit& u, int wr, int wc, int fr, int fq) const {
        const int row0 = u.pm * BM + wr * 64 + fr; int colt = u.pn * BM; bf16_t* base = u.z ? O2 : O; const int ldc = u.z ? ldc2 : this->ldc;
        float sc = 1.f; if (split_cols && !u.z) { const int t = colt / split_cols; base += (size_t)t * split_stride; colt -= t * split_cols; if (t == 0) sc = scale0; }
        const int col0 = colt + wc * 32 + 8 * fq;
#pragma unroll
        for (int ai = 0; ai < 2; ++ai)
#pragma unroll
            for (int m = 0; m < 4; ++m) { bf16_t* rowp = base + (size_t)(row0 + ai * HALF + m * 16) * ldc + col0;
#pragma unroll
                for (int bj = 0; bj < 2; ++bj) { const f32x4 v0 = acc[ai][bj][m][0] * sc, v1 = acc[ai][bj][m][1] * sc;
                    u32x4 w; w.x = cvt_pk_bf16(v0[0], v0[1]); w.y = cvt_pk_bf16(v0[2], v0[3]); w.z = cvt_pk_bf16(v1[0], v1[1]); w.w = cvt_pk_bf16(v1[2], v1[3]);
                    *(u32x4*)(rowp + bj * HALF) = w; } }
    }
};
__device__ __forceinline__ float silu_f(float x) { return x * __builtin_amdgcn_rcpf(1.0f + __expf(-x)); }
struct EpiSwiglu {
    static constexpr bool PERM = true, AFTER_DRAIN = false;
    bf16_t* O; int ldc;
    __device__ __forceinline__ void operator()(const f32x4 (&acc)[2][2][4][2], const Unit& u, int wr, int wc, int fr, int fq) const {
        const int row0 = u.pm * BM + wr * 64 + fr; const int col0 = u.pn * HALF + wc * 32 + 8 * fq;
#pragma unroll
        for (int ai = 0; ai < 2; ++ai)
#pragma unroll
            for (int m = 0; m < 4; ++m) { bf16_t* rowp = O + (size_t)(row0 + ai * HALF + m * 16) * ldc + col0;
                const f32x4 g0 = acc[ai][0][m][0], g1 = acc[ai][0][m][1], u0 = acc[ai][1][m][0], u1 = acc[ai][1][m][1];
                u32x4 w;
                w.x = cvt_pk_bf16(silu_f(g0[0]) * u0[0], silu_f(g0[1]) * u0[1]); w.y = cvt_pk_bf16(silu_f(g0[2]) * u0[2], silu_f(g0[3]) * u0[3]);
                w.z = cvt_pk_bf16(silu_f(g1[0]) * u1[0], silu_f(g1[1]) * u1[1]); w.w = cvt_pk_bf16(silu_f(g1[2]) * u1[2], silu_f(g1[3]) * u1[3]);
                *(u32x4*)rowp = w; }
    }
};
struct EpiResid {
    static constexpr bool PERM = true, AFTER_DRAIN = false;
    const bf16_t* X; bf16_t* Z; int ldc; float alpha; float* ZS;
    __device__ __forceinline__ void operator()(const f32x4 (&acc)[2][2][4][2], const Unit& u, int wr, int wc, int fr, int fq) const {
        const int row0 = u.pm * BM + wr * 64 + fr; const int col0 = u.pn * BM + wc * 32 + 8 * fq;
        if (u.sl >= 0) {
            float* zs = ZS + ((size_t)u.sl * 1024 + (row0 - 65536)) * 1024 + col0;
#pragma unroll
            for (int ai = 0; ai < 2; ++ai)
#pragma unroll
                for (int m = 0; m < 4; ++m)
#pragma unroll
                    for (int bj = 0; bj < 2; ++bj) { float* q = zs + (size_t)(ai * HALF + m * 16) * 1024 + bj * HALF; *(f32x4*)q = acc[ai][bj][m][0]; *(f32x4*)(q + 4) = acc[ai][bj][m][1]; }
            return;
        }
#pragma unroll
        for (int ai = 0; ai < 2; ++ai)
#pragma unroll
            for (int m = 0; m < 4; ++m) { const size_t off = (size_t)(row0 + ai * HALF + m * 16) * ldc + col0;
#pragma unroll
                for (int bj = 0; bj < 2; ++bj) { const u32x4 x = *(const u32x4*)(X + off + bj * HALF);
                    const f32x4 v0 = acc[ai][bj][m][0], v1 = acc[ai][bj][m][1];
                    u32x4 w;
                    w.x = cvt_pk_bf16(alpha * bf_lo(x.x) + v0[0], alpha * bf_hi(x.x) + v0[1]); w.y = cvt_pk_bf16(alpha * bf_lo(x.y) + v0[2], alpha * bf_hi(x.y) + v0[3]);
                    w.z = cvt_pk_bf16(alpha * bf_lo(x.z) + v1[0], alpha * bf_hi(x.z) + v1[1]); w.w = cvt_pk_bf16(alpha * bf_lo(x.w) + v1[2], alpha * bf_hi(x.w) + v1[3]);
                    *(u32x4*)(Z + off + bj * HALF) = w; } }
    }
};
template <class Epi, class Sched, bool ALIGN_EPI = false, bool SP2 = false>
__device__ __forceinline__ void gemm_phase(PG8_LAS unsigned char* lds, const Gemm g, const Sched& S, const Epi& E) {
    int tid = threadIdx.x; asm volatile("" : "+v"(tid)); const int wid = __builtin_amdgcn_readfirstlane(tid >> 6), lane = tid & 63, wr = wid >> 2, wc = wid & 3, fr = lane & 15, fq = lane >> 4;
    const int K = g.K;
    unsigned voffA[2], voffB[2];
#pragma unroll
    for (int i = 0; i < 2; ++i) { int R, C; stage_rc(tid * 16 + i * 8192, R, C); const int Rb = Epi::PERM ? ((R & ~31) + perm32(R & 31)) : R;
        voffA[i] = (unsigned)(R * K + C) * 2u; voffB[i] = (unsigned)(Rb * K + C) * 2u; }
    const size_t kstep = (size_t)(BK * 2);
    const size_t hstep = (size_t)HALF * K * 2;
    const size_t tstep = 2 * hstep;
    const unsigned ldsw = (unsigned)wid * 1024u;
    const int aoff = lds_byte(wr * 64 + fr, fq * 8), boff = lds_byte(wc * 32 + fr, fq * 8);
#define PG8_SA(b, h) (((b) * 2 + (h)) * HTB)
#define PG8_SB(b, h) ((4 + (b) * 2 + (h)) * HTB)
#define PG8_STAGE(bufoff, gbase, voff) do { _Pragma("unroll") for (int _i = 0; _i < 2; ++_i) \
        __builtin_amdgcn_global_load_lds((const unsigned*)((const char*)(gbase) + (voff)[_i]), (PG8_LAS unsigned*)(lds + (bufoff) + ldsw + _i * 8192), 16, 0, 0); } while (0)
#define PG8_LDA(dst, b, h) do { _Pragma("unroll") for (int m = 0; m < 4; ++m) _Pragma("unroll") for (int k = 0; k < 2; ++k) dst[m][k] = *(const PG8_LAS bf16x8*)(lds + PG8_SA(b, h) + aoff + m * 2048 + k * 1024); } while (0)
#define PG8_LDB(dst, b, h) do { _Pragma("unroll") for (int n = 0; n < 2; ++n) _Pragma("unroll") for (int k = 0; k < 2; ++k) dst[n][k] = *(const PG8_LAS bf16x8*)(lds + PG8_SB(b, h) + boff + n * 2048 + k * 1024); } while (0)
#define PG8_MMA(ai, bj, At, Bt) do { __builtin_amdgcn_s_setprio(1); _Pragma("unroll") for (int m = 0; m < 4; ++m) _Pragma("unroll") for (int n = 0; n < 2; ++n) _Pragma("unroll") for (int k = 0; k < 2; ++k) \
        acc[ai][bj][m][n] = __builtin_amdgcn_mfma_f32_16x16x32_bf16(Bt[n][k], At[m][k], acc[ai][bj][m][n], 0, 0, 0); __builtin_amdgcn_s_setprio(0); } while (0)
#define PG8_WAIT_V(n) asm volatile("s_waitcnt vmcnt(" #n ")" ::: "memory")
#define PG8_WAIT_L(n) asm volatile("s_waitcnt lgkmcnt(" #n ")" ::: "memory")
#define PG8_BAR __builtin_amdgcn_s_barrier()
#define PG8_SCHED __builtin_amdgcn_sched_barrier(0)
    Unit cur, nxt; int ui = 0;
    if (!S.next(0, cur)) return;
    f32x4 acc[2][2][4][2];
#pragma unroll
    for (int a = 0; a < 2; ++a)
#pragma unroll
        for (int b = 0; b < 2; ++b)
#pragma unroll
            for (int m = 0; m < 4; ++m)
#pragma unroll
                for (int n = 0; n < 2; ++n) acc[a][b][m][n] = (f32x4){0.f, 0.f, 0.f, 0.f};
    bf16x8 At[4][2], B0[2][2], B1[2][2];
    const char* cA = (const char*)(cur.z ? g.A2 : g.A) + (size_t)cur.pm * tstep + (size_t)cur.k0 * kstep; const char* cB = (const char*)(cur.z ? g.Bt2 : g.Bt) + (size_t)cur.pn * tstep + (size_t)cur.k0 * kstep;
    S.a_ready(cur);
    if constexpr (SP2) {
        PG8_STAGE(PG8_SB(0, 0), cB, voffB); PG8_STAGE(PG8_SB(0, 1), cB + hstep, voffB); PG8_STAGE(PG8_SA(0, 0), cA, voffA); PG8_STAGE(PG8_SA(0, 1), cA + hstep, voffA);
        if (wr == 1) PG8_BAR;
        PG8_WAIT_V(2); PG8_BAR;
        PG8_STAGE(PG8_SB(1, 0), cB + kstep, voffB); PG8_STAGE(PG8_SA(1, 0), cA + kstep, voffA); PG8_STAGE(PG8_SB(1, 1), cB + hstep + kstep, voffB);
        PG8_WAIT_V(6); PG8_BAR;
    } else {
        PG8_STAGE(PG8_SB(0, 0), cB, voffB); PG8_STAGE(PG8_SA(0, 0), cA, voffA); PG8_STAGE(PG8_SB(0, 1), cB + hstep, voffB); PG8_STAGE(PG8_SA(0, 1), cA + hstep, voffA);
        if (wr == 1) PG8_BAR;
        PG8_WAIT_V(4); PG8_BAR;
        PG8_STAGE(PG8_SB(1, 0), cB + kstep, voffB); PG8_STAGE(PG8_SA(1, 0), cA + kstep, voffA); PG8_STAGE(PG8_SB(1, 1), cB + hstep + kstep, voffB);
        PG8_WAIT_V(6); PG8_BAR;
    }
    for (;;) {
        const bool has_next = S.next(ui + 1, nxt);
        const char* nA = has_next ? (const char*)(nxt.z ? g.A2 : g.A) + (size_t)nxt.pm * tstep + (size_t)nxt.k0 * kstep : cA; const char* nB = has_next ? (const char*)(nxt.z ? g.Bt2 : g.Bt) + (size_t)nxt.pn * tstep + (size_t)nxt.k0 * kstep : cB;
        const int nt = cur.nt;
        for (int t = 0; t < nt; t += 2) {
            const bool last = (t == nt - 2);
            const char* a1 = cA + (size_t)(t + 1) * kstep;
            const char* a2 = last ? nA : cA + (size_t)(t + 2) * kstep; const char* b2 = last ? nB : cB + (size_t)(t + 2) * kstep;
            const char* a3 = a2 + kstep; const char* b3 = b2 + kstep;
            if (last && has_next) S.a_ready(nxt);
            if constexpr (SP2) {
            PG8_LDB(B0, 0, 0); PG8_LDB(B1, 0, 1); PG8_SCHED; PG8_LDA(At, 0, 0); PG8_STAGE(PG8_SA(1, 1), a1 + hstep, voffA);
            PG8_WAIT_V(8); PG8_WAIT_L(0); PG8_BAR; PG8_MMA(0, 0, At, B0); PG8_MMA(0, 1, At, B1); PG8_BAR; PG8_SCHED;
            PG8_LDA(At, 0, 1); PG8_STAGE(PG8_SB(0, 0), b2, voffB); PG8_STAGE(PG8_SB(0, 1), b2 + hstep, voffB); PG8_STAGE(PG8_SA(0, 0), a2, voffA);
            PG8_WAIT_V(8); PG8_WAIT_L(0); PG8_BAR; PG8_MMA(1, 0, At, B0); PG8_MMA(1, 1, At, B1); PG8_BAR; PG8_SCHED;
            PG8_LDB(B0, 1, 0); PG8_LDB(B1, 1, 1); PG8_SCHED; PG8_LDA(At, 1, 0); PG8_STAGE(PG8_SA(0, 1), a2 + hstep, voffA);
            PG8_WAIT_V(8); PG8_WAIT_L(0); PG8_BAR; PG8_MMA(0, 0, At, B0); PG8_MMA(0, 1, At, B1); PG8_BAR; PG8_SCHED;
            PG8_LDA(At, 1, 1); PG8_STAGE(PG8_SB(1, 0), b3, voffB); PG8_STAGE(PG8_SB(1, 1), b3 + hstep, voffB); PG8_STAGE(PG8_SA(1, 0), a3, voffA);
            PG8_WAIT_V(8); PG8_WAIT_L(0); PG8_BAR; PG8_MMA(1, 0, At, B0); PG8_MMA(1, 1, At, B1); PG8_BAR; PG8_SCHED;
            } else {
            PG8_LDB(B0, 0, 0); PG8_SCHED; PG8_LDA(At, 0, 0); PG8_STAGE(PG8_SA(1, 1), a1 + hstep, voffA);
            PG8_WAIT_L(8); PG8_BAR; PG8_WAIT_L(0); PG8_MMA(0, 0, At, B0); PG8_BAR; PG8_SCHED;
            PG8_LDB(B1, 0, 1); PG8_STAGE(PG8_SB(0, 0), b2, voffB);
            PG8_BAR; PG8_WAIT_L(0); PG8_MMA(0, 1, At, B1); PG8_BAR;
            PG8_LDA(At, 0, 1); PG8_STAGE(PG8_SA(0, 0), a2, voffA);
            PG8_BAR; PG8_WAIT_L(0); PG8_MMA(1, 0, At, B0); PG8_BAR; PG8_SCHED;
            PG8_STAGE(PG8_SB(0, 1), b2 + hstep, voffB);
            PG8_WAIT_V(6); PG8_BAR; PG8_MMA(1, 1, At, B1); PG8_BAR;
            PG8_LDB(B0, 1, 0); PG8_SCHED; PG8_LDA(At, 1, 0); PG8_STAGE(PG8_SA(0, 1), a2 + hstep, voffA);
            PG8_WAIT_L(8); PG8_BAR; PG8_WAIT_L(0); PG8_MMA(0, 0, At, B0); PG8_BAR; PG8_SCHED;
            PG8_LDB(B1, 1, 1); PG8_STAGE(PG8_SB(1, 0), b3, voffB);
            PG8_BAR; PG8_WAIT_L(0); PG8_MMA(0, 1, At, B1); PG8_BAR;
            PG8_LDA(At, 1, 1); PG8_STAGE(PG8_SA(1, 0), a3, voffA);
            PG8_BAR; PG8_WAIT_L(0); PG8_MMA(1, 0, At, B0); PG8_BAR; PG8_SCHED;
            PG8_STAGE(PG8_SB(1, 1), b3 + hstep, voffB);
            PG8_WAIT_V(6); PG8_BAR; PG8_MMA(1, 1, At, B1); PG8_BAR;
            }
        }
        if constexpr (ALIGN_EPI) { if (wr == 0) PG8_BAR; }
        if constexpr (!Epi::AFTER_DRAIN) { E(acc, cur, wr, wc, fr, fq); S.done(cur); }
        if (!has_next) break;
#pragma unroll
        for (int a = 0; a < 2; ++a)
#pragma unroll
            for (int b = 0; b < 2; ++b)
#pragma unroll
                for (int m = 0; m < 4; ++m)
#pragma unroll
                    for (int n = 0; n < 2; ++n) acc[a][b][m][n] = (f32x4){0.f, 0.f, 0.f, 0.f};
        cur = nxt; cA = nA; cB = nB; ++ui;
        if constexpr (ALIGN_EPI) { if (wr == 1) PG8_BAR; }
    }
    PG8_WAIT_V(0);
    if constexpr (!ALIGN_EPI) { if (wr == 0) PG8_BAR; }
    PG8_BAR;
    if constexpr (Epi::AFTER_DRAIN) { E.fused(acc, cur, wr, wc, fr, fq, lds, wid, lane); S.done(cur); }
#undef PG8_SA
#undef PG8_SB
#undef PG8_STAGE
#undef PG8_LDA
#undef PG8_LDB
#undef PG8_MMA
#undef PG8_WAIT_V
#undef PG8_WAIT_L
#undef PG8_BAR
#undef PG8_SCHED
}
}
#define TR_LO 0
#define TR_HI 16


#define LAS __attribute__((address_space(3)))
typedef unsigned short bf16;
typedef unsigned v4u __attribute__((ext_vector_type(4)));
typedef unsigned v2u __attribute__((ext_vector_type(2)));
typedef float f32x4 __attribute__((ext_vector_type(4)));
typedef short bf16x8 __attribute__((ext_vector_type(8)));
using pg8::cvt_pk_bf16; using pg8::bf_lo; using pg8::bf_hi;

constexpr int DM = 1024, MP = 65536, MS = 1024, MT = MP + MS;
constexpr int TPR = 8192, TSM = 64;
constexpr int APROJ = 1792, NMIX = 3584, FH = 2816, NLORA = 1536, KLORA = 256;
constexpr float LN_EPS = 1e-5f, A_NORM_EPS = 64e-5f;
constexpr float DN_ALPHA = 1.681792830507429f;
constexpr int NWAVES = 8, NTHREADS = 512;
constexpr int LDS_BYTES = 132096;

constexpr size_t SZ_X = (size_t)MT * 1024 * 2;
constexpr size_t W_IN = 0, W_IN_SZ = (size_t)NMIX * 1024 * 2;
constexpr size_t W_LO = W_IN + 2 * W_IN_SZ, W_LO_SZ = (size_t)NLORA * KLORA * 2;
constexpr size_t W_OM = W_LO + 2 * W_LO_SZ, W_SQ_SZ = (size_t)1024 * 1024 * 2;
constexpr size_t W_QKV = W_OM + 2 * W_SQ_SZ, W_QKV_SZ = (size_t)3072 * 1024 * 2;
constexpr size_t W_O = W_QKV + 2 * W_QKV_SZ;
constexpr size_t W_FI = W_O + 2 * W_SQ_SZ, W_FI_SZ = (size_t)2 * FH * 1024 * 2;
constexpr size_t W_FO = W_FI + 4 * W_FI_SZ, W_FO_SZ = (size_t)1024 * FH * 2;
constexpr size_t OFF_XB = W_FO + 4 * W_FO_SZ;
constexpr size_t OFF_R1 = OFF_XB + SZ_X;
constexpr size_t OFF_G = OFF_R1 + SZ_X;
constexpr size_t OFF_Z = OFF_G + SZ_X / 2;
constexpr size_t OFF_BIG = OFF_Z + SZ_X;
constexpr size_t WS_END = OFF_BIG + (size_t)MT * NMIX * 2;
constexpr size_t WS_BAR = WS_END, WS_BAR_BYTES = 16384;
static_assert(OFF_XB % 256 == 0 && WS_BAR % 256 == 0 && WS_BAR + WS_BAR_BYTES <= (size_t)1073741824, "ws map");

constexpr size_t O_YP = 0, O_YS = 67108864, O_PWKV = 68157440, O_PSHIFT = 68681728, O_PGLA = 68710400, O_PK = 69234688, O_PV = 77623296,
                 O_SWKV = 86011904, O_SSHIFT = 87060480, O_SGLA = 87117824, O_SK = 88166400, O_SV = 90263552;

__device__ __forceinline__ int tid_opaque() { int t = threadIdx.x; asm volatile("" : "+v"(t)); return t; }
struct Args { const float* in[32]; float* out; unsigned char* ws; int ph_lo, ph_hi; };

__device__ __forceinline__ float wave_sum(float v) {
#pragma unroll
    for (int o = 1; o < 64; o <<= 1) v += __shfl_xor(v, o);
    return v;
}
__device__ __forceinline__ void unpack8(const v4u w, float* f) {
    f[0] = bf_lo(w.x); f[1] = bf_hi(w.x); f[2] = bf_lo(w.y); f[3] = bf_hi(w.y); f[4] = bf_lo(w.z); f[5] = bf_hi(w.z); f[6] = bf_lo(w.w); f[7] = bf_hi(w.w);
}
__device__ __forceinline__ v4u pack8(const float* f) {
    v4u w; w.x = cvt_pk_bf16(f[0], f[1]); w.y = cvt_pk_bf16(f[2], f[3]); w.z = cvt_pk_bf16(f[4], f[5]); w.w = cvt_pk_bf16(f[6], f[7]); return w;
}
__device__ __forceinline__ void load8f(const float* p, float* f) {
    const f32x4 a = *(const f32x4*)p, b = *(const f32x4*)(p + 4);
    f[0] = a.x; f[1] = a.y; f[2] = a.z; f[3] = a.w; f[4] = b.x; f[5] = b.y; f[6] = b.z; f[7] = b.w;
}
__device__ __forceinline__ float softplus_f(float x) { return fmaxf(x, 0.f) + __logf(1.0f + __expf(-fabsf(x))); }
__device__ __forceinline__ float sigmoid_f(float x) { return __builtin_amdgcn_rcpf(1.0f + __expf(-x)); }
#define LDS_WAIT() asm volatile("s_waitcnt lgkmcnt(0)" ::: "memory")

__device__ __forceinline__ int xcd_vcu() { const int G = gridDim.x, bx = blockIdx.x; return (G % 8 == 0) ? (bx % 8) * (G / 8) + bx / 8 : bx; }
__device__ __forceinline__ int src_col(int mode, int n) {
    if (mode == 0) return n;
    if (mode == 1) {
        if (n < 1792) return n;
        if (n < 2816) { const int h = (n - 1792) >> 8, r = (n - 1792) & 255;
            if (r < 64) return 1792 + h * 64 + r; if (r < 128) return 1792 + 256 + h * 64 + (r - 64); return 1792 + 512 + h * 128 + (r - 128); }
        if (n < 3328) return 1792 + 1040 + (n - 2816);
        if (n < 3344) return 1792 + 1024 + (n - 3328);
        return -1;
    }
    const int pn = n >> 8, jj = n & 255;
    return jj < 128 ? pn * 128 + jj : FH + pn * 128 + (jj - 128);
}
__device__ __forceinline__ void transpose_item(const float* W, int ldw, int mode, bf16* WT, int K, int N, int it, int lane) {
    const int nblk = N / 64;
    const int kb = it / nblk, nb = it - kb * nblk, k0 = 64 * kb, n = 64 * nb + lane;
    const int sc = src_col(mode, n); const float msk = sc >= 0 ? 1.f : 0.f; const int scc = sc >= 0 ? sc : 0;
    const float* wp = W + (size_t)k0 * ldw + scc; bf16* op = WT + (size_t)n * K + k0;
#pragma unroll 4
    for (int k8 = 0; k8 < 8; ++k8) {
        float f[8];
#pragma unroll
        for (int i = 0; i < 8; ++i) f[i] = wp[(size_t)(8 * k8 + i) * ldw] * msk;
        *(v4u*)(op + 8 * k8) = pack8(f);
    }
}
__device__ __forceinline__ void prologue_phase(const Args& a, LAS unsigned char* lds) {
    const int tid = tid_opaque(), lane = tid & 63, wave = tid >> 6;
    const int gw = blockIdx.x * NWAVES + wave, ngw = gridDim.x * NWAVES;
    LAS float* scr = (LAS float*)(lds + wave * 8704);
    unsigned char* ws = a.ws;
    for (int itg = gw; itg < 12800; itg += ngw) {
        int j, base;
        if (itg < 1792) { j = itg / 896; base = j * 896; }
        else if (itg < 2304) { j = 2 + (itg - 1792) / 256; base = 1792 + (j - 2) * 256; }
        else if (itg < 3840) { j = 4 + (itg - 2304) / 768; base = 2304 + (j - 4) * 768; }
        else if (itg < 4352) { j = 6 + (itg - 3840) / 256; base = 3840 + (j - 6) * 256; }
        else if (itg < 9984) { j = 8 + (itg - 4352) / 1408; base = 4352 + (j - 8) * 1408; }
        else { j = 12 + (itg - 9984) / 704; base = 9984 + (j - 12) * 704; }
        const float* W; int ldw, mode, K, N; bf16* WT;
        if (j < 2)       { W = a.in[7] + (size_t)j * 1024 * 3344; ldw = 3344; mode = 1; K = 1024; N = NMIX; WT = (bf16*)(ws + W_IN + j * W_IN_SZ); }
        else if (j < 4)  { const int e = j - 2;  W = a.in[22] + (size_t)e * 1024 * 1024; ldw = 1024; mode = 0; K = 1024; N = 1024; WT = (bf16*)(ws + W_OM + e * W_SQ_SZ); }
        else if (j < 6)  { const int e = j - 4;  W = a.in[23] + (size_t)e * 1024 * 3072; ldw = 3072; mode = 0; K = 1024; N = 3072; WT = (bf16*)(ws + W_QKV + e * W_QKV_SZ); }
        else if (j < 8)  { const int e = j - 6;  W = a.in[25] + (size_t)e * 1024 * 1024; ldw = 1024; mode = 0; K = 1024; N = 1024; WT = (bf16*)(ws + W_O + e * W_SQ_SZ); }
        else if (j < 12) { const int l = j - 8;  W = a.in[30] + (size_t)l * 1024 * 2 * FH; ldw = 2 * FH; mode = 2; K = 1024; N = 2 * FH; WT = (bf16*)(ws + W_FI + l * W_FI_SZ); }
        else             { const int l = j - 12; W = a.in[31] + (size_t)l * FH * 1024; ldw = 1024; mode = 0; K = FH; N = 1024; WT = (bf16*)(ws + W_FO + l * W_FO_SZ); }
        transpose_item(W, ldw, mode, WT, K, N, itg - base, lane);
    }
    const int gt = blockIdx.x * NTHREADS + tid, ngt = gridDim.x * NTHREADS;
#ifndef SKIP_LORA
    for (int idx = gt; idx < 2 * NLORA * 32; idx += ngt) {
        const int e = idx / (NLORA * 32), r = idx - e * (NLORA * 32), n = r >> 5, k0 = (r & 31) * 8;
        float f[8];
#pragma unroll
        for (int i = 0; i < 8; ++i) { const int k = k0 + i; float v = 0.f;
            if (n < 512) { if (k < 64) v = a.in[10][((size_t)e * 64 + k) * 512 + n]; }
            else if (n < 1024) { if (k >= 64 && k < 128) v = a.in[12][((size_t)e * 64 + (k - 64)) * 512 + (n - 512)]; }
            else { if (k >= 128) v = a.in[13][((size_t)e * 128 + (k - 128)) * 512 + (n - 1024)]; }
            f[i] = v; }
        *(v4u*)((bf16*)(ws + W_LO + e * W_LO_SZ) + (size_t)n * KLORA + k0) = pack8(f);
    }
#endif
    bf16* XB = (bf16*)(ws + OFF_XB);
    for (size_t idx = gt; idx < (size_t)MT * 128; idx += ngt) {
        const size_t e0 = idx * 8; const float* src = e0 < (size_t)MP * 1024 ? a.in[0] + e0 : a.in[1] + (e0 - (size_t)MP * 1024);
        float f[8]; load8f(src, f); *(v4u*)(XB + e0) = pack8(f);
    }
}

__device__ __forceinline__ void prep1_phase(const Args& a, int e) {
    const int tid = tid_opaque(), lane = tid & 63, wave = tid >> 6;
    const int gw = blockIdx.x * NWAVES + wave, ngw = gridDim.x * NWAVES;
    const bf16* PA = (const bf16*)(a.ws + OFF_BIG); bf16* L = (bf16*)(a.ws + OFF_Z);
    const float* mu = a.in[8] + (size_t)e * APROJ; const float* shift0 = a.in[3] + (size_t)e * 16 * APROJ;
    const int c = 1536 + 4 * lane;
    const f32x4 mu4 = *(const f32x4*)(mu + c);
    for (int m = gw; m < MT; m += ngw) {
        const v2u pw = *(const v2u*)(PA + (size_t)m * APROJ + c);
        float p[4] = {bf_lo(pw.x), bf_hi(pw.x), bf_lo(pw.y), bf_hi(pw.y)}, q[4];
        const int t = m < MP ? (m & (TPR - 1)) : ((m - MP) & (TSM - 1));
        if (t > 0) { const v2u qw = *(const v2u*)(PA + (size_t)(m - 1) * APROJ + c); q[0] = bf_lo(qw.x); q[1] = bf_hi(qw.x); q[2] = bf_lo(qw.y); q[3] = bf_hi(qw.y); }
        else if (m < MP) { q[0] = q[1] = q[2] = q[3] = 0.f; }
        else { const f32x4 s = *(const f32x4*)(shift0 + (size_t)((m - MP) >> 6) * APROJ + c); q[0] = s.x; q[1] = s.y; q[2] = s.z; q[3] = s.w; }
        float r[4];
#pragma unroll
        for (int i = 0; i < 4; ++i) { const float xs = p[i] + (q[i] - p[i]) * mu4[i]; r[i] = lane < 16 ? 2.0f * sigmoid_f(2.0f * xs) - 1.0f : (lane < 32 ? xs : sigmoid_f(xs))    ; }
        v2u o; o.x = cvt_pk_bf16(r[0], r[1]); o.y = cvt_pk_bf16(r[2], r[3]);
        *(v2u*)(L + (size_t)m * KLORA + 4 * lane) = o;
    }
}
__device__ __forceinline__ void prep2_phase(const Args& a, int e) {
    const int tid = tid_opaque(), lane = tid & 63, wave = tid >> 6;
    const int gw = blockIdx.x * NWAVES + wave, ngw = gridDim.x * NWAVES;
    const bf16* PA = (const bf16*)(a.ws + OFF_BIG); bf16* PB = (bf16*)(a.ws + OFF_BIG) + (size_t)MT * APROJ;
    const bf16* Lw = (const bf16*)(a.ws + OFF_R1); const bf16* La = Lw + (size_t)MT * 512;
    bf16* SA = (bf16*)a.out; bf16* SB = (bf16*)(a.ws + OFF_Z);
    const float* mu = a.in[8] + (size_t)e * APROJ; const float* shift0 = a.in[3] + (size_t)e * 16 * APROJ;
    const int c8 = 8 * lane, h = lane >> 3;
    float mur[8], muk[8], muv[8], w0[8], a0[8], kkw[8], kaw[8];
    load8f(mu + c8, mur); load8f(mu + 512 + c8, muk); load8f(mu + 1024 + c8, muv);
    load8f(a.in[9] + (size_t)e * 512 + c8, w0); load8f(a.in[11] + (size_t)e * 512 + c8, a0);
    load8f(a.in[14] + (size_t)e * 512 + c8, kkw); load8f(a.in[15] + (size_t)e * 512 + c8, kaw);
    const float* aup = a.in[19] + (size_t)e * 16 * 256; const f32x4 ab = *(const f32x4*)(a.in[20] + (size_t)e * 256 + 4 * lane);
    for (int m = gw; m < MT; m += ngw) {
        const bf16* pr = PA + (size_t)m * APROJ;
        float r[8], k[8], v[8], pq[8];
        unpack8(*(const v4u*)(pr + c8), r); unpack8(*(const v4u*)(pr + 512 + c8), k); unpack8(*(const v4u*)(pr + 1024 + c8), v);
        const int t = m < MP ? (m & (TPR - 1)) : ((m - MP) & (TSM - 1));
        if (t > 0) {
            unpack8(*(const v4u*)(pr - APROJ + c8), pq);
#pragma unroll
            for (int i = 0; i < 8; ++i) r[i] += (pq[i] - r[i]) * mur[i];
            unpack8(*(const v4u*)(pr - APROJ + 512 + c8), pq);
#pragma unroll
            for (int i = 0; i < 8; ++i) k[i] += (pq[i] - k[i]) * muk[i];
            unpack8(*(const v4u*)(pr - APROJ + 1024 + c8), pq);
#pragma unroll
            for (int i = 0; i < 8; ++i) v[i] += (pq[i] - v[i]) * muv[i];
        } else if (m < MP) {
#pragma unroll
            for (int i = 0; i < 8; ++i) { r[i] -= r[i] * mur[i]; k[i] -= k[i] * muk[i]; v[i] -= v[i] * muv[i]; }
        } else {
            const float* s0 = shift0 + (size_t)((m - MP) >> 6) * APROJ;
            load8f(s0 + c8, pq);
#pragma unroll
            for (int i = 0; i < 8; ++i) r[i] += (pq[i] - r[i]) * mur[i];
            load8f(s0 + 512 + c8, pq);
#pragma unroll
            for (int i = 0; i < 8; ++i) k[i] += (pq[i] - k[i]) * muk[i];
            load8f(s0 + 1024 + c8, pq);
#pragma unroll
            for (int i = 0; i < 8; ++i) v[i] += (pq[i] - v[i]) * muv[i];
        }
        float lw[8], la[8], u[8], av[8], kk[8], km[8], ka[8];
        unpack8(*(const v4u*)(Lw + (size_t)m * 512 + c8), lw); unpack8(*(const v4u*)(La + (size_t)m * 512 + c8), la);
        float ss = 0.f;
#pragma unroll
        for (int i = 0; i < 8; ++i) {
            u[i] = 1.0f - __expf(-0.6065306597126334f * sigmoid_f(w0[i] + lw[i]));
            av[i] = sigmoid_f(a0[i] + la[i]);
            kk[i] = k[i] * kkw[i]; ss += kk[i] * kk[i];
            km[i] = k[i] * (1.0f + (av[i] - 1.0f) * kaw[i]);
        }
        ss += __shfl_xor(ss, 1); ss += __shfl_xor(ss, 2); ss += __shfl_xor(ss, 4);
        const float rn = rsqrtf(ss + 1e-12f);
#pragma unroll
        for (int i = 0; i < 8; ++i) { kk[i] *= rn; ka[i] = kk[i] * av[i]; }
        bf16* sa = SA + ((size_t)m * 8 + h) * 256 + (lane & 7) * 8; bf16* sb = SB + ((size_t)m * 8 + h) * 128 + (lane & 7) * 8;
        *(v4u*)(sa) = pack8(r); *(v4u*)(sa + 64) = pack8(u); *(v4u*)(sa + 128) = pack8(km); *(v4u*)(sa + 192) = pack8(v);
        *(v4u*)(sb) = pack8(kk); *(v4u*)(sb + 64) = pack8(ka);
        bf16* pb = PB + (size_t)m * APROJ + 1536;
        float xa[16]; unpack8(*(const v4u*)(pb), xa); unpack8(*(const v4u*)(pb + 8), xa + 8);
        f32x4 acc = ab;
#pragma unroll
        for (int i = 0; i < 16; ++i) { const f32x4 wv = *(const f32x4*)(aup + i * 256 + 4 * lane); acc += xa[i] * wv; }
        float ug[4];
#pragma unroll
        for (int i = 0; i < 4; ++i) ug[i] = 1.0f - __expf(-softplus_f(-acc[i]) * (1.0f / 16.0f));
        v2u o; o.x = cvt_pk_bf16(ug[0], ug[1]); o.y = cvt_pk_bf16(ug[2], ug[3]);
        *(v2u*)(pb + 4 * lane) = o;
    }
}
struct PostRaw { v4u o, r, km, v, g, og, rg; };
__device__ __forceinline__ void post_phase(const Args& a, int e) {
    const int tid = tid_opaque(), lane = tid & 63, wave = tid >> 6;
    const int gw = blockIdx.x * NWAVES + wave, ngw = gridDim.x * NWAVES;
    bf16* Y = (bf16*)(a.ws + OFF_R1); const bf16* G = (const bf16*)(a.ws + OFF_G);
    const bf16* PB = (const bf16*)(a.ws + OFF_BIG) + (size_t)MT * APROJ; const bf16* SA = (const bf16*)a.out;
    const int c8 = 8 * lane, h = lane >> 3;
    float lnw[8], lnb[8], rk[8], nw[8];
    load8f(a.in[17] + (size_t)e * 512 + c8, lnw); load8f(a.in[18] + (size_t)e * 512 + c8, lnb); load8f(a.in[16] + (size_t)e * 512 + c8, rk);
    load8f(a.in[21] + (size_t)e * 128 + (lane & 15) * 8, nw);
    for (int mb = gw; mb < MT; mb += 2 * ngw) {
        PostRaw raw[2];
#pragma unroll
        for (int j = 0; j < 2; ++j) { const int m_ = mb + j * ngw; const size_t m = m_ < MT ? m_ : mb;
            const bf16* sa = SA + (m * 8 + h) * 256 + (lane & 7) * 8;
            raw[j].o = *(const v4u*)(Y + m * 1024 + c8); raw[j].r = *(const v4u*)(sa); raw[j].km = *(const v4u*)(sa + 128); raw[j].v = *(const v4u*)(sa + 192);
            raw[j].g = *(const v4u*)(G + m * 512 + c8); raw[j].og = *(const v4u*)(Y + m * 1024 + 512 + c8); raw[j].rg = *(const v4u*)(PB + m * APROJ + 1024 + c8); }
#pragma unroll
        for (int j = 0; j < 2; ++j) {
            const int m = mb + j * ngw;
            float o[8], r[8], km[8], v[8], g[8];
            unpack8(raw[j].o, o); unpack8(raw[j].r, r); unpack8(raw[j].km, km); unpack8(raw[j].v, v); unpack8(raw[j].g, g);
            float s = 0.f, bn = 0.f;
#pragma unroll
            for (int i = 0; i < 8; ++i) { s += o[i]; bn += r[i] * km[i] * rk[i]; }
            s += __shfl_xor(s, 1); s += __shfl_xor(s, 2); s += __shfl_xor(s, 4);
            bn += __shfl_xor(bn, 1); bn += __shfl_xor(bn, 2); bn += __shfl_xor(bn, 4);
            const float mean = s * (1.0f / 64.0f); float q = 0.f;
#pragma unroll
            for (int i = 0; i < 8; ++i) { o[i] -= mean; q += o[i] * o[i]; }
            q += __shfl_xor(q, 1); q += __shfl_xor(q, 2); q += __shfl_xor(q, 4);
            const float rstd = rsqrtf(q * (1.0f / 64.0f) + A_NORM_EPS);
#pragma unroll
            for (int i = 0; i < 8; ++i) o[i] = (o[i] * rstd * lnw[i] + lnb[i] + bn * v[i]) * g[i];
            float og[8], rg[8];
            unpack8(raw[j].og, og); unpack8(raw[j].rg, rg);
            float ms = 0.f;
#pragma unroll
            for (int i = 0; i < 8; ++i) ms += og[i] * og[i];
            ms += __shfl_xor(ms, 1); ms += __shfl_xor(ms, 2); ms += __shfl_xor(ms, 4); ms += __shfl_xor(ms, 8);
            const float rr = rsqrtf(ms * (1.0f / 128.0f) + LN_EPS);
#pragma unroll
            for (int i = 0; i < 8; ++i) og[i] = og[i] * rr * nw[i] * (rg[i] * sigmoid_f(rg[i]));
            if (m < MT) { *(v4u*)(Y + (size_t)m * 1024 + c8) = pack8(o); *(v4u*)(Y + (size_t)m * 1024 + 512 + c8) = pack8(og); }
        }
    }
}
__device__ __forceinline__ void ln_row_out(float* x0, float* x1, const float* w0, const float* w1, const float* b0, const float* b1, bf16* XB, float* fout, int m, int lane) {
    float s = 0.f;
#pragma unroll
    for (int i = 0; i < 8; ++i) s += x0[i] + x1[i];
    const float mean = wave_sum(s) * (1.0f / 1024.0f); float q = 0.f;
#pragma unroll
    for (int i = 0; i < 8; ++i) { x0[i] -= mean; x1[i] -= mean; q += x0[i] * x0[i] + x1[i] * x1[i]; }
    const float rstd = rsqrtf(wave_sum(q) * (1.0f / 1024.0f) + LN_EPS);
#pragma unroll
    for (int i = 0; i < 8; ++i) { x0[i] = x0[i] * rstd * w0[i] + b0[i]; x1[i] = x1[i] * rstd * w1[i] + b1[i]; }
    if (fout) {
        float* fo = fout + (size_t)m * 1024 + 8 * lane;
        *(f32x4*)(fo) = (f32x4){x0[0], x0[1], x0[2], x0[3]}; *(f32x4*)(fo + 4) = (f32x4){x0[4], x0[5], x0[6], x0[7]};
        *(f32x4*)(fo + 512) = (f32x4){x1[0], x1[1], x1[2], x1[3]}; *(f32x4*)(fo + 516) = (f32x4){x1[4], x1[5], x1[6], x1[7]};
    } else {
        *(v4u*)(XB + (size_t)m * 1024 + 8 * lane) = pack8(x0); *(v4u*)(XB + (size_t)m * 1024 + 512 + 8 * lane) = pack8(x1);
    }
}
__device__ __forceinline__ void ln_phase(const Args& a, const float* w, const float* b, float* fout, int ns) {
    const int tid = tid_opaque(), lane = tid & 63, wave = tid >> 6;
    const int gw = blockIdx.x * NWAVES + wave, ngw = gridDim.x * NWAVES;
    const bf16* Z = (const bf16*)(a.ws + OFF_Z); bf16* XB = (bf16*)(a.ws + OFF_XB);
    float w0[8], w1[8], b0[8], b1[8];
    load8f(w + 8 * lane, w0); load8f(w + 512 + 8 * lane, w1); load8f(b + 8 * lane, b0); load8f(b + 512 + 8 * lane, b1);
    for (int mb = gw; mb < MP; mb += 4 * ngw) {
        v4u r0[4], r1[4];
#pragma unroll
        for (int j = 0; j < 4; ++j) { const int m = mb + j * ngw; const int mc = m < MP ? m : mb;
            r0[j] = *(const v4u*)(Z + (size_t)mc * 1024 + 8 * lane); r1[j] = *(const v4u*)(Z + (size_t)mc * 1024 + 512 + 8 * lane); }
#pragma unroll
        for (int j = 0; j < 4; ++j) {
            const int m = mb + j * ngw;
            float x0[8], x1[8];
            unpack8(r0[j], x0); unpack8(r1[j], x1);
            if (m < MP) ln_row_out(x0, x1, w0, w1, b0, b1, XB, fout, m, lane);
        }
    }
#pragma unroll 1
    for (int m = MP + gw; m < MT; m += ngw) {
        float x0[8], x1[8];
        unpack8(*(const v4u*)(XB + (size_t)m * 1024 + 8 * lane), x0); unpack8(*(const v4u*)(XB + (size_t)m * 1024 + 512 + 8 * lane), x1);
#pragma unroll
        for (int i = 0; i < 8; ++i) { x0[i] *= DN_ALPHA; x1[i] *= DN_ALPHA; }
        const float* zs = (const float*)(a.ws + OFF_G) + (size_t)(m - MP) * 1024 + 8 * lane;
#pragma unroll 1
        for (int sl = 0; sl < ns; ++sl) { float t0[8], t1[8]; load8f(zs + (size_t)sl * 1024 * 1024, t0); load8f(zs + (size_t)sl * 1024 * 1024 + 512, t1);
#pragma unroll
            for (int i = 0; i < 8; ++i) { x0[i] += t0[i]; x1[i] += t1[i]; } }
        ln_row_out(x0, x1, w0, w1, b0, b1, XB, fout, m, lane);
    }
}

#define TR_DPP(x, ctrl) __builtin_bit_cast(float, __builtin_amdgcn_update_dpp(0, __builtin_bit_cast(int, x), ctrl, 0xf, 0xf, false))
__device__ __forceinline__ float transpose_reduce16(const float* p, int g) {
    const bool h1 = (g & 8) != 0, h2 = (g & 4) != 0, h3 = (g & 2) != 0, h4 = (g & 1) != 0;
    float q[8], r[4], t[2];
#pragma unroll
    for (int i = 0; i < 8; ++i) { const float keep = h1 ? p[i + 8] : p[i], send = h1 ? p[i] : p[i + 8]; q[i] = keep + TR_DPP(send, 0x140); }
#pragma unroll
    for (int i = 0; i < 4; ++i) { const float keep = h2 ? q[i + 4] : q[i], send = h2 ? q[i] : q[i + 4]; r[i] = keep + TR_DPP(send, 0x141); }
#pragma unroll
    for (int i = 0; i < 2; ++i) { const float keep = h3 ? r[i + 2] : r[i], send = h3 ? r[i] : r[i + 2]; t[i] = keep + TR_DPP(send, 0x4E); }
    const float keep = h4 ? t[1] : t[0], send = h4 ? t[0] : t[1];
    return keep + TR_DPP(send, 0xB1);
}
constexpr int TC = 16;
constexpr int SCW = 384, SCG = 320;
__device__ __forceinline__ void st8n(LAS float* d, const v4u w) {
    *(LAS f32x4*)(d) = (f32x4){bf_lo(w.x), bf_hi(w.x), bf_lo(w.y), bf_hi(w.y)};
    *(LAS f32x4*)(d + 4) = (f32x4){bf_lo(w.z), bf_hi(w.z), bf_lo(w.w), bf_hi(w.w)};
}
__device__ __forceinline__ void st8(LAS float* d, const v4u w, float sc) {
    *(LAS f32x4*)(d) = (f32x4){bf_lo(w.x) * sc, bf_hi(w.x) * sc, bf_lo(w.y) * sc, bf_hi(w.y) * sc};
    *(LAS f32x4*)(d + 4) = (f32x4){bf_lo(w.z) * sc, bf_hi(w.z) * sc, bf_lo(w.w) * sc, bf_hi(w.w) * sc};
}
typedef float f32x2 __attribute__((ext_vector_type(2)));
#define LO2(v4) (__builtin_shufflevector(v4, v4, 0, 1))
#define HI2(v4) (__builtin_shufflevector(v4, v4, 2, 3))
__device__ __forceinline__ f32x2 fma2(f32x2 a, f32x2 b, f32x2 c) { return __builtin_elementwise_fma(a, b, c); }
__device__ __forceinline__ float rowsum16(float x) {
    x += __builtin_bit_cast(float, __builtin_amdgcn_update_dpp(0, __builtin_bit_cast(int, x), 0x128, 0xf, 0xf, false));
    x += __builtin_bit_cast(float, __builtin_amdgcn_update_dpp(0, __builtin_bit_cast(int, x), 0x124, 0xf, 0xf, false));
    x += __builtin_bit_cast(float, __builtin_amdgcn_update_dpp(0, __builtin_bit_cast(int, x), 0x122, 0xf, 0xf, false));
    x += __builtin_bit_cast(float, __builtin_amdgcn_update_dpp(0, __builtin_bit_cast(int, x), 0x121, 0xf, 0xf, false));
    return x;
}
struct WkvIn { f32x4 r, u, km, kk, ka; float v; };
struct GlaIn { f32x4 q, k, u; float v; };
__device__ __forceinline__ void scan_phase(const Args& a, int e, LAS unsigned char* lds) {
    const int tid = tid_opaque(), lane = tid & 63, wave = tid >> 6;
    const bool isW = wave < 4; const int ltid = tid & 255, lw = wave & 3;
    const int g = lane & 15, rl = lw * 4 + (lane >> 4);
    const bf16* SA = (const bf16*)a.out; const bf16* SB = (const bf16*)(a.ws + OFF_Z);
    const bf16* PB = (const bf16*)(a.ws + OFF_BIG) + (size_t)MT * APROJ;
    bf16* O1 = (bf16*)(a.ws + OFF_R1);
    LAS float* bufW = (LAS float*)lds;
    LAS float* bufG = (LAS float*)(lds + 2 * TC * SCW * 4);
    int ps[3], pp[3];
#pragma unroll
    for (int j = 0; j < 3; ++j) { const int p = ltid + 256 * j; if (isW) { ps[j] = p / 48; pp[j] = p - ps[j] * 48; } else { ps[j] = p / 40; pp[j] = p - ps[j] * 40; } }
    const bool v2ok = isW || (ltid + 512 < 640);
#pragma unroll 1
    for (int it = xcd_vcu(); it < 768; it += gridDim.x) {
        const bool samp = it >= 256; const int wi = samp ? it - 256 : it;
        const int b = wi >> 5; const int T = samp ? TSM : TPR; const size_t row0 = samp ? (size_t)MP + b * TSM : (size_t)b * TPR;
        const int nb = samp ? 16 : 8;
        int h, sub;
        if (isW) { h = (wi >> 2) & 7; sub = wi & 3; } else { h = (wi >> 3) & 3; sub = wi & 7; }
        const int vrow = sub * 16 + rl;
        f32x2 P0 = {0.f, 0.f}, P1 = {0.f, 0.f};
        if (samp) {
            if (isW) { const f32x4 S = *(const f32x4*)(a.in[2] + ((((size_t)e * 16 + b) * 8 + h) * 64 + vrow) * 64 + 4 * g); P0 = LO2(S); P1 = HI2(S); }
            else { const float* s0 = a.in[4] + (((size_t)e * 16 + b) * 4 + h) * 8192 + vrow;
                P0 = (f32x2){s0[(4 * g + 0) * 128], s0[(4 * g + 1) * 128]}; P1 = (f32x2){s0[(4 * g + 2) * 128], s0[(4 * g + 3) * 128]}; }
        }
        const int nc = T / TC;
        bf16* obase = isW ? O1 + (row0 + g) * 1024 + h * 64 + vrow : O1 + (row0 + g) * 1024 + 512 + h * 128 + vrow;
        v4u pre[3];
        unsigned so[3];
#pragma unroll
        for (int j = 0; j < 3; ++j) { const unsigned row = (unsigned)row0 + ps[j];
            if (isW) so[j] = pp[j] < 32 ? (row * 8 + h) * 256 + pp[j] * 8 : (row * 8 + h) * 128 + (pp[j] - 32) * 8;
            else so[j] = pp[j] < 32 ? row * APROJ + h * 256 + pp[j] * 8 : row * APROJ + 1536 + h * 64 + (pp[j] - 32) * 8; }
#define SCAN_ISSUE(t0) do { _Pragma("unroll") for (int j = 0; j < 3; ++j) { const bf16* src = (isW ? (pp[j] < 32 ? SA : SB) : PB) + so[j]; \
            if (j < 2 || v2ok) pre[j] = *(const v4u*)src; so[j] += isW ? (pp[j] < 32 ? TC * 2048 : TC * 1024) : TC * APROJ; } } while (0)
#define SCAN_COMMIT(bi) do { _Pragma("unroll") for (int j = 0; j < 3; ++j) { if (j < 2 || v2ok) { \
            if (isW) st8n(bufW + ((bi) * TC + ps[j]) * SCW + pp[j] * 8, pre[j]); else st8n(bufG + ((bi) * TC + ps[j]) * SCG + pp[j] * 8, pre[j]); } } } while (0)
        __syncthreads();
        SCAN_ISSUE(0); SCAN_COMMIT(0);
        __syncthreads();
#pragma unroll 1
        for (int c = 0; c < nc; ++c) {
            const int bi = c & 1;
            if (c + 1 < nc) SCAN_ISSUE((c + 1) * TC);
            float oacc = 0.f; float op[16];
            if (isW) {
                const LAS float* bw = bufW + bi * TC * SCW + 4 * g; const LAS float* bv = bufW + bi * TC * SCW + 192 + vrow;
#define WKV_LOAD(d, s) do { const LAS float* p_ = bw + (s) * SCW; d.r = *(const LAS f32x4*)(p_); d.u = *(const LAS f32x4*)(p_ + 64); d.km = *(const LAS f32x4*)(p_ + 128); \
                    d.kk = *(const LAS f32x4*)(p_ + 256); d.ka = *(const LAS f32x4*)(p_ + 320); d.v = bv[(s) * SCW]; } while (0)
                WkvIn in[3];
                WKV_LOAD(in[0], 0); WKV_LOAD(in[1], 1);
#pragma unroll
                for (int s = 0; s < TC; ++s) {
                    if (s + 2 < TC) WKV_LOAD(in[(s + 2) % 3], s + 2);
                    __builtin_amdgcn_sched_barrier(0);
                    const WkvIn& x = in[s % 3];
                    const f32x2 vv = {x.v, x.v};
                    const f32x2 s2 = fma2(P1, HI2(x.kk), P0 * LO2(x.kk));
                    const f32x2 T0 = fma2(vv, LO2(x.km), fma2(-LO2(x.u), P0, P0)), T1 = fma2(vv, HI2(x.km), fma2(-HI2(x.u), P1, P1));
                    const float sa = rowsum16(s2.x + s2.y);
                    const f32x2 ns = {-sa, -sa};
                    P0 = fma2(ns, LO2(x.ka), T0); P1 = fma2(ns, HI2(x.ka), T1);
                    const f32x2 o2 = fma2(P1, HI2(x.r), P0 * LO2(x.r));
                    op[s] = o2.x + o2.y;
                }
                oacc = transpose_reduce16(op, g);
#undef WKV_LOAD
            } else {
                const LAS float* bg = bufG + bi * TC * SCG + 4 * g; const LAS float* bv = bufG + bi * TC * SCG + 128 + vrow;
#define GLA_LOAD(d, s) do { const LAS float* p_ = bg + (s) * SCG; d.q = *(const LAS f32x4*)(p_); d.k = *(const LAS f32x4*)(p_ + 64); d.u = *(const LAS f32x4*)(p_ + 256); d.v = bv[(s) * SCG]; } while (0)
                GlaIn in[3];
                GLA_LOAD(in[0], 0); GLA_LOAD(in[1], 1);
#pragma unroll
                for (int s = 0; s < TC; ++s) {
                    if (s + 2 < TC) GLA_LOAD(in[(s + 2) % 3], s + 2);
                    __builtin_amdgcn_sched_barrier(0);
                    const GlaIn& x = in[s % 3];
                    const f32x2 vv = {x.v, x.v};
                    P0 = fma2(vv, LO2(x.k), fma2(-LO2(x.u), P0, P0)); P1 = fma2(vv, HI2(x.k), fma2(-HI2(x.u), P1, P1));
                    const f32x2 o2 = fma2(P1, HI2(x.q), P0 * LO2(x.q));
                    op[s] = o2.x + o2.y;
                }
                oacc = transpose_reduce16(op, g);
#undef GLA_LOAD
            }
            obase[(size_t)c * TC * 1024] = (bf16)(cvt_pk_bf16(isW ? oacc : oacc * 0.125f, 0.f) & 0xffffu);
            if (c + 1 < nc) SCAN_COMMIT(bi ^ 1);
            __syncthreads();
        }
#undef SCAN_ISSUE
#undef SCAN_COMMIT
        if (isW) { float* so = a.out + (samp ? O_SWKV : O_PWKV) + ((((size_t)e * nb + b) * 8 + h) * 64 + vrow) * 64 + 4 * g; *(f32x4*)so = (f32x4){P0.x, P0.y, P1.x, P1.y}; }
        else { float* so = a.out + (samp ? O_SGLA : O_PGLA) + (((size_t)e * nb + b) * 4 + h) * 8192 + vrow;
            so[(4 * g + 0) * 128] = P0.x; so[(4 * g + 1) * 128] = P0.y; so[(4 * g + 2) * 128] = P1.x; so[(4 * g + 3) * 128] = P1.y; }
    }
    const bf16* PA = (const bf16*)(a.ws + OFF_BIG);
    for (int idx = blockIdx.x * NTHREADS + tid; idx < 24 * APROJ; idx += gridDim.x * NTHREADS) {
        const int bb = idx / APROJ, c = idx - bb * APROJ;
        if (bb < 8) a.out[O_PSHIFT + ((size_t)e * 8 + bb) * APROJ + c] = bf_lo((unsigned)PA[((size_t)bb * TPR + TPR - 1) * APROJ + c]);
        else a.out[O_SSHIFT + ((size_t)e * 16 + (bb - 8)) * APROJ + c] = bf_lo((unsigned)PA[((size_t)MP + (bb - 8) * TSM + TSM - 1) * APROJ + c]);
    }
}

constexpr int KEXT = 8192, LDV = MT + KEXT;
constexpr size_t BIG_K = (size_t)MT * 1024, BIG_VT = (size_t)(2 * MT + KEXT) * 1024;
__device__ __forceinline__ bf16x8 ld_frag(const bf16* p) { return __builtin_bit_cast(bf16x8, *(const v4u*)p); }
__device__ __forceinline__ void cache_convert(const Args& a, int o) {
    const int tid = tid_opaque();
    const int gt = blockIdx.x * NTHREADS + tid, ngt = gridDim.x * NTHREADS;
    bf16* Kb = (bf16*)(a.ws + OFF_BIG) + BIG_K; bf16* Vt = (bf16*)(a.ws + OFF_BIG) + BIG_VT;
    const float* ck = a.in[5] + (size_t)o * 16 * 16 * 512 * 64; const float* cv = a.in[6] + (size_t)o * 16 * 16 * 512 * 64;
    for (int idx = gt; idx < 16 * 16 * 512 * 8; idx += ngt) {
        const int d8 = idx & 7, key = (idx >> 3) & 511, h = (idx >> 12) & 15, b = idx >> 16;
        float f[8]; load8f(ck + (size_t)idx * 8, f);
        *(v4u*)(Kb + ((size_t)MT + b * 512 + key) * 1024 + h * 64 + d8 * 8) = pack8(f);
    }
    for (int idx = gt; idx < 16 * 16 * 64 * 64; idx += ngt) {
        const int d = idx & 63, k8 = (idx >> 6) & 63, h = (idx >> 12) & 15, b = idx >> 16;
        const float* src = cv + (((size_t)b * 16 + h) * 512 + k8 * 8) * 64 + d; float f[8];
#pragma unroll
        for (int j = 0; j < 8; ++j) f[j] = src[j * 64];
        *(v4u*)(Vt + (size_t)(h * 64 + d) * LDV + MT + b * 512 + k8 * 8) = pack8(f);
    }
}
__device__ __forceinline__ void attn_phase(const Args& a, int o, LAS unsigned char* lds) {
    const int tid = tid_opaque(), lane = tid & 63, wave = tid >> 6;
    const int gw = blockIdx.x * NWAVES + wave, ngw = gridDim.x * NWAVES;
    const bf16* Q = (const bf16*)(a.ws + OFF_BIG); const bf16* Kb = Q + BIG_K; const bf16* Vt = Q + BIG_VT;
    bf16* O = (bf16*)(a.ws + OFF_R1);
    LAS float* bias = (LAS float*)lds;
    constexpr int KVP = 72;
    LAS bf16* KT = (LAS bf16*)(lds + 16512);
    LAS bf16* VT = KT + 2 * 64 * KVP;
    for (int i = tid; i < 16 * 257; i += NTHREADS) bias[i] = a.in[24][(size_t)o * 16 * 257 + i] * 1.4426950408889634f;
    __syncthreads();
    const int i16 = lane & 15, g = lane >> 4;
    const int keyoff = 8 * (i16 >> 2) + (i16 & 3);
    {
        const int wu = __builtin_amdgcn_readfirstlane(wave);
        const int srow = tid >> 3, sseg = (tid & 7) * 8;
#pragma unroll 1
        for (int unit = xcd_vcu(); unit < 4096; unit += gridDim.x) {
            const int b = unit >> 9, h = (unit >> 5) & 15, c0 = (unit & 31) * 4;
            const int c = c0 + (wu >> 1), half = wu & 1;
            const size_t qrow0 = (size_t)b * TPR + c * 64 + half * 32;
            const int qpos0 = c * 64 + half * 32;
            const int kc_lo = c0 >= 8 ? c0 - 8 : 0, kc_hi = c0 + 3, my_lo = c >= 8 ? c - 8 : 0;
            const LAS float* bh = bias + h * 257 + 128;
            const float bfar = bh[128];
            bf16x8 qf[2][2];
#pragma unroll
            for (int qt = 0; qt < 2; ++qt)
#pragma unroll
                for (int kk = 0; kk < 2; ++kk) qf[qt][kk] = ld_frag(Q + (qrow0 + 16 * qt + i16) * 1024 + h * 64 + 32 * kk + 8 * g);
            f32x4 ot[4][2];
#pragma unroll
            for (int dt = 0; dt < 4; ++dt) { ot[dt][0] = (f32x4){0.f, 0.f, 0.f, 0.f}; ot[dt][1] = (f32x4){0.f, 0.f, 0.f, 0.f}; }
            float mrun[2] = {-1e30f, -1e30f}, lrun[2] = {0.f, 0.f};
            const bf16* kg_ = Kb + ((size_t)b * TPR + srow) * 1024 + h * 64 + sseg;
            const bf16* vg_ = Vt + (size_t)(h * 64 + srow) * LDV + (size_t)b * TPR + sseg;
            v4u kreg = *(const v4u*)(kg_ + (size_t)(64 * kc_lo) * 1024), vreg = *(const v4u*)(vg_ + 64 * kc_lo);
            *(LAS v4u*)(KT + srow * KVP + sseg) = kreg; *(LAS v4u*)(VT + srow * KVP + sseg) = vreg;
            kreg = *(const v4u*)(kg_ + (size_t)(64 * (kc_lo + 1)) * 1024); vreg = *(const v4u*)(vg_ + 64 * (kc_lo + 1));
            v4u kreg2 = kreg, vreg2 = vreg;
            __syncthreads();
#pragma unroll 1
            for (int kc = kc_lo; kc <= kc_hi; ++kc) {
                const int buf = (kc - kc_lo) & 1;
                if (kc + 2 <= kc_hi) { kreg2 = *(const v4u*)(kg_ + (size_t)(64 * (kc + 2)) * 1024); vreg2 = *(const v4u*)(vg_ + 64 * (kc + 2)); }
                if (kc >= my_lo && kc <= c) {
                    const int kpos0 = 64 * kc;
                    const LAS bf16* kt = KT + buf * 64 * KVP + keyoff * KVP + 8 * g; const LAS bf16* vt = VT + buf * 64 * KVP + i16 * KVP + 8 * g;
                    f32x4 st[4][2];
#pragma unroll
                    for (int t4 = 0; t4 < 4; ++t4) {
                        const LAS bf16* p = kt + (32 * (t4 >> 1) + 4 * (t4 & 1)) * KVP;
                        const bf16x8 k0 = *(const LAS bf16x8*)p, k1 = *(const LAS bf16x8*)(p + 32);
#pragma unroll
                        for (int qt = 0; qt < 2; ++qt) {
                            f32x4 acc = {0.f, 0.f, 0.f, 0.f};
                            acc = __builtin_amdgcn_mfma_f32_16x16x32_bf16(k0, qf[qt][0], acc, 0, 0, 0);
                            acc = __builtin_amdgcn_mfma_f32_16x16x32_bf16(k1, qf[qt][1], acc, 0, 0, 0);
                            st[t4][qt] = acc;
                        }
                    }
                    const bool far = qpos0 - (kpos0 + 63) >= 128;
                    bf16x8 pf[2][2];
#pragma unroll
                    for (int qt = 0; qt < 2; ++qt) {
                        const int qpos = qpos0 + 16 * qt + i16;
                        float mx = -1e30f;
                        float boff = 0.f;
                        if (far) {
#pragma unroll
                            for (int t4 = 0; t4 < 4; ++t4)
#pragma unroll
                                for (int j = 0; j < 4; ++j) mx = fmaxf(mx, st[t4][qt][j]);
                            mx += bfar; boff = bfar;
                        } else {
#pragma unroll
                            for (int t4 = 0; t4 < 4; ++t4)
#pragma unroll
                                for (int j = 0; j < 4; ++j) {
                                    int rel = qpos - (kpos0 + 32 * (t4 >> 1) + 8 * g + 4 * (t4 & 1) + j); rel = rel > 128 ? 128 : (rel < -128 ? -128 : rel);
                                    const float sv = st[t4][qt][j] + bh[rel]; st[t4][qt][j] = sv; mx = fmaxf(mx, sv);
                                }
                        }
                        mx = fmaxf(mx, __shfl_xor(mx, 16)); mx = fmaxf(mx, __shfl_xor(mx, 32));
                        const float mnew = fmaxf(mrun[qt], mx), corr = __builtin_amdgcn_exp2f(mrun[qt] - mnew), msub = mnew - boff; mrun[qt] = mnew;
                        float psum = 0.f;
#pragma unroll
                        for (int sb = 0; sb < 2; ++sb) {
                            float p[8];
#pragma unroll
                            for (int T = 0; T < 2; ++T)
#pragma unroll
                                for (int j = 0; j < 4; ++j) { p[4 * T + j] = __builtin_amdgcn_exp2f(st[2 * sb + T][qt][j] - msub); psum += p[4 * T + j]; }
                            pf[sb][qt] = __builtin_bit_cast(bf16x8, pack8(p));
                        }
                        lrun[qt] = lrun[qt] * corr + psum;
#pragma unroll
                        for (int dt = 0; dt < 4; ++dt) ot[dt][qt] *= corr;
                    }
#pragma unroll
                    for (int sb = 0; sb < 2; ++sb)
#pragma unroll
                        for (int dt = 0; dt < 4; ++dt) {
                            const bf16x8 vf = *(const LAS bf16x8*)(vt + 16 * dt * KVP + 32 * sb);
#pragma unroll
                            for (int qt = 0; qt < 2; ++qt) ot[dt][qt] = __builtin_amdgcn_mfma_f32_16x16x32_bf16(vf, pf[sb][qt], ot[dt][qt], 0, 0, 0);
                        }
                }
                if (kc < kc_hi) { *(LAS v4u*)(KT + (buf ^ 1) * 64 * KVP + srow * KVP + sseg) = kreg; *(LAS v4u*)(VT + (buf ^ 1) * 64 * KVP + srow * KVP + sseg) = vreg; }
                kreg = kreg2; vreg = vreg2;
                __syncthreads();
            }
#pragma unroll
            for (int qt = 0; qt < 2; ++qt) {
                float l = lrun[qt]; l += __shfl_xor(l, 16); l += __shfl_xor(l, 32);
                const float inv = 1.0f / l;
                bf16* op = O + (qrow0 + 16 * qt + i16) * 1024 + h * 64 + 4 * g;
#pragma unroll
                for (int dt = 0; dt < 4; ++dt) { const f32x4 v = ot[dt][qt] * inv; v2u w; w.x = cvt_pk_bf16(v[0], v[1]); w.y = cvt_pk_bf16(v[2], v[3]); *(v2u*)(op + 16 * dt) = w; }
            }
        }
    }
#pragma unroll 1
    for (int it = 32768 + gw; it < 32768 + 512; it += ngw) {
        const bool samp = it >= 32768;
        int b, c, h, half;
        if (!samp) { b = it >> 12; c = (it >> 5) & 127; h = (it >> 1) & 15; half = it & 1; }
        else { const int r = it - 32768; b = r >> 5; c = 8; h = (r >> 1) & 15; half = r & 1; }
        const size_t qrow0 = samp ? (size_t)MP + b * 64 + half * 32 : (size_t)b * TPR + c * 64 + half * 32;
        const int qpos0 = c * 64 + half * 32;
        const int kstart = c >= 8 ? c * 64 - 512 : 0, nkb = (c * 64 + 64 - kstart) >> 6;
        const size_t kbase = samp ? (size_t)MT + b * 512 : (size_t)b * TPR + kstart;
        const size_t knew = (size_t)MP + b * 64;
        const LAS float* bh = bias + h * 257 + 128;
        const float bfar = bh[128];
        bf16x8 qf[2][2];
#pragma unroll
        for (int qt = 0; qt < 2; ++qt)
#pragma unroll
            for (int kk = 0; kk < 2; ++kk) qf[qt][kk] = ld_frag(Q + (qrow0 + 16 * qt + i16) * 1024 + h * 64 + 32 * kk + 8 * g);
        f32x4 ot[4][2];
#pragma unroll
        for (int dt = 0; dt < 4; ++dt) { ot[dt][0] = (f32x4){0.f, 0.f, 0.f, 0.f}; ot[dt][1] = (f32x4){0.f, 0.f, 0.f, 0.f}; }
        float mrun[2] = {-1e30f, -1e30f}, lrun[2] = {0.f, 0.f};
        bf16x8 kc[4][2], kn[4][2];
        {   const bf16* kp = Kb + (kbase + keyoff) * 1024 + h * 64 + 8 * g;
#pragma unroll
            for (int t4 = 0; t4 < 4; ++t4) { const bf16* p = kp + (size_t)(32 * (t4 >> 1) + 4 * (t4 & 1)) * 1024; kc[t4][0] = ld_frag(p); kc[t4][1] = ld_frag(p + 32); } }
#pragma unroll 1
        for (int kb = 0; kb < nkb; ++kb) {
            const int kpos0 = kstart + 64 * kb;
            const size_t krow0 = (samp && kb == 8) ? knew : kbase + 64 * kb;
            bf16x8 vf[2][4];
            {   const bf16* vp = Vt + (size_t)(h * 64 + i16) * LDV + krow0 + 8 * g;
#pragma unroll
                for (int sb = 0; sb < 2; ++sb)
#pragma unroll
                    for (int dt = 0; dt < 4; ++dt) vf[sb][dt] = ld_frag(vp + (size_t)(16 * dt) * LDV + 32 * sb); }
            if (kb + 1 < nkb) {
                const size_t krow1 = (samp && kb + 1 == 8) ? knew : kbase + 64 * (kb + 1);
                const bf16* kp = Kb + (krow1 + keyoff) * 1024 + h * 64 + 8 * g;
#pragma unroll
                for (int t4 = 0; t4 < 4; ++t4) { const bf16* p = kp + (size_t)(32 * (t4 >> 1) + 4 * (t4 & 1)) * 1024; kn[t4][0] = ld_frag(p); kn[t4][1] = ld_frag(p + 32); }
            }
            f32x4 st[4][2];
#pragma unroll
            for (int t4 = 0; t4 < 4; ++t4)
#pragma unroll
                for (int qt = 0; qt < 2; ++qt) {
                    f32x4 acc = {0.f, 0.f, 0.f, 0.f};
                    acc = __builtin_amdgcn_mfma_f32_16x16x32_bf16(kc[t4][0], qf[qt][0], acc, 0, 0, 0);
                    acc = __builtin_amdgcn_mfma_f32_16x16x32_bf16(kc[t4][1], qf[qt][1], acc, 0, 0, 0);
                    st[t4][qt] = acc;
                }
            const bool far = qpos0 - (kpos0 + 63) >= 128;
            bf16x8 pf[2][2];
#pragma unroll
            for (int qt = 0; qt < 2; ++qt) {
                const int qpos = qpos0 + 16 * qt + i16;
                float mx = -1e30f;
                float boff = 0.f;
                if (far) {
#pragma unroll
                    for (int t4 = 0; t4 < 4; ++t4)
#pragma unroll
                        for (int j = 0; j < 4; ++j) mx = fmaxf(mx, st[t4][qt][j]);
                    mx += bfar; boff = bfar;
                } else {
#pragma unroll
                    for (int t4 = 0; t4 < 4; ++t4)
#pragma unroll
                        for (int j = 0; j < 4; ++j) {
                            int rel = qpos - (kpos0 + 32 * (t4 >> 1) + 8 * g + 4 * (t4 & 1) + j); rel = rel > 128 ? 128 : (rel < -128 ? -128 : rel);
                            const float s = st[t4][qt][j] + bh[rel]; st[t4][qt][j] = s; mx = fmaxf(mx, s);
                        }
                }
                mx = fmaxf(mx, __shfl_xor(mx, 16)); mx = fmaxf(mx, __shfl_xor(mx, 32));
                const float mnew = fmaxf(mrun[qt], mx), corr = __builtin_amdgcn_exp2f(mrun[qt] - mnew), msub = mnew - boff; mrun[qt] = mnew;
                float psum = 0.f;
#pragma unroll
                for (int sb = 0; sb < 2; ++sb) {
                    float p[8];
#pragma unroll
                    for (int T = 0; T < 2; ++T)
#pragma unroll
                        for (int j = 0; j < 4; ++j) { p[4 * T + j] = __builtin_amdgcn_exp2f(st[2 * sb + T][qt][j] - msub); psum += p[4 * T + j]; }
                    pf[sb][qt] = __builtin_bit_cast(bf16x8, pack8(p));
                }
                lrun[qt] = lrun[qt] * corr + psum;
#pragma unroll
                for (int dt = 0; dt < 4; ++dt) ot[dt][qt] *= corr;
            }
#pragma unroll
            for (int sb = 0; sb < 2; ++sb)
#pragma unroll
                for (int dt = 0; dt < 4; ++dt)
#pragma unroll
                    for (int qt = 0; qt < 2; ++qt) ot[dt][qt] = __builtin_amdgcn_mfma_f32_16x16x32_bf16(vf[sb][dt], pf[sb][qt], ot[dt][qt], 0, 0, 0);
#pragma unroll
            for (int t4 = 0; t4 < 4; ++t4) { kc[t4][0] = kn[t4][0]; kc[t4][1] = kn[t4][1]; }
        }
#pragma unroll
        for (int qt = 0; qt < 2; ++qt) {
            float l = lrun[qt]; l += __shfl_xor(l, 16); l += __shfl_xor(l, 32);
            const float inv = 1.0f / l;
            bf16* op = O + (qrow0 + 16 * qt + i16) * 1024 + h * 64 + 4 * g;
#pragma unroll
            for (int dt = 0; dt < 4; ++dt) { const f32x4 v = ot[dt][qt] * inv; v2u w; w.x = cvt_pk_bf16(v[0], v[1]); w.y = cvt_pk_bf16(v[2], v[3]); *(v2u*)(op + 16 * dt) = w; }
        }
    }
    const int gt = blockIdx.x * NTHREADS + tid, ngt = gridDim.x * NTHREADS;
    for (int idx = gt; idx < 8 * 16 * 512 * 8; idx += ngt) {
        const int d8 = idx & 7, r = (idx >> 3) & 511, h = (idx >> 12) & 15, b = idx >> 16;
        float f[8]; unpack8(*(const v4u*)(Kb + ((size_t)b * TPR + 7680 + r) * 1024 + h * 64 + d8 * 8), f);
        float* dst = a.out + O_PK + ((((size_t)o * 8 + b) * 16 + h) * 512 + r) * 64 + d8 * 8;
        *(f32x4*)dst = (f32x4){f[0], f[1], f[2], f[3]}; *(f32x4*)(dst + 4) = (f32x4){f[4], f[5], f[6], f[7]};
    }
    for (int idx = gt; idx < 8 * 16 * 64 * 64; idx += ngt) {
        const int r8 = idx & 63, d = (idx >> 6) & 63, h = (idx >> 12) & 15, b = idx >> 16;
        float f[8]; unpack8(*(const v4u*)(Vt + (size_t)(h * 64 + d) * LDV + (size_t)b * TPR + 7680 + r8 * 8), f);
        float* dst = a.out + O_PV + ((((size_t)o * 8 + b) * 16 + h) * 512 + r8 * 8) * 64 + d;
#pragma unroll
        for (int j = 0; j < 8; ++j) dst[j * 64] = f[j];
    }
    for (int idx = gt; idx < 16 * 16 * 64 * 8; idx += ngt) {
        const int d8 = idx & 7, t = (idx >> 3) & 63, h = (idx >> 9) & 15, b = idx >> 13;
        float f[8]; unpack8(*(const v4u*)(Kb + ((size_t)MP + b * 64 + t) * 1024 + h * 64 + d8 * 8), f);
        float* dst = a.out + O_SK + ((((size_t)o * 16 + b) * 16 + h) * 64 + t) * 64 + d8 * 8;
        *(f32x4*)dst = (f32x4){f[0], f[1], f[2], f[3]}; *(f32x4*)(dst + 4) = (f32x4){f[4], f[5], f[6], f[7]};
    }
    for (int idx = gt; idx < 16 * 16 * 64 * 8; idx += ngt) {
        const int t8 = idx & 7, d = (idx >> 3) & 63, h = (idx >> 9) & 15, b = idx >> 13;
        float f[8]; unpack8(*(const v4u*)(Vt + (size_t)(h * 64 + d) * LDV + (size_t)MP + b * 64 + t8 * 8), f);
        float* dst = a.out + O_SV + ((((size_t)o * 16 + b) * 16 + h) * 64 + t8 * 8) * 64 + d;
#pragma unroll
        for (int j = 0; j < 8; ++j) dst[j * 64] = f[j];
    }
}

#define XB_TMO      128
#define XB_XCNT(j)  (256  + 64 * (j))
#define XB_XSUB(j)  (1280 + 64 * (j))
#define XB_XGEN(j)  (2304 + 64 * (j))
#define XB_TOP      3328
#define XB_TOPGEN   3392
#define XCD_BAR_WORDS 3456
#define XB_SPIN_CAP (1u << 18)

__device__ __forceinline__ unsigned xb_ld(unsigned* p)              { return __hip_atomic_load(p, __ATOMIC_RELAXED, __HIP_MEMORY_SCOPE_AGENT); }
__device__ __forceinline__ unsigned xb_add(unsigned* p, unsigned v) { return __hip_atomic_fetch_add(p, v, __ATOMIC_RELAXED, __HIP_MEMORY_SCOPE_AGENT); }
__device__ __forceinline__ unsigned xb_xcc_id() { return (unsigned)__builtin_amdgcn_s_getreg((3 << 11) | 20) & 0xFu; }
#define XB_SPIN(cond, bar) do { unsigned _sp = 0; while (cond) { __builtin_amdgcn_s_sleep(1); \
    if ((++_sp & 255u) == 0u) { if (xb_ld(&(bar)[XB_TMO])) break; if (_sp > XB_SPIN_CAP) { atomicAdd(&(bar)[XB_TMO], 1u); break; } } } } while (0)

struct XcdBarrier {
    unsigned* bar; unsigned x;
    volatile LAS unsigned* st;
};

__device__ __forceinline__ XcdBarrier xcd_barrier_post(unsigned* bar, volatile LAS unsigned* st) {
    XcdBarrier b; b.bar = bar; b.x = xb_xcc_id(); b.st = st;
    if (threadIdx.x == 0) (void)xb_add(&bar[XB_XCNT(b.x)], 1u);
    return b;
}
__device__ __forceinline__ void xcd_barrier_complete(unsigned* bar, unsigned x, unsigned& nloc, unsigned& nx) {
    const unsigned G = gridDim.x * gridDim.y * gridDim.z;
    unsigned sum, cnt, mine, sp = 0u;
    for (;;) {
        sum = 0u; cnt = 0u; mine = 0u;
#pragma unroll
        for (unsigned j = 0; j < 16; ++j) { const unsigned c = xb_ld(&bar[XB_XCNT(j)]); sum += c; cnt += (c > 0u) ? 1u : 0u; mine = (j == x) ? c : mine; }
        if (sum == G) break;
        __builtin_amdgcn_s_sleep(1);
        if ((++sp & 255u) == 0u) { if (xb_ld(&bar[XB_TMO])) break; if (sp > XB_SPIN_CAP) { atomicAdd(&bar[XB_TMO], 1u); break; } }
    }
    nloc = mine > 0u ? mine : 1u; nx = cnt > 0u ? cnt : 1u;
}

__device__ __forceinline__ void xcd_barrier(const XcdBarrier& b) {
    asm volatile("s_waitcnt vmcnt(0)" ::: "memory");
    __syncthreads();
    if (threadIdx.x == 0) {
        unsigned* bar = b.bar;
        __builtin_amdgcn_s_waitcnt(0);
        unsigned nloc = b.st[0], nx = b.st[1];
        if (nloc == 0u) { xcd_barrier_complete(bar, b.x, nloc, nx); b.st[0] = nloc; b.st[1] = nx; }
        const unsigned old = xb_add(&bar[XB_XSUB(b.x)], 1u);
        const unsigned gen = old / nloc;
        if (old + 1u == (gen + 1u) * nloc) {
            __builtin_amdgcn_fence(__ATOMIC_RELEASE, "agent");
            asm volatile("s_waitcnt vmcnt(0)" ::: "memory");
            const unsigned og = xb_add(&bar[XB_TOP], 1u);
            const unsigned tg = og / nx;
            if (og + 1u == (tg + 1u) * nx) xb_add(&bar[XB_TOPGEN], 1u);
            else XB_SPIN(xb_ld(&bar[XB_TOPGEN]) == tg, bar);
            __builtin_amdgcn_fence(__ATOMIC_ACQUIRE, "agent");
            xb_add(&bar[XB_XGEN(b.x)], 1u);
            asm volatile("s_waitcnt vmcnt(0)" ::: "memory");
        } else {
            XB_SPIN(xb_ld(&bar[XB_XGEN(b.x)]) == gen, bar);
            __builtin_amdgcn_fence(__ATOMIC_ACQUIRE, "agent");
            asm volatile("s_waitcnt vmcnt(0)" ::: "memory");
        }
    }
    __syncthreads();
}

#ifndef REP_GEMM
#define REP_GEMM 1
#endif
#ifndef REP_SCAN
#define REP_SCAN 1
#endif
#ifndef REP_ATTN
#define REP_ATTN 1
#endif
#ifndef REP_LN
#define REP_LN 1
#endif
#ifndef EXTRA_SYNC
#define EXTRA_SYNC 2
#endif
#ifndef PH_STOP
#define PH_STOP N_PHASES
#endif
#ifndef PHMASK
#define PHMASK 0xffff
#endif
#define PHM(i) (((PHMASK) >> (i)) & 1)
constexpr int NS_K1 = 4, NS_K2 = 11;
constexpr int PH_PER_PAIR = 19, N_PHASES = 1 + 2 * PH_PER_PAIR;
__global__ void __launch_bounds__(NTHREADS, 2) trunk_fwd(Args a) {
    __shared__ __attribute__((aligned(16))) unsigned char lds_raw[LDS_BYTES];
    LAS unsigned char* lds = (LAS unsigned char*)lds_raw;
    cg::grid_group grid = cg::this_grid();
    volatile LAS unsigned* bar_st = (volatile LAS unsigned*)(lds + 131072);
    if (threadIdx.x < 2) bar_st[threadIdx.x] = 0u;
    __syncthreads();
    XcdBarrier xbar = xcd_barrier_post((unsigned*)(a.ws + WS_BAR), bar_st);
    unsigned char* ws = a.ws;
    bf16* XB = (bf16*)(ws + OFF_XB); bf16* R1 = (bf16*)(ws + OFF_R1); bf16* Z = (bf16*)(ws + OFF_Z); bf16* BIG = (bf16*)(ws + OFF_BIG);
    const int G = gridDim.x, cb = blockIdx.x;
#pragma unroll 1
    for (int ph = a.ph_lo; ph < a.ph_hi; ++ph) {
        bool nosync = false;
        if (ph == 0) { if (PHM(0)) prologue_phase(a, lds); }
        else {
            const int e = (ph - 1) / PH_PER_PAIR, q = (ph - 1) - e * PH_PER_PAIR;
            const int layer = 2 * e + (q >= 11 ? 1 : 0);
            int kind = -1; pg8::Gemm g{nullptr, nullptr, MT, 0, 0, nullptr, nullptr};
            pg8::EpiBf16 eb{nullptr, 0, 0, 0, 1.f, nullptr, 0}; int m2 = 0, n2 = 0;
            switch (q) {
            case 0:  kind = 0; g = pg8::Gemm{XB, (const bf16*)(ws + W_IN + e * W_IN_SZ), MT, NMIX, 1024, nullptr, nullptr}; eb = pg8::EpiBf16{BIG, APROJ, APROJ, (size_t)MT * APROJ, 1.f, nullptr, 0}; break;
            case 2:  kind = 0; g = pg8::Gemm{Z, (const bf16*)(ws + W_LO + e * W_LO_SZ), MT, NLORA, KLORA, nullptr, nullptr}; eb = pg8::EpiBf16{R1, 512, 512, (size_t)MT * 512, 1.f, nullptr, 0}; break;
            case 11: kind = 0; g = pg8::Gemm{XB, (const bf16*)(ws + W_QKV + e * W_QKV_SZ), MT, 2048, 1024, (const bf16*)(ws + W_QKV + e * W_QKV_SZ) + (size_t)2048 * 1024, XB};
                     eb = pg8::EpiBf16{BIG, 1024, 1024, (size_t)MT * 1024, 0.125f * 1.4426950408889634f, BIG + BIG_VT, LDV}; m2 = 1024; n2 = MT; break;
            case 12: nosync = true; break;
            case 8: case 16: kind = 1; g = pg8::Gemm{XB, (const bf16*)(ws + W_FI + layer * W_FI_SZ), MT, 2 * FH, 1024, nullptr, nullptr}; break;
            case 6:  kind = 2; g = pg8::Gemm{R1, (const bf16*)(ws + W_OM + e * W_SQ_SZ), MT, 1024, 1024, nullptr, nullptr}; break;
            case 14: kind = 2; g = pg8::Gemm{R1, (const bf16*)(ws + W_O + e * W_SQ_SZ), MT, 1024, 1024, nullptr, nullptr}; break;
            case 9: case 17: kind = 2; g = pg8::Gemm{BIG, (const bf16*)(ws + W_FO + layer * W_FO_SZ), MT, 1024, FH, nullptr, nullptr}; break;
            default: break;
            }
            const int nrep = kind >= 0 ? REP_GEMM : (q == 4 ? REP_SCAN : (q == 13 ? REP_ATTN : ((q == 7 || q == 15 || q == 10 || q == 18) ? REP_LN : 1)));
            if (q == 11) cache_convert(a, e);
#pragma unroll 1
            for (int rep = 0; rep < nrep; ++rep) {
            if (kind == 0 && PHM(1)) { pg8::StaticOrder S; S.init(g.M, g.N, G, cb, g.K, q == 2 ? 1 : 0); if (m2) S.second(m2, n2); pg8::gemm_phase<pg8::EpiBf16, pg8::StaticOrder, true, true>(lds, g, S, eb); }
            else if (kind == 1 && PHM(2)) { pg8::StaticOrder S; S.init(g.M, g.N, G, cb, g.K); pg8::EpiSwiglu es{BIG, FH}; pg8::gemm_phase<pg8::EpiSwiglu, pg8::StaticOrder, true, true>(lds, g, S, es); }
            else if (kind == 2 && PHM(3)) { pg8::SplitOrder S; S.init(G, cb, g.K, g.K == 1024 ? NS_K1 : NS_K2); pg8::EpiResid er{XB, Z, 1024, DN_ALPHA, (float*)(ws + OFF_G)}; pg8::gemm_phase<pg8::EpiResid, pg8::SplitOrder, true, true>(lds, g, S, er); }
            else if (q == 1 && PHM(4)) prep1_phase(a, e);
            else if (q == 3 && PHM(5)) prep2_phase(a, e);
            else if (q == 4 && PHM(6)) scan_phase(a, e, lds);
            else if (q == 5 && PHM(7)) post_phase(a, e);
            else if (q == 13 && PHM(8)) attn_phase(a, e, lds);
            else if ((q == 7 || q == 15) && PHM(9)) ln_phase(a, a.in[26] + (size_t)layer * 1024, a.in[27] + (size_t)layer * 1024, nullptr, NS_K1);
            else if ((q == 10 || q == 18) && PHM(9)) ln_phase(a, a.in[28] + (size_t)layer * 1024, a.in[29] + (size_t)layer * 1024, (layer == 3) ? a.out : nullptr, NS_K2);
        }
        }
        if (ph + 1 < a.ph_hi && !nosync) { if (ph == 0) grid.sync(); else xcd_barrier(xbar); }
        else __syncthreads();
    }
}

extern "C" void kernel_launch(void* const* d_in, const int* in_sizes, int n_in, void* d_out, int out_size, void* d_ws, size_t ws_size, hipStream_t stream) {
    static int grid = 0; static int badsz = 0;
    if (grid == 0) {
        if (n_in != 32 || ws_size < WS_BAR + WS_BAR_BYTES || out_size != 92360704) { fprintf(stderr, "kernel_launch: unexpected shapes (n_in %d, ws %zu, out %d)\n", n_in, ws_size, out_size); grid = -1; return; }
        static const long long exp_sz[32] = {67108864LL, 1048576, 1048576, 57344, 1048576, 16777216, 16777216, 6848512, 3584, 1024, 65536, 1024, 65536, 131072, 1024, 1024, 1024, 1024, 1024, 8192, 512, 256, 2097152, 6291456, 8224, 2097152, 4096, 4096, 4096, 4096, 23068672, 11534336};
        for (int i = 0; i < 32; ++i) if ((long long)in_sizes[i] != exp_sz[i]) { fprintf(stderr, "kernel_launch: input %d has %d elements, expected %lld\n", i, in_sizes[i], exp_sz[i]); badsz = 1; }
        int dev = 0, cus = 0, per_cu = 0;
        hipGetDevice(&dev); hipDeviceGetAttribute(&cus, hipDeviceAttributeMultiprocessorCount, dev);
        if (hipOccupancyMaxActiveBlocksPerMultiprocessor(&per_cu, (const void*)trunk_fwd, NTHREADS, 0) != hipSuccess || per_cu < 1) { fprintf(stderr, "kernel_launch: occupancy query says %d\n", per_cu); per_cu = 1; }
        (void)hipGetLastError();
        grid = cus * per_cu;
    }
    if (grid < 0) return;
    Args a{};
    for (int i = 0; i < 32; ++i) a.in[i] = (const float*)d_in[i];
    a.out = (float*)d_out; a.ws = (unsigned char*)d_ws;
#if defined(MK_PER_PHASE)
    for (int p = 0; p < N_PHASES; ++p) { a.ph_lo = p; a.ph_hi = p + 1; hipLaunchKernelGGL(trunk_fwd, dim3(grid), dim3(NTHREADS), 0, stream, a); }
#else
    a.ph_lo = 0; a.ph_hi = badsz ? 0 : PH_STOP;
    if (hipMemsetAsync((char*)d_ws + WS_BAR, 0, WS_BAR_BYTES, stream) != hipSuccess) { fprintf(stderr, "kernel_launch: memset of the barrier words failed\n"); return; }
    void* args[] = {&a};
    hipError_t err = hipLaunchCooperativeKernel((const void*)trunk_fwd, dim3(grid), dim3(NTHREADS), args, 0, stream);
    if (err != hipSuccess) fprintf(stderr, "kernel_launch: cooperative launch failed: %s (grid %d)\n", hipGetErrorString(err), grid);
#endif
}
```
